# Optimizing an MI355X kernel written in HIP

```python
import math
import jax
import jax.numpy as jnp
from jax import lax
import numpy as np

D_MODEL = 1024
BATCH = 2
SEQ = 8192
DEPTH = 2

HEAD_DIM = 64
BRANCH_WIDTH = 512
N_BRANCH = 4
SSM_HEADS = 8
SSM_HEAD_DIM = 64
SSM_INNER = SSM_HEADS * SSM_HEAD_DIM
SSM_GROUPS = 2
SSM_STATE = 128
SSM_CONV = 4
SSM_CHUNK = 256
SSM_CONV_CH = SSM_INNER + 2 * SSM_GROUPS * SSM_STATE
FOX_HEADS = 8
MOBA_HEADS = 8
MOBA_BLOCK = 256
MOBA_TOPK = 3
MOBA_Q_BLOCK = 64
DSA_HEADS = 8
IDX_HEADS = 4
IDX_DIM = 64
DSA_TOPK = 256
Q_BLOCK = 128
ROPE_THETA = 10000.0
FFN_HIDDEN = -(-8 * D_MODEL // (3 * 256)) * 256
EPS = 1e-6

IN_SPLITS = (
    SSM_INNER, SSM_INNER, SSM_GROUPS * SSM_STATE, SSM_GROUPS * SSM_STATE, SSM_HEADS,
    FOX_HEADS * HEAD_DIM, FOX_HEADS * HEAD_DIM, FOX_HEADS * HEAD_DIM, FOX_HEADS,
    MOBA_HEADS * HEAD_DIM, MOBA_HEADS * HEAD_DIM, MOBA_HEADS * HEAD_DIM,
    DSA_HEADS * HEAD_DIM, DSA_HEADS * HEAD_DIM, DSA_HEADS * HEAD_DIM,
    IDX_HEADS * IDX_DIM, IDX_DIM, IDX_HEADS,
)
D_IN = sum(IN_SPLITS)

kernel_name = 'hybrid_gated_ssd_fox_moba_dsa'


def rms_norm(x, g):
    x32 = x.astype(jnp.float32)
    y = x32 * lax.rsqrt(jnp.mean(x32 * x32, axis=-1, keepdims=True) + EPS)
    return (y * g.astype(jnp.float32)).astype(x.dtype)


def rope_tables(seq):
    pos = jnp.arange(seq, dtype=jnp.float32)
    inv = ROPE_THETA ** (-jnp.arange(0, HEAD_DIM, 2, dtype=jnp.float32) / HEAD_DIM)
    ang = pos[:, None] * inv[None, :]
    return jnp.cos(ang), jnp.sin(ang)


def apply_rope(t, cos, sin):
    t1, t2 = jnp.split(t.astype(jnp.float32), 2, axis=-1)
    c = cos[None, :, None, :]
    s = sin[None, :, None, :]
    return jnp.concatenate([t1 * c - t2 * s, t2 * c + t1 * s], axis=-1).astype(t.dtype)


def split_heads(t, n_heads):
    return t.reshape(t.shape[0], t.shape[1], n_heads, -1)


def causal_dwconv(u, w, b):
    width = w.shape[0]
    up = jnp.pad(u, ((0, 0), (width - 1, 0), (0, 0)))
    y = lax.conv_general_dilated(up, w[:, None, :], window_strides=(1,), padding='VALID',
                                 dimension_numbers=('NWC', 'WIO', 'NWC'),
                                 feature_group_count=u.shape[-1])
    return y + b


def ssd_chunked(x, dt, a, bmat, cmat):
    bsz, seq, n_heads, hp = x.shape
    pad = (-seq) % SSM_CHUNK
    padl = lambda t: jnp.pad(t, ((0, 0), (0, pad)) + ((0, 0),) * (t.ndim - 2))
    n_chunk = (seq + pad) // SSM_CHUNK
    chunk = lambda t: padl(t).reshape((bsz, n_chunk, SSM_CHUNK) + t.shape[2:])
    xc, dtc, bc, cc = chunk(x), chunk(dt), chunk(bmat), chunk(cmat)
    a_cs = jnp.cumsum((dtc * a).transpose(0, 3, 1, 2), axis=-1)
    xdt = xc * dtc[..., None]
    causal = jnp.tril(jnp.ones((SSM_CHUNK, SSM_CHUNK), dtype=bool))
    seg = a_cs[..., :, None] - a_cs[..., None, :]
    decay = jnp.exp(jnp.where(causal, seg, -jnp.inf))
    scores = jnp.einsum('bclhn,bcshn->bhcls', cc, bc) * decay
    y_diag = jnp.einsum('bhcls,bcshp->bclhp', scores, xdt)
    decay_states = jnp.exp(a_cs[..., -1:] - a_cs)
    states = jnp.einsum('bclhn,bhcl,bclhp->bchpn', bc, decay_states, xdt)
    chunk_decay = jnp.exp(a_cs[..., -1])

    def step(h, inp):
        s_c, d_c = inp
        return h * d_c[..., None, None] + s_c, h

    h0 = jnp.zeros((bsz, n_heads, hp, bmat.shape[-1]), jnp.float32)
    _, prev = lax.scan(step, h0, (states.transpose(1, 0, 2, 3, 4), chunk_decay.transpose(2, 0, 1)))
    prev = prev.transpose(1, 0, 2, 3, 4)
    y_off = jnp.einsum('bclhn,bchpn,bhcl->bclhp', cc, prev, jnp.exp(a_cs))
    y = (y_diag + y_off).reshape(bsz, n_chunk * SSM_CHUNK, n_heads, hp)
    return y[:, :seq]


def mamba2_branch(z, xs, bs, cs, dt_raw, conv_w, conv_b, dt_bias, a_log, d_skip, norm_w):
    bsz, seq, _ = z.shape
    xbc = jax.nn.silu(causal_dwconv(jnp.concatenate([xs, bs, cs], axis=-1), conv_w, conv_b))
    xs, bs, cs = jnp.split(xbc, [SSM_INNER, SSM_INNER + SSM_GROUPS * SSM_STATE], axis=-1)
    rep = SSM_HEADS // SSM_GROUPS
    xh = xs.reshape(bsz, seq, SSM_HEADS, SSM_HEAD_DIM).astype(jnp.float32)
    bh = jnp.repeat(bs.reshape(bsz, seq, SSM_GROUPS, SSM_STATE), rep, axis=2).astype(jnp.float32)
    ch = jnp.repeat(cs.reshape(bsz, seq, SSM_GROUPS, SSM_STATE), rep, axis=2).astype(jnp.float32)
    dt = jax.nn.softplus(dt_raw.astype(jnp.float32) + dt_bias.astype(jnp.float32))
    a = -jnp.exp(a_log.astype(jnp.float32))
    y = ssd_chunked(xh, dt, a, bh, ch) + d_skip.astype(jnp.float32)[:, None] * xh
    y = y.reshape(bsz, seq, SSM_INNER) * jax.nn.silu(z.astype(jnp.float32))
    yg = y.reshape(bsz, seq, SSM_GROUPS, -1)
    yg = yg * lax.rsqrt(jnp.mean(yg * yg, axis=-1, keepdims=True) + EPS)
    return (yg.reshape(bsz, seq, SSM_INNER) * norm_w.astype(jnp.float32)).astype(z.dtype)


def fox_branch(q, k, v, f_logit, f_bias):
    bsz, seq, n_heads, hd = q.shape
    log_f = jax.nn.log_sigmoid(f_logit.astype(jnp.float32) + f_bias.astype(jnp.float32))
    cf = jnp.cumsum(log_f, axis=1).transpose(0, 2, 1)
    kpos = jnp.arange(seq)
    scale = hd ** -0.5

    def block(i):
        start = i * Q_BLOCK
        qb = lax.dynamic_slice_in_dim(q, start, Q_BLOCK, axis=1)
        cq = lax.dynamic_slice_in_dim(cf, start, Q_BLOCK, axis=2)
        qpos = start + jnp.arange(Q_BLOCK)
        logits = jnp.einsum('bqhd,bkhd->bhqk', qb, k).astype(jnp.float32) * scale
        logits = logits + cq[..., :, None] - cf[..., None, :]
        logits = jnp.where(kpos[None, :] <= qpos[:, None], logits, -jnp.inf)
        p = jax.nn.softmax(logits, axis=-1).astype(v.dtype)
        return jnp.einsum('bhqk,bkhd->bqhd', p, v)

    out = lax.map(block, jnp.arange(seq // Q_BLOCK))
    return out.transpose(1, 0, 2, 3, 4).reshape(bsz, seq, n_heads * hd)


def moba_branch(q, k, v):
    bsz, seq, n_heads, hd = q.shape
    n_blk = -(-seq // MOBA_BLOCK)
    pad = n_blk * MOBA_BLOCK - seq
    to_blocks = lambda t: jnp.pad(t, ((0, 0), (0, pad), (0, 0), (0, 0))).reshape(
        bsz, n_blk, MOBA_BLOCK, n_heads, hd).transpose(0, 3, 1, 2, 4)
    k_blk, v_blk = to_blocks(k), to_blocks(v)
    k_mean = jnp.mean(k_blk.astype(jnp.float32), axis=3)
    n_sel = min(MOBA_TOPK, n_blk)
    n_sel_keys = n_sel * MOBA_BLOCK
    scale = hd ** -0.5
    b_ix = jnp.arange(bsz)[:, None, None, None]
    h_ix = jnp.arange(n_heads)[None, None, :, None]
    blk_ids = jnp.arange(n_blk)

    def block(i):
        start = i * MOBA_Q_BLOCK
        qb = lax.dynamic_slice_in_dim(q, start, MOBA_Q_BLOCK, axis=1)
        qpos = start + jnp.arange(MOBA_Q_BLOCK)
        cur = start // MOBA_BLOCK
        gate = jnp.einsum('bqhd,bhnd->bqhn', qb.astype(jnp.float32), k_mean)
        gate = jnp.where(blk_ids < cur, gate, -jnp.inf)
        _, sel = lax.top_k(gate, n_sel)
        sel_ok = sel < cur
        k_sel = k_blk[b_ix, h_ix, sel]
        v_sel = v_blk[b_ix, h_ix, sel]
        s_sel = jnp.einsum('bqhd,bqhnkd->bqhnk', qb, k_sel).astype(jnp.float32) * scale
        s_sel = jnp.where(sel_ok[..., None], s_sel, -jnp.inf)
        k_own = lax.dynamic_index_in_dim(k_blk, cur, axis=2, keepdims=False)
        v_own = lax.dynamic_index_in_dim(v_blk, cur, axis=2, keepdims=False)
        own_pos = cur * MOBA_BLOCK + jnp.arange(MOBA_BLOCK)
        s_own = jnp.einsum('bqhd,bhkd->bqhk', qb, k_own).astype(jnp.float32) * scale
        s_own = jnp.where(own_pos[None, None, None, :] <= qpos[None, :, None, None], s_own, -jnp.inf)
        logits = jnp.concatenate([s_sel.reshape(bsz, MOBA_Q_BLOCK, n_heads, n_sel_keys), s_own], axis=-1)
        p = jax.nn.softmax(logits, axis=-1).astype(v.dtype)
        p_sel = p[..., :n_sel_keys].reshape(bsz, MOBA_Q_BLOCK, n_heads, n_sel, MOBA_BLOCK)
        p_own = p[..., n_sel_keys:]
        return (jnp.einsum('bqhnk,bqhnkd->bqhd', p_sel, v_sel)
                + jnp.einsum('bqhk,bhkd->bqhd', p_own, v_own))

    out = lax.map(block, jnp.arange(seq // MOBA_Q_BLOCK))
    return out.transpose(1, 0, 2, 3, 4).reshape(bsz, seq, n_heads * hd)


def dsa_branch(q, k, v, qi, ki, wi):
    bsz, seq, n_heads, hd = q.shape
    n_keep = min(DSA_TOPK, seq // 4)
    kpos = jnp.arange(seq)
    scale = hd ** -0.5
    idx_scale = IDX_DIM ** -0.5
    w_scale = IDX_HEADS ** -0.5
    b_ix = jnp.arange(bsz)[:, None, None]

    def block(i):
        start = i * Q_BLOCK
        qb = lax.dynamic_slice_in_dim(q, start, Q_BLOCK, axis=1)
        qib = lax.dynamic_slice_in_dim(qi, start, Q_BLOCK, axis=1)
        wib = lax.dynamic_slice_in_dim(wi, start, Q_BLOCK, axis=1)
        qpos = start + jnp.arange(Q_BLOCK)
        isc = jax.nn.relu(jnp.einsum('bqhd,bkd->bqhk', qib, ki).astype(jnp.float32) * idx_scale)
        isc = jnp.einsum('bqh,bqhk->bqk', wib.astype(jnp.float32) * w_scale, isc)
        isc = jnp.where(kpos[None, None, :] <= qpos[None, :, None], isc, -jnp.inf)
        _, sel = lax.top_k(isc, n_keep)
        ok = sel <= qpos[None, :, None]
        k_sel = k[b_ix, sel]
        v_sel = v[b_ix, sel]
        logits = jnp.einsum('bqhd,bqkhd->bqhk', qb, k_sel).astype(jnp.float32) * scale
        logits = jnp.where(ok[:, :, None, :], logits, -jnp.inf)
        p = jax.nn.softmax(logits, axis=-1).astype(v.dtype)
        return jnp.einsum('bqhk,bqkhd->bqhd', p, v_sel)

    out = lax.map(block, jnp.arange(seq // Q_BLOCK))
    return out.transpose(1, 0, 2, 3, 4).reshape(bsz, seq, n_heads * hd)


def hybrid_mixer(h, w_in, conv_w, conv_b, dt_bias, a_log, d_skip, ssm_norm, fox_fbias,
                 w_gate, b_gate, w_branch, w_out, cos, sin):
    bsz, seq, _ = h.shape
    u = h @ w_in
    (z, xs, bs, cs, dt_raw, fq, fk, fv, ff, mq, mk, mv, dq, dk, dv, iq, ik, iw) = jnp.split(
        u, np.cumsum(IN_SPLITS)[:-1].tolist(), axis=-1)
    y_ssm = mamba2_branch(z, xs, bs, cs, dt_raw, conv_w, conv_b, dt_bias, a_log, d_skip, ssm_norm)
    y_fox = fox_branch(split_heads(fq, FOX_HEADS), split_heads(fk, FOX_HEADS),
                       split_heads(fv, FOX_HEADS), ff, fox_fbias)
    y_moba = moba_branch(apply_rope(split_heads(mq, MOBA_HEADS), cos, sin),
                         apply_rope(split_heads(mk, MOBA_HEADS), cos, sin),
                         split_heads(mv, MOBA_HEADS))
    y_dsa = dsa_branch(apply_rope(split_heads(dq, DSA_HEADS), cos, sin),
                       apply_rope(split_heads(dk, DSA_HEADS), cos, sin),
                       split_heads(dv, DSA_HEADS),
                       apply_rope(split_heads(iq, IDX_HEADS), cos, sin),
                       apply_rope(ik[:, :, None, :], cos, sin)[:, :, 0, :],
                       iw)
    ys = jnp.stack([y_ssm, y_fox, y_moba, y_dsa], axis=2)
    proj = jnp.einsum('bsnc,ncd->bsnd', ys, w_branch)
    gates = jax.nn.sigmoid(h @ w_gate + b_gate).reshape(bsz, seq, N_BRANCH, D_MODEL)
    merged = jnp.sum(gates * proj, axis=2)
    return merged @ w_out


def swiglu(h, w_in, w_out):
    g, up = jnp.split(h @ w_in, 2, axis=-1)
    return (jax.nn.silu(g) * up) @ w_out


def setup_inputs(seed: int = 0) -> dict:
    key = jax.random.key(seed)
    ks = jax.random.split(key, 19)
    f32 = jnp.float32
    nrm = lambda k, shape, scale: jax.random.normal(k, shape, f32) * scale
    gain = lambda k, shape: 1.0 + 0.05 * jax.random.normal(k, shape, f32)
    dt0 = jnp.exp(jax.random.uniform(ks[5], (DEPTH, SSM_HEADS), f32, math.log(1e-3), math.log(1e-1)))
    return {
        'x': nrm(ks[0], (BATCH, SEQ, D_MODEL), 1.0),
        'norm_mix_pre': gain(ks[1], (DEPTH, D_MODEL)),
        'w_in': nrm(ks[2], (DEPTH, D_MODEL, D_IN), D_MODEL ** -0.5),
        'conv_w': nrm(ks[3], (DEPTH, SSM_CONV, SSM_CONV_CH), SSM_CONV ** -0.5),
        'conv_b': nrm(ks[4], (DEPTH, SSM_CONV_CH), 0.02),
        'dt_bias': dt0 + jnp.log(-jnp.expm1(-dt0)),
        'a_log': jnp.log(jax.random.uniform(ks[6], (DEPTH, SSM_HEADS), f32, 1.0, 16.0)),
        'd_skip': 1.0 + 0.1 * jax.random.normal(ks[7], (DEPTH, SSM_HEADS), f32),
        'ssm_norm': gain(ks[8], (DEPTH, SSM_INNER)),
        'fox_fbias': 3.0 + 0.5 * jax.random.normal(ks[9], (DEPTH, FOX_HEADS), f32),
        'w_gate': nrm(ks[10], (DEPTH, D_MODEL, N_BRANCH * D_MODEL), D_MODEL ** -0.5),
        'b_gate': nrm(ks[11], (DEPTH, N_BRANCH * D_MODEL), 0.02),
        'w_branch': nrm(ks[12], (DEPTH, N_BRANCH, BRANCH_WIDTH, D_MODEL), BRANCH_WIDTH ** -0.5),
        'w_out': nrm(ks[13], (DEPTH, D_MODEL, D_MODEL), D_MODEL ** -0.5),
        'norm_mix_post': gain(ks[14], (DEPTH, D_MODEL)),
        'norm_ffn_pre': gain(ks[15], (DEPTH, D_MODEL)),
        'w_ffn_in': nrm(ks[16], (DEPTH, D_MODEL, 2 * FFN_HIDDEN), D_MODEL ** -0.5),
        'w_ffn_out': nrm(ks[17], (DEPTH, FFN_HIDDEN, D_MODEL), FFN_HIDDEN ** -0.5),
        'norm_ffn_post': gain(ks[18], (DEPTH, D_MODEL)),
    }


def reference(x, norm_mix_pre, w_in, conv_w, conv_b, dt_bias, a_log, d_skip, ssm_norm, fox_fbias,
              w_gate, b_gate, w_branch, w_out, norm_mix_post, norm_ffn_pre, w_ffn_in, w_ffn_out,
              norm_ffn_post):
    cos, sin = rope_tables(x.shape[1])
    for l in range(DEPTH):
        h = rms_norm(x, norm_mix_pre[l])
        mix = hybrid_mixer(h, w_in[l], conv_w[l], conv_b[l], dt_bias[l], a_log[l], d_skip[l],
                           ssm_norm[l], fox_fbias[l], w_gate[l], b_gate[l], w_branch[l], w_out[l],
                           cos, sin)
        x = x + rms_norm(mix, norm_mix_post[l])
        h = rms_norm(x, norm_ffn_pre[l])
        x = x + rms_norm(swiglu(h, w_ffn_in[l], w_ffn_out[l]), norm_ffn_post[l])
    return x
```

```cpp
#include <hip/hip_runtime.h>
#include <hip/hip_cooperative_groups.h>
#include <hip/hip_bf16.h>
#include <cstdio>
#include <cstdint>
#include <cmath>
namespace cg = cooperative_groups;
namespace pg8 {
#define PG8_LAS __attribute__((address_space(3)))
typedef unsigned short bf16_t;
typedef short bf16x8 __attribute__((ext_vector_type(8)));
typedef float f32x4 __attribute__((ext_vector_type(4)));
typedef unsigned u32x4 __attribute__((ext_vector_type(4)));
constexpr int BM = 256, BK = 64, HALF = 128, HTB = HALF * BK * 2  , STAGE_BYTES = 8 * HTB, NXCD = 8, WGM = 8;

__host__ __device__ __forceinline__ int lds_byte(int r, int c) { const int st = (r >> 4) * 2 + (c >> 5), rr = r & 15, cc = c & 31, ob = rr * 64 + cc * 2; return st * 1024 + (ob ^ (((ob >> 9) & 1) << 5)); }
__host__ __device__ __forceinline__ void stage_rc(int b, int& R, int& C) { const int st = b / 1024, sb = b % 1024, swz = sb ^ (((sb >> 9) & 1) << 5); R = (st >> 1) * 16 + swz / 64; C = (st & 1) * 32 + (swz % 64) / 2; }
__host__ __device__ __forceinline__ int perm32(int rho) { const int n = rho >> 4, i = rho & 15; return 8 * (i >> 2) + 4 * n + (i & 3); }

struct Unit { int pm, pn; };
struct Gemm { const bf16_t* A; const bf16_t* Bt; int M, N, K, lda, ldb; };

struct StaticOrder {
    int nM, nN, nwg, G, c;
    __host__ __device__ void init(int M, int N, int G_, int c_) { nM = M / BM; nN = N / BM; nwg = nM * nN; G = G_; c = c_; }
    __host__ __device__ bool next(int i, Unit& u) const {
        const long L = (long)i * G + c; if (L >= nwg) return false;
        int wgid = (int)L; { const int q = nwg / NXCD, r = nwg % NXCD, xcd = wgid % NXCD, off = wgid / NXCD; wgid = (xcd < r ? xcd * (q + 1) : r * (q + 1) + (xcd - r) * q) + off; }
        const int nig = WGM * nN, gid = wgid / nig, fm = gid * WGM, gsz = (nM - fm) < WGM ? (nM - fm) : WGM;
        u.pm = fm + ((wgid % nig) % gsz); u.pn = (wgid % nig) / gsz; return true;
    }
    __device__ __forceinline__ void a_ready(const Unit&) const {}
    __device__ __forceinline__ void done(const Unit&) const {}
};
typedef float f32x2 __attribute__((ext_vector_type(2)));
typedef __bf16 bf16x2_t __attribute__((ext_vector_type(2)));
typedef unsigned u32x2 __attribute__((ext_vector_type(2)));
__device__ __forceinline__ unsigned cvt_pk_bf16(float lo, float hi) { f32x2 v = {lo, hi}; bf16x2_t b = __builtin_convertvector(v, bf16x2_t); return __builtin_bit_cast(unsigned, b); }
__device__ __forceinline__ float bf_lo(unsigned w) { return __builtin_bit_cast(float, w << 16); }
__device__ __forceinline__ float bf_hi(unsigned w) { return __builtin_bit_cast(float, w & 0xffff0000u); }
__device__ __forceinline__ float sigmoidf_(float x) { return 1.0f / (1.0f + __expf(-x)); }

struct EpiIn {
    static constexpr bool PERM = true, AFTER_DRAIN = false;
    bf16_t* U; int ldu; unsigned scale_tiles; float scale; int misc_tile; float* misc;
    __device__ __forceinline__ void operator()(const f32x4 (&acc)[2][2][4][2], const Unit& u, int wr, int wc, int fr, int fq) const {
        const int row0 = u.pm * BM + wr * 64 + fr;
        if (u.pn == misc_tile) {
#pragma unroll
            for (int ai = 0; ai < 2; ++ai)
#pragma unroll
                for (int m = 0; m < 4; ++m) { float* rowp = misc + (size_t)(row0 + ai * HALF + m * 16) * 128 + wc * 32 + 8 * fq;
                    *(f32x4*)(rowp) = acc[ai][0][m][0]; *(f32x4*)(rowp + 4) = acc[ai][0][m][1]; }
            return;
        }
        const float sc = ((scale_tiles >> u.pn) & 1u) ? scale : 1.0f;
        const int col0 = u.pn * BM + wc * 32 + 8 * fq;
#pragma unroll
        for (int ai = 0; ai < 2; ++ai)
#pragma unroll
            for (int m = 0; m < 4; ++m) { bf16_t* rowp = U + (size_t)(row0 + ai * HALF + m * 16) * ldu + col0;
#pragma unroll
                for (int bj = 0; bj < 2; ++bj) { const f32x4 v0 = acc[ai][bj][m][0] * sc, v1 = acc[ai][bj][m][1] * sc;
                    u32x4 w; w.x = cvt_pk_bf16(v0[0], v0[1]); w.y = cvt_pk_bf16(v0[2], v0[3]); w.z = cvt_pk_bf16(v1[0], v1[1]); w.w = cvt_pk_bf16(v1[2], v1[3]);
                    *(u32x4*)(rowp + bj * HALF) = w; } }
    }
};
struct EpiSig {
    static constexpr bool PERM = true, AFTER_DRAIN = false;
    bf16_t* O; int ldc; const float* bias;
    __device__ __forceinline__ void operator()(const f32x4 (&acc)[2][2][4][2], const Unit& u, int wr, int wc, int fr, int fq) const {
        const int row0 = u.pm * BM + wr * 64 + fr, col0 = u.pn * BM + wc * 32 + 8 * fq;
        f32x4 bv[2][2];
#pragma unroll
        for (int bj = 0; bj < 2; ++bj)
#pragma unroll
            for (int n = 0; n < 2; ++n) bv[bj][n] = *(const f32x4*)(bias + col0 + bj * HALF + 4 * n);
#pragma unroll
        for (int ai = 0; ai < 2; ++ai)
#pragma unroll
            for (int m = 0; m < 4; ++m) { bf16_t* rowp = O + (size_t)(row0 + ai * HALF + m * 16) * ldc + col0;
#pragma unroll
                for (int bj = 0; bj < 2; ++bj) { f32x4 v0 = acc[ai][bj][m][0] + bv[bj][0], v1 = acc[ai][bj][m][1] + bv[bj][1];
#pragma unroll
                    for (int j = 0; j < 4; ++j) { v0[j] = sigmoidf_(v0[j]); v1[j] = sigmoidf_(v1[j]); }
                    u32x4 w; w.x = cvt_pk_bf16(v0[0], v0[1]); w.y = cvt_pk_bf16(v0[2], v0[3]); w.z = cvt_pk_bf16(v1[0], v1[1]); w.w = cvt_pk_bf16(v1[2], v1[3]);
                    *(u32x4*)(rowp + bj * HALF) = w; } }
    }
};
struct EpiBranch {
    static constexpr bool PERM = false, AFTER_DRAIN = false;
    bf16_t* G; float* Mg; int ldc; int first, last;
    __device__ __forceinline__ void operator()(const f32x4 (&acc)[2][2][4][2], const Unit& u, int wr, int wc, int fr, int fq) const {
        const int row0 = u.pm * BM + wr * 64 + fr, col0 = u.pn * BM + wc * 32 + 4 * fq;
#pragma unroll
        for (int ai = 0; ai < 2; ++ai)
#pragma unroll
            for (int m = 0; m < 4; ++m) { const size_t ro = (size_t)(row0 + ai * HALF + m * 16) * ldc + col0;
#pragma unroll
                for (int bj = 0; bj < 2; ++bj)
#pragma unroll
                    for (int n = 0; n < 2; ++n) { const size_t off = ro + bj * HALF + n * 16;
                        const u32x2 gw = *(const u32x2*)(G + off);
                        f32x4 v = acc[ai][bj][m][n]; v[0] *= bf_lo(gw.x); v[1] *= bf_hi(gw.x); v[2] *= bf_lo(gw.y); v[3] *= bf_hi(gw.y);
                        if (!first) v = v + *(const f32x4*)(Mg + off);
                        if (last) { u32x2 w; w.x = cvt_pk_bf16(v[0], v[1]); w.y = cvt_pk_bf16(v[2], v[3]); *(u32x2*)(G + off) = w; }
                        else *(f32x4*)(Mg + off) = v; } }
    }
};
struct EpiF32 {
    static constexpr bool PERM = false, AFTER_DRAIN = false;
    float* C; int ldc;
    __device__ __forceinline__ void operator()(const f32x4 (&acc)[2][2][4][2], const Unit& u, int wr, int wc, int fr, int fq) const {
        const int row0 = u.pm * BM + wr * 64 + fr, col0 = u.pn * BM + wc * 32 + 4 * fq;
#pragma unroll
        for (int ai = 0; ai < 2; ++ai)
#pragma unroll
            for (int m = 0; m < 4; ++m) { float* rowp = C + (size_t)(row0 + ai * HALF + m * 16) * ldc + col0;
#pragma unroll
                for (int bj = 0; bj < 2; ++bj)
#pragma unroll
                    for (int n = 0; n < 2; ++n) *(f32x4*)(rowp + bj * HALF + n * 16) = acc[ai][bj][m][n]; }
    }
};
struct EpiSwi {
    static constexpr bool PERM = true, AFTER_DRAIN = false;
    bf16_t* O; int ldc;
    __device__ __forceinline__ void operator()(const f32x4 (&acc)[2][2][4][2], const Unit& u, int wr, int wc, int fr, int fq) const {
        const int row0 = u.pm * BM + wr * 64 + fr, col0 = u.pn * HALF + wc * 32 + 8 * fq;
#pragma unroll
        for (int ai = 0; ai < 2; ++ai)
#pragma unroll
            for (int m = 0; m < 4; ++m) { bf16_t* rowp = O + (size_t)(row0 + ai * HALF + m * 16) * ldc + col0;
                f32x4 v0 = acc[ai][0][m][0], v1 = acc[ai][0][m][1]; const f32x4 u0 = acc[ai][1][m][0], u1 = acc[ai][1][m][1];
#pragma unroll
                for (int j = 0; j < 4; ++j) { v0[j] = v0[j] * sigmoidf_(v0[j]) * u0[j]; v1[j] = v1[j] * sigmoidf_(v1[j]) * u1[j]; }
                u32x4 w; w.x = cvt_pk_bf16(v0[0], v0[1]); w.y = cvt_pk_bf16(v0[2], v0[3]); w.z = cvt_pk_bf16(v1[0], v1[1]); w.w = cvt_pk_bf16(v1[2], v1[3]);
                *(u32x4*)(rowp) = w; }
    }
};

template <class Epi, class Sched, bool ALIGN_EPI = false, bool SP2 = false>
__device__ __forceinline__ void gemm_phase(PG8_LAS unsigned char* lds, const Gemm g, const Sched& S, const Epi& E, const int tid_in) {
    const int tid = tid_in, wid = __builtin_amdgcn_readfirstlane(tid >> 6), lane = tid & 63, wr = wid >> 2, wc = wid & 3, fr = lane & 15, fq = lane >> 4;
    const int K = g.K, nt = K / BK;
    unsigned voffA[2], voffB[2];
#pragma unroll
    for (int i = 0; i < 2; ++i) { int R, C; stage_rc(tid * 16 + i * 8192, R, C); const int Rb = Epi::PERM ? ((R & ~31) + perm32(R & 31)) : R;
        voffA[i] = (unsigned)(R * g.lda + C) * 2u; voffB[i] = (unsigned)(Rb * g.ldb + C) * 2u; }
    const size_t kstep = (size_t)(BK * 2);
    const size_t hstepA = (size_t)HALF * g.lda * 2, hstepB = (size_t)HALF * g.ldb * 2;
    const size_t tstepA = 2 * hstepA, tstepB = 2 * hstepB;
    const unsigned ldsw = (unsigned)wid * 1024u;
    const int aoff = lds_byte(wr * 64 + fr, fq * 8), boff = lds_byte(wc * 32 + fr, fq * 8);
#define PG8_SA(b, h) (((b) * 2 + (h)) * HTB)
#define PG8_SB(b, h) ((4 + (b) * 2 + (h)) * HTB)
#define PG8_STAGE(bufoff, gbase, voff) do { _Pragma("unroll") for (int _i = 0; _i < 2; ++_i) \
        __builtin_amdgcn_global_load_lds((const unsigned*)((const char*)(gbase) + (voff)[_i]), (PG8_LAS unsigned*)(lds + (bufoff) + ldsw + _i * 8192), 16, 0, 0); } while (0)
#define PG8_LDA(dst, b, h) do { _Pragma("unroll") for (int m = 0; m < 4; ++m) _Pragma("unroll") for (int k = 0; k < 2; ++k) dst[m][k] = *(const PG8_LAS bf16x8*)(lds + PG8_SA(b, h) + aoff + m * 2048 + k * 1024); } while (0)
#define PG8_LDB(dst, b, h) do { _Pragma("unroll") for (int n = 0; n < 2; ++n) _Pragma("unroll") for (int k = 0; k < 2; ++k) dst[n][k] = *(const PG8_LAS bf16x8*)(lds + PG8_SB(b, h) + boff + n * 2048 + k * 1024); } while (0)
#define PG8_MMA(ai, bj, At, Bt) do { __builtin_amdgcn_s_setprio(1); _Pragma("unroll") for (int m = 0; m < 4; ++m) _Pragma("unroll") for (int n = 0; n < 2; ++n) _Pragma("unroll") for (int k = 0; k < 2; ++k) \
        acc[ai][bj][m][n] = __builtin_amdgcn_mfma_f32_16x16x32_bf16(Bt[n][k], At[m][k], acc[ai][bj][m][n], 0, 0, 0); __builtin_amdgcn_s_setprio(0); } while (0)
#define PG8_WAIT_V(n) asm volatile("s_waitcnt vmcnt(" #n ")" ::: "memory")
#define PG8_WAIT_L(n) asm volatile("s_waitcnt lgkmcnt(" #n ")" ::: "memory")
#define PG8_BAR __builtin_amdgcn_s_barrier()
#define PG8_SCHED __builtin_amdgcn_sched_barrier(0)
    Unit cur, nxt; int ui = 0;
    if (!S.next(0, cur)) return;
    f32x4 acc[2][2][4][2];
#pragma unroll
    for (int a = 0; a < 2; ++a)
#pragma unroll
        for (int b = 0; b < 2; ++b)
#pragma unroll
            for (int m = 0; m < 4; ++m)
#pragma unroll
                for (int n = 0; n < 2; ++n) acc[a][b][m][n] = (f32x4){0.f, 0.f, 0.f, 0.f};
    bf16x8 At[4][2], B0[2][2], B1[2][2];
    const char* cA = (const char*)g.A + (size_t)cur.pm * tstepA; const char* cB = (const char*)g.Bt + (size_t)cur.pn * tstepB;
    S.a_ready(cur);
    if constexpr (SP2) {
        PG8_STAGE(PG8_SB(0, 0), cB, voffB); PG8_STAGE(PG8_SB(0, 1), cB + hstepB, voffB); PG8_STAGE(PG8_SA(0, 0), cA, voffA); PG8_STAGE(PG8_SA(0, 1), cA + hstepA, voffA);
        if (wr == 1) PG8_BAR;
        PG8_WAIT_V(2); PG8_BAR;
        PG8_STAGE(PG8_SB(1, 0), cB + kstep, voffB); PG8_STAGE(PG8_SA(1, 0), cA + kstep, voffA); PG8_STAGE(PG8_SB(1, 1), cB + hstepB + kstep, voffB);
        PG8_WAIT_V(6); PG8_BAR;
    } else {
        PG8_STAGE(PG8_SB(0, 0), cB, voffB); PG8_STAGE(PG8_SA(0, 0), cA, voffA); PG8_STAGE(PG8_SB(0, 1), cB + hstepB, voffB); PG8_STAGE(PG8_SA(0, 1), cA + hstepA, voffA);
        if (wr == 1) PG8_BAR;
        PG8_WAIT_V(4); PG8_BAR;
        PG8_STAGE(PG8_SB(1, 0), cB + kstep, voffB); PG8_STAGE(PG8_SA(1, 0), cA + kstep, voffA); PG8_STAGE(PG8_SB(1, 1), cB + hstepB + kstep, voffB);
        PG8_WAIT_V(6); PG8_BAR;
    }
    for (;;) {
        const bool has_next = S.next(ui + 1, nxt);
        const char* nA = has_next ? (const char*)g.A + (size_t)nxt.pm * tstepA : cA; const char* nB = has_next ? (const char*)g.Bt + (size_t)nxt.pn * tstepB : cB;
        for (int t = 0; t < nt; t += 2) {
            const bool last = (t == nt - 2);
            const char* a1 = cA + (size_t)(t + 1) * kstep;
            const char* a2 = last ? nA : cA + (size_t)(t + 2) * kstep; const char* b2 = last ? nB : cB + (size_t)(t + 2) * kstep;
            const char* a3 = a2 + kstep; const char* b3 = b2 + kstep;
            if (last && has_next) S.a_ready(nxt);
            if constexpr (SP2) {
            PG8_LDB(B0, 0, 0); PG8_LDB(B1, 0, 1); PG8_SCHED; PG8_LDA(At, 0, 0); PG8_STAGE(PG8_SA(1, 1), a1 + hstepA, voffA);
            PG8_WAIT_V(8); PG8_WAIT_L(0); PG8_BAR; PG8_MMA(0, 0, At, B0); PG8_MMA(0, 1, At, B1); PG8_BAR; PG8_SCHED;
            PG8_LDA(At, 0, 1); PG8_STAGE(PG8_SB(0, 0), b2, voffB); PG8_STAGE(PG8_SB(0, 1), b2 + hstepB, voffB); PG8_STAGE(PG8_SA(0, 0), a2, voffA);
            PG8_WAIT_V(8); PG8_WAIT_L(0); PG8_BAR; PG8_MMA(1, 0, At, B0); PG8_MMA(1, 1, At, B1); PG8_BAR; PG8_SCHED;
            PG8_LDB(B0, 1, 0); PG8_LDB(B1, 1, 1); PG8_SCHED; PG8_LDA(At, 1, 0); PG8_STAGE(PG8_SA(0, 1), a2 + hstepA, voffA);
            PG8_WAIT_V(8); PG8_WAIT_L(0); PG8_BAR; PG8_MMA(0, 0, At, B0); PG8_MMA(0, 1, At, B1); PG8_BAR; PG8_SCHED;
            PG8_LDA(At, 1, 1); PG8_STAGE(PG8_SB(1, 0), b3, voffB); PG8_STAGE(PG8_SB(1, 1), b3 + hstepB, voffB); PG8_STAGE(PG8_SA(1, 0), a3, voffA);
            PG8_WAIT_V(8); PG8_WAIT_L(0); PG8_BAR; PG8_MMA(1, 0, At, B0); PG8_MMA(1, 1, At, B1); PG8_BAR; PG8_SCHED;
            } else {
            PG8_LDB(B0, 0, 0); PG8_SCHED; PG8_LDA(At, 0, 0); PG8_STAGE(PG8_SA(1, 1), a1 + hstepA, voffA);
            PG8_WAIT_L(8); PG8_BAR; PG8_WAIT_L(0); PG8_MMA(0, 0, At, B0); PG8_BAR; PG8_SCHED;
            PG8_LDB(B1, 0, 1); PG8_STAGE(PG8_SB(0, 0), b2, voffB);
            PG8_BAR; PG8_WAIT_L(0); PG8_MMA(0, 1, At, B1); PG8_BAR;
            PG8_LDA(At, 0, 1); PG8_STAGE(PG8_SA(0, 0), a2, voffA);
            PG8_BAR; PG8_WAIT_L(0); PG8_MMA(1, 0, At, B0); PG8_BAR; PG8_SCHED;
            PG8_STAGE(PG8_SB(0, 1), b2 + hstepB, voffB);
            PG8_WAIT_V(6); PG8_BAR; PG8_MMA(1, 1, At, B1); PG8_BAR;
            PG8_LDB(B0, 1, 0); PG8_SCHED; PG8_LDA(At, 1, 0); PG8_STAGE(PG8_SA(0, 1), a2 + hstepA, voffA);
            PG8_WAIT_L(8); PG8_BAR; PG8_WAIT_L(0); PG8_MMA(0, 0, At, B0); PG8_BAR; PG8_SCHED;
            PG8_LDB(B1, 1, 1); PG8_STAGE(PG8_SB(1, 0), b3, voffB);
            PG8_BAR; PG8_WAIT_L(0); PG8_MMA(0, 1, At, B1); PG8_BAR;
            PG8_LDA(At, 1, 1); PG8_STAGE(PG8_SA(1, 0), a3, voffA);
            PG8_BAR; PG8_WAIT_L(0); PG8_MMA(1, 0, At, B0); PG8_BAR; PG8_SCHED;
            PG8_STAGE(PG8_SB(1, 1), b3 + hstepB, voffB);
            PG8_WAIT_V(6); PG8_BAR; PG8_MMA(1, 1, At, B1); PG8_BAR;
            }
        }
        if constexpr (ALIGN_EPI) { if (wr == 0) PG8_BAR; }
        if constexpr (!Epi::AFTER_DRAIN) { E(acc, cur, wr, wc, fr, fq); S.done(cur); }
        if (!has_next) break;
#pragma unroll
        for (int a = 0; a < 2; ++a)
#pragma unroll
            for (int b = 0; b < 2; ++b)
#pragma unroll
                for (int m = 0; m < 4; ++m)
#pragma unroll
                    for (int n = 0; n < 2; ++n) acc[a][b][m][n] = (f32x4){0.f, 0.f, 0.f, 0.f};
        cur = nxt; cA = nA; cB = nB; ++ui;
        if constexpr (ALIGN_EPI) { if (wr == 1) PG8_BAR; }
    }
    PG8_WAIT_V(0);
    if constexpr (!ALIGN_EPI) { if (wr == 0) PG8_BAR; }
    PG8_BAR;
    if constexpr (Epi::AFTER_DRAIN) { E.fused(acc, cur, wr, wc, fr, fq, lds, wid, lane); S.done(cur); }
#undef PG8_SA
#undef PG8_SB
#undef PG8_STAGE
#undef PG8_LDA
#undef PG8_LDB
#undef PG8_MMA
#undef PG8_WAIT_V
#undef PG8_WAIT_L
#undef PG8_BAR
#undef PG8_SCHED
}
}

#include <hip/hip_bf16.h>
#include <cmath>
namespace attn_body {
using bf16=__hip_bfloat16;
using bf16x8=__attribute__((ext_vector_type(8)))short;
using s16x4=__attribute__((ext_vector_type(4)))short;
using f32x16=__attribute__((ext_vector_type(16)))float;
using u32x4=__attribute__((ext_vector_type(4)))unsigned;
constexpr int BATCH=2,SEQ=8192,D=64;
constexpr int NW=8,QBLK=32,QB=QBLK*NW,KVBLK=64,NQB=SEQ/QB;
constexpr int ATTN_UNIT_ROWS=QB;
__device__ __forceinline__ int crow(int r,int hi){return (r&3)+8*(r>>2)+4*hi;}
#define SBAR() __builtin_amdgcn_sched_barrier(0)
__device__ __forceinline__ void cmask(f32x16&p0,f32x16&p1,int jb,int qrel,int hi){
  const float NEG=-INFINITY; int kb=64*jb+4*hi;
  #pragma unroll
  for(int r=0;r<16;++r){int kv=kb+(r&3)+8*(r>>2); if(kv>qrel)p0[r]=NEG; if(kv+32>qrel)p1[r]=NEG;}
}

constexpr int NSLOT=3, SLOTB=8192;
constexpr int LDS_K=0, LDS_V=NSLOT*SLOTB, LDS_WS=2*NSLOT*SLOTB, LDS_OST=LDS_WS+NW*64*4, LDS_BYTES=LDS_OST+NW*4096, LDS_CF=LDS_BYTES, LDS_TOTAL=LDS_CF+32768;
constexpr float C2=0.125f*1.4426950408889634f;
__device__ __forceinline__ void glds16(const void*gsrc,unsigned lds_dst){unsigned keep;
  asm volatile("s_mov_b32 %0, m0\n\ts_mov_b32 m0, %2\n\ts_nop 0\n\tglobal_load_lds_dwordx4 %1, off\n\ts_mov_b32 m0, %0":"=&s"(keep):"v"(gsrc),"s"(lds_dst):"memory");}
__device__ __forceinline__ float max3f(float a,float b,float c){float r;asm("v_max3_f32 %0, %1, %2, %3":"=v"(r):"v"(a),"v"(b),"v"(c));return r;}
__device__ __forceinline__ float max2f(float a,float b){float r;asm("v_max_f32_e32 %0, %1, %2":"=v"(r):"v"(a),"v"(b));return r;}
__device__ __forceinline__ float fadd_s(float a,float b){float r;asm("v_add_f32_e32 %0, %1, %2":"=v"(r):"v"(a),"v"(b));return r;}
__device__ __forceinline__ float fsub_s(float a,float b){float r;asm("v_sub_f32_e32 %0, %1, %2":"=v"(r):"v"(a),"v"(b));return r;}
typedef float f32x2_t __attribute__((ext_vector_type(2))); typedef __bf16 bf16x2_t __attribute__((ext_vector_type(2)));
__device__ __forceinline__ unsigned cvtpk_s(float lo,float hi){f32x2_t v={lo,hi};bf16x2_t b=__builtin_convertvector(v,bf16x2_t);return __builtin_bit_cast(unsigned,b);}
#define WAIT_BAR(N) asm volatile("s_waitcnt vmcnt(" #N ") lgkmcnt(0)\n\ts_barrier":::"memory")

__device__ __forceinline__ void qkt(f32x16&p0,f32x16&p1,const char*Kslot,const bf16x8*qr,int r32,int hi){ const f32x16 negm=f32x16{};
  const char*kb=Kslot+hi*1024+r32*16;
  #pragma unroll
  for(int d0=0;d0<4;++d0){
    const bf16x8 b0=*reinterpret_cast<const bf16x8*>(kb+d0*2048);
    const bf16x8 b1=*reinterpret_cast<const bf16x8*>(kb+d0*2048+512);
    if(d0==0){p0=__builtin_amdgcn_mfma_f32_32x32x16_bf16(b0,qr[0],negm,0,0,0);p1=__builtin_amdgcn_mfma_f32_32x32x16_bf16(b1,qr[0],negm,0,0,0);}
    else{p0=__builtin_amdgcn_mfma_f32_32x32x16_bf16(b0,qr[d0],p0,0,0,0);p1=__builtin_amdgcn_mfma_f32_32x32x16_bf16(b1,qr[d0],p1,0,0,0);}}
}
typedef __attribute__((address_space(3))) const char* lds_cptr;
typedef short v4i16_t __attribute__((ext_vector_type(4)));
__device__ __forceinline__ void kload8(bf16x8*kf,lds_cptr kp){
  kf[0]=*(const __attribute__((address_space(3))) bf16x8*)(kp);      kf[1]=*(const __attribute__((address_space(3))) bf16x8*)(kp+512);
  kf[2]=*(const __attribute__((address_space(3))) bf16x8*)(kp+2048); kf[3]=*(const __attribute__((address_space(3))) bf16x8*)(kp+2560);
  kf[4]=*(const __attribute__((address_space(3))) bf16x8*)(kp+4096); kf[5]=*(const __attribute__((address_space(3))) bf16x8*)(kp+4608);
  kf[6]=*(const __attribute__((address_space(3))) bf16x8*)(kp+6144); kf[7]=*(const __attribute__((address_space(3))) bf16x8*)(kp+6656);
}
__device__ __forceinline__ void kload2(bf16x8*kf,lds_cptr kp,int j){ kf[2*j]=*(const __attribute__((address_space(3))) bf16x8*)(kp+j*2048); kf[2*j+1]=*(const __attribute__((address_space(3))) bf16x8*)(kp+j*2048+512); }
__device__ __forceinline__ s16x4 vtr(lds_cptr p){ return __builtin_bit_cast(s16x4,__builtin_amdgcn_ds_read_tr16_b64_v4i16((__attribute__((address_space(3))) v4i16_t*)p)); }
__device__ __forceinline__ float rowmax(const f32x16&p0,const f32x16&p1){
  float a=max3f(p0[0],p0[1],p1[0]),b=max3f(p0[2],p0[3],p1[1]);a=max3f(a,p1[2],p1[3]);
  #pragma unroll
  for(int r=4;r<16;r+=4){a=max3f(a,p0[r],p0[r+1]);b=max3f(b,p0[r+2],p0[r+3]);a=max3f(a,p1[r],p1[r+1]);b=max3f(b,p1[r+2],p1[r+3]);}
  const float m=max2f(a,b);
  auto rr=__builtin_amdgcn_permlane32_swap(__float_as_uint(m),__float_as_uint(m),false,false);
  return max2f(__uint_as_float(rr[0]),__uint_as_float(rr[1]));
}
__device__ __forceinline__ void pv(f32x16*o,int vb,bf16x8 pa0,bf16x8 pa1,bf16x8 pa2,bf16x8 pa3){
  #pragma unroll
  for(int d0=0;d0<2;++d0){s16x4 lo[4],hi[4];
    #pragma unroll
    for(int ks=0;ks<4;++ks){
      asm volatile("ds_read_b64_tr_b16 %0,%1 offset:%c2":"=&v"(lo[ks]):"v"(vb),"i"(d0*4096+ks*1024):"memory");
      asm volatile("ds_read_b64_tr_b16 %0,%1 offset:%c2":"=&v"(hi[ks]):"v"(vb),"i"(d0*4096+ks*1024+512):"memory");}
    asm volatile("s_waitcnt lgkmcnt(0)":::"memory");SBAR();
    #define PK(k) (bf16x8){lo[k][0],lo[k][1],lo[k][2],lo[k][3],hi[k][0],hi[k][1],hi[k][2],hi[k][3]}
    o[d0]=__builtin_amdgcn_mfma_f32_32x32x16_bf16(pa0,PK(0),o[d0],0,0,0);
    o[d0]=__builtin_amdgcn_mfma_f32_32x32x16_bf16(pa1,PK(1),o[d0],0,0,0);
    o[d0]=__builtin_amdgcn_mfma_f32_32x32x16_bf16(pa2,PK(2),o[d0],0,0,0);
    o[d0]=__builtin_amdgcn_mfma_f32_32x32x16_bf16(pa3,PK(3),o[d0],0,0,0);
    #undef PK
  }
}


typedef __attribute__((address_space(3))) const float* lds_cfptr;
typedef float f32x4m __attribute__((ext_vector_type(4)));
template<int MODE,bool BAND> __device__ __forceinline__ void tile_mask(f32x16&p0,f32x16&p1,int t,int NT,int qrel,int hi,lds_cfptr cfl,unsigned selw,unsigned long long mw,float nref){
  const float NEG=-INFINITY;
  const int jb=t-(NT-4); const int dq=qrel-((BAND && jb>=0)?(64*jb+4*hi):-(1<<20));
  if constexpr(MODE==0){
    const __attribute__((address_space(3))) f32x4m* c4=(const __attribute__((address_space(3))) f32x4m*)(cfl+64*t+4*hi);
    #pragma unroll
    for(int g=0;g<4;++g){ const f32x4m a=c4[2*g], bq=c4[8+2*g];
      #pragma unroll
      for(int j=0;j<4;++j){ const int kc=j+8*g; const float v0=(p0[4*g+j]+nref)-a[j], v1=(p1[4*g+j]+nref)-bq[j];
        if constexpr(BAND){ p0[4*g+j]=(kc>dq)?NEG:v0; p1[4*g+j]=(kc+32>dq)?NEG:v1; } else { p0[4*g+j]=v0; p1[4*g+j]=v1; } }
      __builtin_amdgcn_sched_barrier(0); }
  }
  if constexpr(MODE==1 || MODE==3){
    float rf=nref;
    if constexpr(MODE==1){ const bool band=BAND && jb>=0; rf=(band || ((selw>>(t>>2))&1u)) ? nref : NEG; }
    #pragma unroll
    for(int r=0;r<16;++r){ const int kc=(r&3)+8*(r>>2);
      if constexpr(BAND){ p0[r]=(kc>dq)?NEG:p0[r]+rf; p1[r]=(kc+32>dq)?NEG:p1[r]+rf; } else { p0[r]+=rf; p1[r]+=rf; } }
  }
  if constexpr(MODE==2){
    const unsigned lo=(unsigned)mw>>(4*hi), hw=(unsigned)(mw>>32)>>(4*hi);
    #pragma unroll
    for(int r=0;r<16;++r){ const int sh=(r&3)+8*(r>>2); p0[r]=((lo>>sh)&1u)?p0[r]+nref:NEG; p1[r]=((hw>>sh)&1u)?p1[r]+nref:NEG; }
  }
}
#ifndef ATTN_STORE16
#define ATTN_STORE16(p,v) (*(u32x4*)(p)=(v))
#endif
template<int THRL,int MODE,int DM,int ODM> __device__ __forceinline__ void attn_unit(int b,int h,int qb,const bf16*Q,const bf16*__restrict__ K,const bf16*__restrict__ V,bf16*O,char*shm,const void*aux,const int tid_in){
  const int tid=tid_in,lane=tid&63,r32=lane&31,hi=lane>>5; const int wid=__builtin_amdgcn_readfirstlane(tid>>6);
  const long rowbase=(long)b*SEQ; const int q0=qb*QB;
  const bf16*Qw=Q+(rowbase+q0+wid*QBLK)*DM+h*D;
  const bf16*Kh=K+rowbase*DM+h*D,*Vh=V+rowbase*DM+h*D;
  const unsigned lds0=(unsigned)(uintptr_t)shm;
  float*wsf=(float*)(shm+LDS_WS)+wid*64;
  const bf16*ksrc=Kh+(long)lane*DM+wid*8;
  const bf16*vsrc=Vh+(long)(16*(wid&3)+(lane>>2))*DM+(wid>>2)*32+(lane&3)*8;
  const unsigned kdst=lds0+LDS_K+wid*1024, vdst=lds0+LDS_V+wid*1024;
  #define DMA_K(t,slot) glds16(ksrc+(long)(t)*KVBLK*DM,(unsigned)__builtin_amdgcn_readfirstlane(kdst+(slot)))
  #define DMA_V(t,slot) glds16(vsrc+(long)(t)*KVBLK*DM,(unsigned)__builtin_amdgcn_readfirstlane(vdst+(slot)))
  const int vb0=(int)(lds0+LDS_V)+((lane>>4)&1)*32+(lane&3)*8+(4*hi+((lane&15)>>2))*64;
  const char*Kbase=shm+LDS_K; bf16x8 kf[8];
  const lds_cptr shm3=(lds_cptr)shm; const lds_cptr kp0=shm3+LDS_K+hi*1024+r32*16; const lds_cptr vp0=shm3+LDS_V+((lane>>4)&1)*32+(lane&3)*8+(4*hi+((lane&15)>>2))*64;
  const int NT=(q0+QB)/KVBLK;
  DMA_K(0,0);DMA_V(0,0);DMA_K(1,SLOTB);
  bf16x8 qr[4];
  #pragma unroll
  for(int d0=0;d0<4;++d0)qr[d0]=*reinterpret_cast<const bf16x8*>(&Qw[(long)r32*DM+d0*16+hi*8]);
  const int qrel=wid*QBLK+r32;
  float cfq2=0.f; unsigned selw=0u; const unsigned long long*mrow=nullptr; unsigned long long mw_cur=0ull,mw_nxt=0ull;
  const lds_cfptr cfl3=(lds_cfptr)(shm+LDS_CF);
  if constexpr(MODE==0){ const float*cf=(const float*)aux+((long)b*8+h)*SEQ; cfq2=cf[q0+qrel];
    __attribute__((address_space(3))) f32x4m* cw=(__attribute__((address_space(3))) f32x4m*)(shm+LDS_CF);
    for(int i=tid;i<(q0+QB)/4;i+=NW*64) cw[i]=((const f32x4m*)cf)[i]; }
  if constexpr(MODE==1){ selw=((const unsigned*)aux)[(rowbase+q0+qrel)*8+h]; }
  if constexpr(MODE==2){ mrow=(const unsigned long long*)aux+(long)b*128*SEQ+q0+qrel; mw_cur=mrow[0]; mw_nxt=mrow[SEQ]; }
  float mhat=0.f,l_reg=0.f;f32x16 o[2];o[0]=f32x16{};o[1]=f32x16{};float nref=cfq2; const f32x16 ZC=f32x16{};
  #define CMASK(P0,P1,t) tile_mask<MODE,true>(P0,P1,(t),NT,qrel,hi,cfl3,selw,mw_cur,nref)
  bool resc=false;
  #define START(P0,P1) do{ const float rm=max2f(rowmax(P0,P1),-100.f); resc=false; \
    { const float dl=rm; mhat=fadd_s(mhat,dl); \
      _Pragma("unroll") for(int r=0;r<16;++r){P0[r]=fsub_s(P0[r],dl);P1[r]=fsub_s(P1[r],dl);} \
      nref=cfq2-mhat; } \
    _Pragma("unroll") for(int r=0;r<16;++r)P0[r]=__builtin_amdgcn_exp2f(P0[r]); }while(0)
  #define RESC() do{ if(resc){ asm volatile("s_waitcnt lgkmcnt(0)":::"memory"); \
      _Pragma("unroll") for(int d_=0;d_<2;++d_) _Pragma("unroll") for(int r=0;r<16;++r)o[d_][r]*=wsf[crow(r,hi)]; } }while(0)
  f32x16 pA0,pA1,pB0,pB1;
  int sl_prev=0,sl_cur=0,sl_next=SLOTB;
  #define ROT() do{sl_prev=sl_cur;sl_cur=sl_next;sl_next=(sl_next==(NSLOT-1)*SLOTB)?0:sl_next+SLOTB; if constexpr(MODE==2){ mw_cur=mw_nxt; asm volatile("":"+v"(mw_cur)); } }while(0)
  DMA_K(2,2*SLOTB);
  WAIT_BAR(3);
  qkt(pA0,pA1,Kbase,qr,r32,hi);asm volatile("s_nop 15\n\ts_nop 7":"+v"(pA0),"+v"(pA1));CMASK(pA0,pA1,0);
  START(pA0,pA1);
  _Pragma("unroll") for(int r=0;r<16;++r)pA1[r]=__builtin_amdgcn_exp2f(pA1[r]);
  WAIT_BAR(0);
  DMA_K(3,0);DMA_V(1,SLOTB);
  ROT();
  kload8(kf,kp0+sl_cur);
  WAIT_BAR(2);
  s16x4 vlo[8],vhi[8]; u32x4 pw0,pw1,pw2,pw3;
  #define PKW(P,B) cvtpk_s(P[B],P[B+1])
  #define PAF(k) __builtin_bit_cast(bf16x8,pw##k)
  #define VFR(i) (bf16x8){vlo[i][0],vlo[i][1],vlo[i][2],vlo[i][3],vhi[i][0],vhi[i][1],vhi[i][2],vhi[i][3]}
  #define PIN(x) asm volatile("":"+v"(x))
  #define MX3(a,b,c) __builtin_fmaxf(__builtin_fmaxf((a),(b)),(c))
  #define GAPA(MF,A0,A1,A2,A3,W0,W1,PW) do{ MF; sacc+=A0; sacc+=A1; sacc+=A2; sacc+=A3; PIN(sacc); W0; W1; PIN(PW); SBAR(); }while(0)
  #define EX(v) __builtin_amdgcn_exp2f(v)
  #define GAPB(MF,X,B) do{ MF; X[B]=EX(X[B]); X[B+1]=EX(X[B+1]); X[B+2]=EX(X[B+2]); X[B+3]=EX(X[B+3]); PIN(X); SBAR(); }while(0)
  #define VRD(i) do{ vlo[i]=vtr(vp_+(((i)>>2)*4096+((i)&3)*1024)); vhi[i]=vtr(vp_+(((i)>>2)*4096+((i)&3)*1024+512)); }while(0)
  #define KRD(G,j) do{ if(G){ kload2(kf,kp0+sl_next,j); SBAR(); } }while(0)
  #define STEP(C0,C1,P0,P1,t,GK,GV,GL) do{ SBAR(); if constexpr(MODE==2){ if((t)+1<NT) mw_nxt=mrow[(long)((t)+1)*SEQ]; } \
    const lds_cptr vp_=vp0+sl_prev; \
    VRD(0); SBAR(); float sacc=(P0[0]+P0[1]); \
    GAPA(C0=__builtin_amdgcn_mfma_f32_32x32x16_bf16(kf[0],qr[0],ZC,0,0,0), P0[2],P0[3],P0[4],P0[5],     pw0[0]=PKW(P0,0), pw0[1]=PKW(P0,2), pw0); \
    VRD(4); SBAR(); GAPA(C1=__builtin_amdgcn_mfma_f32_32x32x16_bf16(kf[1],qr[0],ZC,0,0,0), P0[6],P0[7],P0[8],P0[9],     pw0[2]=PKW(P0,4), pw0[3]=PKW(P0,6), pw0); \
    VRD(1); SBAR(); GAPA(C0=__builtin_amdgcn_mfma_f32_32x32x16_bf16(kf[2],qr[1],C0,0,0,0),   P0[10],P0[11],P0[12],P0[13], pw1[0]=PKW(P0,8), pw1[1]=PKW(P0,10), pw1); \
    VRD(5); SBAR(); GAPA(C1=__builtin_amdgcn_mfma_f32_32x32x16_bf16(kf[3],qr[1],C1,0,0,0),   P0[14],P0[15],P1[0],P1[1],   pw1[2]=PKW(P0,12),pw1[3]=PKW(P0,14), pw1); \
    VRD(2); SBAR(); GAPA(C0=__builtin_amdgcn_mfma_f32_32x32x16_bf16(kf[4],qr[2],C0,0,0,0),   P1[2],P1[3],P1[4],P1[5],     pw2[0]=PKW(P1,0), pw2[1]=PKW(P1,2), pw2); \
    VRD(6); SBAR(); GAPA(C1=__builtin_amdgcn_mfma_f32_32x32x16_bf16(kf[5],qr[2],C1,0,0,0),   P1[6],P1[7],P1[8],P1[9],     pw2[2]=PKW(P1,4), pw2[3]=PKW(P1,6), pw2); \
    VRD(3); SBAR(); GAPA(C0=__builtin_amdgcn_mfma_f32_32x32x16_bf16(kf[6],qr[3],C0,0,0,0),   P1[10],P1[11],P1[12],P1[13], pw3[0]=PKW(P1,8), pw3[1]=PKW(P1,10), pw3); \
    VRD(7); SBAR(); GAPA(C1=__builtin_amdgcn_mfma_f32_32x32x16_bf16(kf[7],qr[3],C1,0,0,0),   P1[14],P1[15],0.f,0.f,       pw3[2]=PKW(P1,12),pw3[3]=PKW(P1,14), pw3); \
    l_reg+=sacc; \
    if(GK){DMA_K((t)+3,sl_cur);} if(GV){DMA_V((t)+1,sl_next);} \
    CMASK(C0,C1,t); \
    { float a=MX3(C0[0],C0[1],C1[0]),b=MX3(C0[2],C0[3],C1[1]); a=MX3(a,C1[2],C1[3]); \
      _Pragma("unroll") for(int r=4;r<16;r+=4){a=MX3(a,C0[r],C0[r+1]);b=MX3(b,C0[r+2],C0[r+3]);a=MX3(a,C1[r],C1[r+1]);b=MX3(b,C1[r+2],C1[r+3]);} \
      float rm=__builtin_fmaxf(a,b); { auto rr=__builtin_amdgcn_permlane32_swap(__float_as_uint(rm),__float_as_uint(rm),false,false); rm=__builtin_fmaxf(__uint_as_float(rr[0]),__uint_as_float(rr[1])); } \
      resc=false; \
      if(__builtin_expect(__any(rm>(float)THRL),0)){ const float dl=__builtin_fmaxf(rm,0.f); mhat+=dl; \
        _Pragma("unroll") for(int r=0;r<16;++r){C0[r]-=dl;C1[r]-=dl;} \
        nref=cfq2-mhat; \
        const float f=__builtin_amdgcn_exp2f(-dl); l_reg*=f; if(hi==0)wsf[r32]=f; resc=true; } } \
    SBAR(); \
    GAPB(o[0]=__builtin_amdgcn_mfma_f32_32x32x16_bf16(PAF(0),VFR(0),o[0],0,0,0), C0,0); \
    GAPB(o[1]=__builtin_amdgcn_mfma_f32_32x32x16_bf16(PAF(0),VFR(4),o[1],0,0,0), C0,4); \
    KRD(GL,0); GAPB(o[0]=__builtin_amdgcn_mfma_f32_32x32x16_bf16(PAF(1),VFR(1),o[0],0,0,0), C0,8); \
    KRD(GL,1); GAPB(o[1]=__builtin_amdgcn_mfma_f32_32x32x16_bf16(PAF(1),VFR(5),o[1],0,0,0), C0,12); \
    KRD(GL,2); GAPB(o[0]=__builtin_amdgcn_mfma_f32_32x32x16_bf16(PAF(2),VFR(2),o[0],0,0,0), C1,0); \
    KRD(GL,3); GAPB(o[1]=__builtin_amdgcn_mfma_f32_32x32x16_bf16(PAF(2),VFR(6),o[1],0,0,0), C1,4); \
    GAPB(o[0]=__builtin_amdgcn_mfma_f32_32x32x16_bf16(PAF(3),VFR(3),o[0],0,0,0), C1,8); \
    GAPB(o[1]=__builtin_amdgcn_mfma_f32_32x32x16_bf16(PAF(3),VFR(7),o[1],0,0,0), C1,12); \
    }while(0)
  int t=1;
  #undef CMASK
  #define CMASK(P0,P1,t) tile_mask<MODE,false>(P0,P1,(t),NT,qrel,hi,cfl3,selw,mw_cur,nref)
  for(;t+5<NT;t+=2){
    STEP(pB0,pB1,pA0,pA1,t,true,true,true);     WAIT_BAR(2); RESC(); ROT();
    STEP(pA0,pA1,pB0,pB1,t+1,true,true,true);   WAIT_BAR(2); RESC(); ROT();
  }
  #undef CMASK
  #define CMASK(P0,P1,t) tile_mask<MODE,true>(P0,P1,(t),NT,qrel,hi,cfl3,selw,mw_cur,nref)
  #define ENDW(tt) do{ if((tt)+3<NT){WAIT_BAR(2);} else if((tt)+2<NT){WAIT_BAR(1);} else {WAIT_BAR(0);} }while(0)
  for(;t+1<NT;t+=2){
    STEP(pB0,pB1,pA0,pA1,t,(t+3<NT),(t+1<NT),(t+1<NT));       ENDW(t);   RESC(); ROT();
    STEP(pA0,pA1,pB0,pB1,t+1,(t+4<NT),(t+2<NT),(t+2<NT));     ENDW(t+1); RESC(); ROT();
  }
  STEP(pB0,pB1,pA0,pA1,NT-1,false,false,false); RESC();
  { float sacc=pB0[0]+pB0[1]; _Pragma("unroll") for(int r=2;r<16;++r)sacc+=pB0[r]; _Pragma("unroll") for(int r=0;r<16;++r)sacc+=pB1[r]; l_reg+=sacc;
    pw0=(u32x4){PKW(pB0,0),PKW(pB0,2),PKW(pB0,4),PKW(pB0,6)};pw1=(u32x4){PKW(pB0,8),PKW(pB0,10),PKW(pB0,12),PKW(pB0,14)};pw2=(u32x4){PKW(pB1,0),PKW(pB1,2),PKW(pB1,4),PKW(pB1,6)};pw3=(u32x4){PKW(pB1,8),PKW(pB1,10),PKW(pB1,12),PKW(pB1,14)};
    SBAR(); pv(o,vb0+sl_cur,PAF(0),PAF(1),PAF(2),PAF(3)); }
  #undef PKW
  #undef PAF
  #undef VFR
  #undef PIN
  #undef MX3
  #undef GAPA
  #undef GAPB
  #undef EX
  #undef VRD
  #undef KRD
  #undef STEP
  #undef ENDW
  {auto rr=__builtin_amdgcn_permlane32_swap(__float_as_uint(l_reg),__float_as_uint(l_reg),false,false);l_reg=__uint_as_float(rr[0])+__uint_as_float(rr[1]);}
  if(hi==0)wsf[32+r32]=l_reg;asm volatile("s_waitcnt lgkmcnt(0)":::"memory");
  float rli[16];
  #pragma unroll
  for(int r=0;r<16;++r)rli[r]=__builtin_amdgcn_rcpf(wsf[32+crow(r,hi)]);
  bf16*Ow=O+(rowbase+q0+wid*QBLK)*ODM+h*D;
  { bf16*stg=(bf16*)(shm+LDS_OST)+wid*2048;
    #pragma unroll
    for(int r=0;r<16;++r){const int orow=crow(r,hi);
      #pragma unroll
      for(int d0=0;d0<2;++d0)stg[orow*64+d0*32+r32]=__float2bfloat16(o[d0][r]*rli[r]);}
    asm volatile("s_waitcnt lgkmcnt(0)":::"memory");
    #pragma unroll
    for(int i=0;i<4;++i){const int row=i*8+(lane>>3),ch=lane&7; const u32x4 v=*(const u32x4*)(stg+row*64+ch*8); ATTN_STORE16(Ow+(long)row*ODM+ch*8,v);} }
  asm volatile("s_waitcnt lgkmcnt(0)\n\ts_barrier":::"memory");
  #undef DMA_K
  #undef DMA_V
  #undef CMASK
  #undef START
  #undef RESC
  #undef ROT
}
constexpr int ATTN_LDS_BYTES=LDS_TOTAL;
#undef SBAR
#undef WAIT_BAR
}
#define GAS __attribute__((address_space(1)))
#define LAS __attribute__((address_space(3)))
typedef unsigned short bf16;
typedef unsigned v4u __attribute__((ext_vector_type(4)));
typedef float f32x4 __attribute__((ext_vector_type(4)));
typedef short bf16x8 __attribute__((ext_vector_type(8)));
typedef GAS unsigned gu32;
typedef GAS unsigned long long gu64;
#define RLX_AGENT __ATOMIC_RELAXED, __HIP_MEMORY_SCOPE_AGENT
#define LDS_WAIT() asm volatile("s_waitcnt lgkmcnt(0)" ::: "memory")
#define VM_WAIT() asm volatile("s_waitcnt vmcnt(0)" ::: "memory")
__device__ __forceinline__ unsigned long long rt() { return __builtin_amdgcn_s_memrealtime(); }
__device__ __forceinline__ unsigned f2bf(float f) { unsigned u = __builtin_bit_cast(unsigned, f); return (u + 0x7fffu + ((u >> 16) & 1u)) >> 16; }
__device__ __forceinline__ unsigned pk2(float lo, float hi) { return f2bf(lo) | (f2bf(hi) << 16); }

#define XB_TMO      128
#define XB_XCNT(j)  (256  + 64 * (j))
#define XB_XSUB(j)  (1280 + 64 * (j))
#define XB_XGEN(j)  (2304 + 64 * (j))
#define XB_TOP      3328
#define XB_TOPGEN   3392
#define XCD_BAR_WORDS 3456
#define XB_SPIN_CAP (1u << 18)

__device__ __forceinline__ unsigned xb_ld(unsigned* p)              { return __hip_atomic_load(p, __ATOMIC_RELAXED, __HIP_MEMORY_SCOPE_AGENT); }
__device__ __forceinline__ unsigned xb_add(unsigned* p, unsigned v) { return __hip_atomic_fetch_add(p, v, __ATOMIC_RELAXED, __HIP_MEMORY_SCOPE_AGENT); }
__device__ __forceinline__ unsigned xb_xcc_id() { return (unsigned)__builtin_amdgcn_s_getreg((3 << 11) | 20) & 0xFu; }
#define XB_SPIN(cond, bar) do { unsigned _sp = 0; while (cond) { __builtin_amdgcn_s_sleep(1); \
    if ((++_sp & 255u) == 0u) { if (xb_ld(&(bar)[XB_TMO])) break; if (_sp > XB_SPIN_CAP) { atomicAdd(&(bar)[XB_TMO], 1u); break; } } } } while (0)

struct XcdBarrier {
    unsigned* bar; unsigned x;
    volatile LAS unsigned* st;
};

__device__ __forceinline__ XcdBarrier xcd_barrier_post(unsigned* bar, volatile LAS unsigned* st) {
    XcdBarrier b; b.bar = bar; b.x = xb_xcc_id(); b.st = st;
    if (threadIdx.x == 0) (void)xb_add(&bar[XB_XCNT(b.x)], 1u);
    return b;
}
__device__ __forceinline__ void xcd_barrier_complete(unsigned* bar, unsigned x, unsigned& nloc, unsigned& nx) {
    const unsigned G = gridDim.x * gridDim.y * gridDim.z;
    unsigned sum, cnt, mine, sp = 0u;
    for (;;) {
        sum = 0u; cnt = 0u; mine = 0u;
#pragma unroll
        for (unsigned j = 0; j < 16; ++j) { const unsigned c = xb_ld(&bar[XB_XCNT(j)]); sum += c; cnt += (c > 0u) ? 1u : 0u; mine = (j == x) ? c : mine; }
        if (sum == G) break;
        __builtin_amdgcn_s_sleep(1);
        if ((++sp & 255u) == 0u) { if (xb_ld(&bar[XB_TMO])) break; if (sp > XB_SPIN_CAP) { atomicAdd(&bar[XB_TMO], 1u); break; } }
    }
    nloc = mine > 0u ? mine : 1u; nx = cnt > 0u ? cnt : 1u;
}

__device__ __forceinline__ void xcd_barrier(const XcdBarrier& b) {
    asm volatile("s_waitcnt vmcnt(0)" ::: "memory");
    __syncthreads();
    if (threadIdx.x == 0) {
        unsigned* bar = b.bar;
        __builtin_amdgcn_s_waitcnt(0);
        unsigned nloc = b.st[0], nx = b.st[1];
        if (nloc == 0u) { xcd_barrier_complete(bar, b.x, nloc, nx); b.st[0] = nloc; b.st[1] = nx; }
        const unsigned old = xb_add(&bar[XB_XSUB(b.x)], 1u);
        const unsigned gen = old / nloc;
        if (old + 1u == (gen + 1u) * nloc) {
            __builtin_amdgcn_fence(__ATOMIC_RELEASE, "agent");
            asm volatile("s_waitcnt vmcnt(0)" ::: "memory");
            const unsigned og = xb_add(&bar[XB_TOP], 1u);
            const unsigned tg = og / nx;
            if (og + 1u == (tg + 1u) * nx) xb_add(&bar[XB_TOPGEN], 1u);
            else XB_SPIN(xb_ld(&bar[XB_TOPGEN]) == tg, bar);
            __builtin_amdgcn_fence(__ATOMIC_ACQUIRE, "agent");
            xb_add(&bar[XB_XGEN(b.x)], 1u);
            asm volatile("s_waitcnt vmcnt(0)" ::: "memory");
        } else {
            XB_SPIN(xb_ld(&bar[XB_XGEN(b.x)]) == gen, bar);
            __builtin_amdgcn_fence(__ATOMIC_ACQUIRE, "agent");
            asm volatile("s_waitcnt vmcnt(0)" ::: "memory");
        }
    }
    __syncthreads();
}

constexpr int NWAVES = 8, NTHR = 512;
constexpr int NB = 2, SEQ = 8192, T = NB * SEQ, DMODEL = 1024, FFH = 2816;
constexpr int UB_P = 3328, UA_P = 3072;
constexpr int NWIN = 6656, NWIN_B = 3584, NWIN_A = 3072;
constexpr float EPS = 1e-6f;
constexpr float LOG2E = 1.4426950408889634f;
constexpr float C2 = 0.125f * 1.4426950408889634f;
constexpr size_t MiB = 1u << 20;
constexpr size_t WS_CTL = 0, CTL_ZERO_BYTES = 1 * MiB;
constexpr size_t WS_ROPEC = 1 * MiB, WS_ROPES = 2 * MiB;
constexpr size_t WS_CF2 = 3 * MiB, WS_ACS = WS_CF2 + 512 * 1024, WS_DTA = WS_ACS + 512 * 1024;
constexpr size_t WS_SELM = WS_DTA + 512 * 1024, WS_KPART = WS_SELM + 512 * 1024, WS_IKB = WS_KPART + 512 * 1024;
constexpr size_t WS_WIN = 8 * MiB;
constexpr size_t WS_WG = 8 * MiB, WS_WB = 16 * MiB;
constexpr size_t WS_H = 24 * MiB;
constexpr size_t WS_Y = 56 * MiB;
constexpr size_t WS_U = 120 * MiB;
constexpr size_t WS_XT = 216 * MiB;
constexpr size_t WS_MASK = 232 * MiB;
constexpr size_t WS_BC = 232 * MiB, WS_CC = 240 * MiB;
constexpr size_t WS_MISC = 248 * MiB;
constexpr size_t WS_STATE = WS_Y;
constexpr size_t WS_BT = WS_Y + 16 * MiB, WS_PREV = WS_Y + 24 * MiB;
constexpr size_t WS_G = 120 * MiB, WS_MG = 152 * MiB;
constexpr size_t WS_W2B = 232 * MiB;
constexpr size_t WS_WO = WS_W2B, WS_WF1 = WS_W2B + 2 * MiB, WS_WF2 = WS_W2B + 13 * MiB;
constexpr size_t WS_HP = 56 * MiB;
constexpr size_t WS_END = 256 * MiB;
static_assert(WS_IKB + (size_t)T * 64 * 2 <= WS_WIN && WS_WIN + (size_t)NWIN * 1024 * 2 <= WS_H && WS_U + (size_t)T * UB_P * 2 <= WS_MASK && WS_U + (size_t)T * UA_P * 2 <= WS_XT, "ws map 1");
static_assert(WS_WF2 + (size_t)1024 * FFH * 2 <= WS_END && WS_HP + (size_t)T * FFH * 2 <= WS_MG && WS_MG + (size_t)T * 1024 * 4 <= WS_W2B && WS_MISC + (size_t)T * 128 * 4 <= WS_END, "ws map 2");
constexpr int CW_BAR = 4096;
constexpr int RING_BYTES = 131072;
constexpr int XTRA_OFF = RING_BYTES;
constexpr int LDSCTL_OFF = RING_BYTES + 8192, MISC_OFF = LDSCTL_OFF + 320;
constexpr int LDS_BYTES = 147456;
static_assert(MISC_OFF + 128 <= LDS_BYTES, "LDS map");

__device__ __forceinline__ float wave_sum(float v) {
#pragma unroll
    for (int o = 1; o < 64; o <<= 1) v += __shfl_xor(v, o);
    return v;
}
__device__ __forceinline__ float bfl(unsigned w) { return __builtin_bit_cast(float, w << 16); }
__device__ __forceinline__ float bfh(unsigned w) { return __builtin_bit_cast(float, w & 0xffff0000u); }
__device__ __forceinline__ float silu_(float x) { return x / (1.0f + __expf(-x)); }
__device__ __forceinline__ float softplus_(float x) { return fmaxf(x, 0.f) + log1pf(expf(-fabsf(x))); }
__device__ __forceinline__ float logsigmoid_(float x) { return fminf(x, 0.f) - log1pf(expf(-fabsf(x))); }

struct MapWin { __device__ __forceinline__ int operator()(int r) const {
    if (r < 3072) return 3088 + r;
    if (r < 3328) return 6160 + (r - 3072);
    if (r < 3584) { const int m = r - 3328; if (m < 64) return 6416 + m; if (m < 68) return 6480 + (m - 64); if (m < 76) return 1536 + (m - 68); if (m < 84) return 3080 + (m - 76); return -1; }
    const int a = r - 3584; if (a < 1536) return a;
    return 1544 + (a - 1536); } };
struct MapId { int off; __device__ __forceinline__ int operator()(int r) const { return off + r; } };
struct MapFfn { __device__ __forceinline__ int operator()(int r) const { const int t = r >> 8, w = r & 255; return w < 128 ? 128 * t + w : FFH + 128 * t + (w - 128); } };
template <class Map> __device__ __forceinline__ void tr_items(const float* W, int N, int K, bf16* WT, int nrows, Map map, LAS float* scr, int gw, int NGW, int lane) {
    const int nrb = nrows / 32, nitems = nrb * (K / 64);
    for (int it = gw; it < nitems; it += NGW) {
        const int rb = it % nrb, kb = it / nrb, r0 = rb * 32, k0 = kb * 64;
        const int c = map(r0 + (lane & 31));
#pragma unroll 8
        for (int i = 0; i < 32; ++i) { const int kk = 2 * i + (lane >> 5); scr[kk * 33 + (lane & 31)] = (c >= 0) ? W[(size_t)(k0 + kk) * N + c] : 0.f; }
        LDS_WAIT(); asm volatile("" ::: "memory");
        const int cc = lane & 7;
#pragma unroll
        for (int j = 0; j < 4; ++j) { const int n = (lane >> 3) + 8 * j; const LAS float* s = scr + (8 * cc) * 33 + n;
            v4u o; o.x = pk2(s[0 * 33], s[1 * 33]); o.y = pk2(s[2 * 33], s[3 * 33]); o.z = pk2(s[4 * 33], s[5 * 33]); o.w = pk2(s[6 * 33], s[7 * 33]);
            *(GAS v4u*)(WT + (size_t)(r0 + n) * K + k0 + 8 * cc) = o; }
        LDS_WAIT(); asm volatile("" ::: "memory");
    }
}
__device__ __forceinline__ void norm_rows_to_bf16(const float* X, const float* g, bf16* Hout, int gw, int NGW, int lane) {
    for (int m = gw; m < T; m += NGW) {
        const f32x4* xr = (const f32x4*)(X + (size_t)m * DMODEL) + lane;
        f32x4 v[4]; float s = 0.f;
#pragma unroll
        for (int j = 0; j < 4; ++j) { v[j] = xr[64 * j]; s += (v[j].x * v[j].x + v[j].y * v[j].y) + (v[j].z * v[j].z + v[j].w * v[j].w); }
        const float rstd = 1.0f / sqrtf(wave_sum(s) * (1.0f / DMODEL) + EPS);
        unsigned long long* o8 = (unsigned long long*)(Hout + (size_t)m * DMODEL) + lane;
#pragma unroll
        for (int j = 0; j < 4; ++j) { const f32x4 gv = ((const f32x4*)g)[lane + 64 * j];
            o8[64 * j] = (unsigned long long)pk2(v[j].x * rstd * gv.x, v[j].y * rstd * gv.y) | ((unsigned long long)pk2(v[j].z * rstd * gv.z, v[j].w * rstd * gv.w) << 32); }
    }
}
__device__ __forceinline__ void norm_res_rows(const float* V, const float* g1, const float* xold, float* xout, const float* g2, bf16* Hout, int gw, int NGW, int lane) {
    for (int m = gw; m < T; m += NGW) {
        const f32x4* vr = (const f32x4*)(V + (size_t)m * DMODEL) + lane; const f32x4* xr = (const f32x4*)(xold + (size_t)m * DMODEL) + lane;
        f32x4 v[4], x[4]; float s = 0.f;
#pragma unroll
        for (int j = 0; j < 4; ++j) { v[j] = vr[64 * j]; x[j] = xr[64 * j]; s += (v[j].x * v[j].x + v[j].y * v[j].y) + (v[j].z * v[j].z + v[j].w * v[j].w); }
        const float rstd = 1.0f / sqrtf(wave_sum(s) * (1.0f / DMODEL) + EPS);
        float s2 = 0.f; f32x4* xo = (f32x4*)(xout + (size_t)m * DMODEL) + lane;
#pragma unroll
        for (int j = 0; j < 4; ++j) { const f32x4 gv = ((const f32x4*)g1)[lane + 64 * j]; x[j] = x[j] + v[j] * rstd * gv; xo[64 * j] = x[j];
            s2 += (x[j].x * x[j].x + x[j].y * x[j].y) + (x[j].z * x[j].z + x[j].w * x[j].w); }
        if (g2) {
            const float rstd2 = 1.0f / sqrtf(wave_sum(s2) * (1.0f / DMODEL) + EPS);
            unsigned long long* o8 = (unsigned long long*)(Hout + (size_t)m * DMODEL) + lane;
#pragma unroll
            for (int j = 0; j < 4; ++j) { const f32x4 gv = ((const f32x4*)g2)[lane + 64 * j];
                o8[64 * j] = (unsigned long long)pk2(x[j].x * rstd2 * gv.x, x[j].y * rstd2 * gv.y) | ((unsigned long long)pk2(x[j].z * rstd2 * gv.z, x[j].w * rstd2 * gv.w) << 32); }
        }
    }
}
__device__ __forceinline__ void rope_tables(float* RC, float* RS, int gtid, int NGT) {
    for (int i = gtid; i < SEQ * 32; i += NGT) { const int pos = i >> 5, k = i & 31;
        const float inv = powf(10000.0f, -(float)(2 * k) / 64.0f); const float ang = (float)pos * inv;
        RC[i] = cosf(ang); RS[i] = sinf(ang); }
}
__device__ __forceinline__ void rope_pair4(unsigned long long& a, unsigned long long& b, const f32x4 c, const f32x4 s, f32x4& o1, f32x4& o2) {
    const unsigned a0 = (unsigned)a, a1 = (unsigned)(a >> 32), b0 = (unsigned)b, b1 = (unsigned)(b >> 32);
    const f32x4 x1 = {bfl(a0), bfh(a0), bfl(a1), bfh(a1)}, x2 = {bfl(b0), bfh(b0), bfl(b1), bfh(b1)};
    o1 = x1 * c - x2 * s; o2 = x2 * c + x1 * s;
    a = (unsigned long long)pk2(o1.x, o1.y) | ((unsigned long long)pk2(o1.z, o1.w) << 32); b = (unsigned long long)pk2(o2.x, o2.y) | ((unsigned long long)pk2(o2.z, o2.w) << 32);
}
__device__ __forceinline__ void rope_phase(bf16* UB, const float* MISCF, bf16* IKB, float* KPART, const float* RC, const float* RS, LAS unsigned char* lds, int G, int bx, int tid, int lane, int wave) {
    LAS float* red = (LAS float*)lds;
    for (int unit = bx; unit < T / 64; unit += G) {
        f32x4 ks1 = {0.f, 0.f, 0.f, 0.f}, ks2 = {0.f, 0.f, 0.f, 0.f};
        const int hd = lane >> 3, d = (lane & 7) * 4;
        for (int i = 0; i < 8; ++i) {
            const int m = unit * 64 + wave * 8 + i, pos = m & (SEQ - 1);
            const f32x4 c = *(const f32x4*)(RC + pos * 32 + d), s = *(const f32x4*)(RS + pos * 32 + d);
            bf16* row = UB + (size_t)m * UB_P;
            const int segs[4] = {0, 512, 1536, 2048};
#pragma unroll
            for (int sg = 0; sg < 4; ++sg) {
                unsigned long long* p1 = (unsigned long long*)(row + segs[sg] + hd * 64 + d); unsigned long long* p2 = (unsigned long long*)(row + segs[sg] + hd * 64 + 32 + d);
                unsigned long long a = *p1, b = *p2; f32x4 o1, o2; rope_pair4(a, b, c, s, o1, o2); *p1 = a; *p2 = b;
                if (sg == 1) { ks1 = ks1 + o1; ks2 = ks2 + o2; }
            }
            if (lane < 32) {
                unsigned long long* p1 = (unsigned long long*)(row + 3072 + hd * 64 + d); unsigned long long* p2 = (unsigned long long*)(row + 3072 + hd * 64 + 32 + d);
                unsigned long long a = *p1, b = *p2; f32x4 o1, o2; rope_pair4(a, b, c, s, o1, o2); *p1 = a; *p2 = b;
            }
            if (lane < 8) {
                const f32x4 x1 = *(const f32x4*)(MISCF + (size_t)m * 128 + d), x2 = *(const f32x4*)(MISCF + (size_t)m * 128 + 32 + d);
                const f32x4 o1 = x1 * c - x2 * s, o2 = x2 * c + x1 * s;
                *(unsigned long long*)(IKB + (size_t)m * 64 + d) = (unsigned long long)pk2(o1.x, o1.y) | ((unsigned long long)pk2(o1.z, o1.w) << 32);
                *(unsigned long long*)(IKB + (size_t)m * 64 + 32 + d) = (unsigned long long)pk2(o2.x, o2.y) | ((unsigned long long)pk2(o2.z, o2.w) << 32);
            }
        }
        *(LAS f32x4*)(red + wave * 512 + hd * 64 + d) = ks1; *(LAS f32x4*)(red + wave * 512 + hd * 64 + 32 + d) = ks2;
        __syncthreads();
        { float a = 0.f;
#pragma unroll
          for (int w = 0; w < 8; ++w) a += red[w * 512 + tid];
          KPART[(size_t)unit * 512 + tid] = a; }
        __syncthreads();
    }
}
__device__ __forceinline__ void moba_gate_phase(const bf16* UB, const float* KPART, unsigned* SELM, LAS unsigned char* lds, int G, int bx, int tid, int lane, int wave) {
    LAS float* km = (LAS float*)lds;
    for (int unit = bx; unit < T / 64; unit += G) {
        const int b = (unit * 64) / SEQ;
        __syncthreads();
        for (int i = tid; i < 8 * 32 * 64; i += NTHR) { const int dd = i & 63, n = (i >> 6) & 31, hh = i >> 11;
            const float* kp = KPART + (size_t)(b * 128 + 4 * n) * 512 + hh * 64 + dd;
            km[(hh * 32 + n) * 68 + dd] = ((kp[0] + kp[512]) + (kp[1024] + kp[1536])) * (1.0f / 256.0f); }
        __syncthreads();
        const int hd = lane >> 3, j = lane & 7;
        for (int i = 0; i < 8; ++i) {
            const int m = unit * 64 + wave * 8 + i, pos = m & (SEQ - 1), cur = pos >> 8;
            const v4u* qp = (const v4u*)(UB + (size_t)m * UB_P + hd * 64);
            v4u qv[8];
#pragma unroll
            for (int k = 0; k < 8; ++k) qv[k] = qp[k];
            float val[4];
#pragma unroll
            for (int ii = 0; ii < 4; ++ii) { const int n = j + 8 * ii; const LAS f32x4* kr = (const LAS f32x4*)(km + (hd * 32 + n) * 68); float acc = 0.f;
#pragma unroll
                for (int k = 0; k < 8; ++k) { const f32x4 k0 = kr[2 * k], k1 = kr[2 * k + 1]; const v4u q = qv[k];
                    acc += bfl(q.x) * k0.x + bfh(q.x) * k0.y + bfl(q.y) * k0.z + bfh(q.y) * k0.w + bfl(q.z) * k1.x + bfh(q.z) * k1.y + bfl(q.w) * k1.z + bfh(q.w) * k1.w; }
                val[ii] = (n < cur) ? acc : -INFINITY; }
            unsigned selmask = 0u;
#pragma unroll
            for (int round = 0; round < 3; ++round) {
                float bv = val[0]; int bn = j;
#pragma unroll
                for (int ii = 1; ii < 4; ++ii) { if (val[ii] > bv) { bv = val[ii]; bn = j + 8 * ii; } }
#pragma unroll
                for (int o = 1; o < 8; o <<= 1) { const float ov = __shfl_xor(bv, o); const int on = __shfl_xor(bn, o); if (ov > bv || (ov == bv && on < bn)) { bv = ov; bn = on; } }
                if (bv > -INFINITY) selmask |= 1u << bn;
#pragma unroll
                for (int ii = 0; ii < 4; ++ii) if (bn == j + 8 * ii) val[ii] = -INFINITY;
            }
            if (j == 0) SELM[(size_t)m * 8 + hd] = selmask;
        }
    }
}
typedef __attribute__((ext_vector_type(8))) short dsa_bf16x8;
typedef __attribute__((ext_vector_type(4))) float dsa_f32x4;
struct DsaCtx { dsa_bf16x8 af[4][2]; float wq[4][4]; int b, p0, g4; };
__device__ __forceinline__ void dsa_scores(const DsaCtx& c, const bf16* IKB, int key0, int lane, unsigned (&k22)[4], bool (&valid)[4]) {
    const int key = key0 + (lane & 15);
    const bf16* kp = IKB + ((size_t)c.b * SEQ + key) * 64 + 8 * (lane >> 4);
    const dsa_bf16x8 b0 = *(const dsa_bf16x8*)(kp), b1 = *(const dsa_bf16x8*)(kp + 32);
    dsa_f32x4 a[4];
#pragma unroll
    for (int hh = 0; hh < 4; ++hh) { dsa_f32x4 z = {0.f, 0.f, 0.f, 0.f};
        z = __builtin_amdgcn_mfma_f32_16x16x32_bf16(c.af[hh][0], b0, z, 0, 0, 0);
        a[hh] = __builtin_amdgcn_mfma_f32_16x16x32_bf16(c.af[hh][1], b1, z, 0, 0, 0); }
#pragma unroll
    for (int r = 0; r < 4; ++r) {
        float sc = c.wq[r][0] * fmaxf(a[0][r], 0.f);
        sc += c.wq[r][1] * fmaxf(a[1][r], 0.f); sc += c.wq[r][2] * fmaxf(a[2][r], 0.f); sc += c.wq[r][3] * fmaxf(a[3][r], 0.f);
        const float v = sc + 0.0f;
        const unsigned u = __builtin_bit_cast(unsigned, v);
        const unsigned mono = (u >> 31) ? ~u : (u | 0x80000000u);
        k22[r] = mono >> 10;
        valid[r] = key <= c.p0 + c.g4 + r;
    }
}
__device__ __forceinline__ void dsa_scan(LAS unsigned* hist, int q, unsigned need, int lane, LAS unsigned* o_bin, LAS unsigned* o_above, LAS unsigned* o_cnt) {
    const LAS unsigned* hrow = hist + q * 2048; const int rot = 67 * q;
    unsigned cnt = 0;
#pragma unroll 8
    for (int i = 0; i < 32; ++i) cnt += hrow[(32 * lane + i + rot) & 2047];
    unsigned sfx = cnt;
#pragma unroll
    for (int o = 1; o < 64; o <<= 1) { const unsigned t = __shfl_down(sfx, o); if (lane + o < 64) sfx += t; }
    const unsigned above = sfx - cnt;
    if (lane == 0) { *o_bin = 0u; *o_above = 0u; *o_cnt = 0u; }
    if (above < need && sfx >= need) {
        unsigned cum = above;
        for (int i = 31; i >= 0; --i) { const unsigned h = hrow[(32 * lane + i + rot) & 2047];
            if (cum + h >= need) { *o_bin = (unsigned)(32 * lane + i); *o_above = cum; *o_cnt = h; break; }
            cum += h; }
    }
}
__device__ __forceinline__ void dsa_topk_phase(const bf16* UB, const bf16* IKB, const float* MISCF, unsigned long long* MASKT, LAS unsigned char* lds, int G, int bx, int vcu, int tid, int lane, int wave) {
    LAS unsigned* hist = (LAS unsigned*)lds;
    LAS unsigned* par = (LAS unsigned*)(lds + XTRA_OFF);
    const int nun = T / 16;
    for (int it = 0;; ++it) {
        int unit;
        if (G == 256) { if (it >= 4) break; unit = (it == 0) ? vcu : (it == 1) ? 511 - vcu : (it == 2) ? 512 + vcu : 1023 - vcu; }
        else { unit = bx + it * G; if (unit >= nun) break; }
        DsaCtx c; const int row0 = unit * 16; c.b = row0 >> 13; c.p0 = row0 & (SEQ - 1); c.g4 = 4 * (lane >> 4);
        { const bf16* qp = UB + (size_t)(row0 + (lane & 15)) * UB_P + 3072 + 8 * (lane >> 4);
#pragma unroll
          for (int hh = 0; hh < 4; ++hh) { c.af[hh][0] = *(const dsa_bf16x8*)(qp + hh * 64); c.af[hh][1] = *(const dsa_bf16x8*)(qp + hh * 64 + 32); }
#pragma unroll
          for (int r = 0; r < 4; ++r) { const dsa_f32x4 w4 = *(const dsa_f32x4*)(MISCF + (size_t)(row0 + c.g4 + r) * 128 + 64);
              c.wq[r][0] = w4[0] * 0.0625f; c.wq[r][1] = w4[1] * 0.0625f; c.wq[r][2] = w4[2] * 0.0625f; c.wq[r][3] = w4[3] * 0.0625f; } }
        const int nsteps = (c.p0 + 16 + 127) >> 7;
        __syncthreads();
        for (int i = tid; i < 8192; i += NTHR) ((LAS v4u*)hist)[i] = (v4u){0u, 0u, 0u, 0u};
        __syncthreads();
        for (int s = 0; s < nsteps; ++s) { const int key0 = 128 * s + 16 * wave; if (key0 > c.p0 + 15) continue;
            unsigned k22[4]; bool valid[4]; dsa_scores(c, IKB, key0, lane, k22, valid);
#pragma unroll
            for (int r = 0; r < 4; ++r) if (valid[r]) { const int q = c.g4 + r; __hip_atomic_fetch_add(hist + q * 2048 + (((k22[r] >> 11) + 67 * q) & 2047), 1u, __ATOMIC_RELAXED, __HIP_MEMORY_SCOPE_WORKGROUP); } }
        __syncthreads();
#pragma unroll
        for (int k = 0; k < 2; ++k) { const int q = 2 * wave + k; dsa_scan(hist, q, 256u, lane, par + q, par + 16 + q, par + 80 + q); }
        __syncthreads();
        for (int i = tid; i < 8192; i += NTHR) ((LAS v4u*)hist)[i] = (v4u){0u, 0u, 0u, 0u};
        __syncthreads();
        for (int s = 0; s < nsteps; ++s) { const int key0 = 128 * s + 16 * wave; if (key0 > c.p0 + 15) continue;
            unsigned k22[4]; bool valid[4]; dsa_scores(c, IKB, key0, lane, k22, valid);
#pragma unroll
            for (int r = 0; r < 4; ++r) { const int q = c.g4 + r; if (valid[r] && (k22[r] >> 11) == par[q]) __hip_atomic_fetch_add(hist + q * 2048 + (((k22[r] & 2047u) + 67 * q) & 2047), 1u, __ATOMIC_RELAXED, __HIP_MEMORY_SCOPE_WORKGROUP); } }
        __syncthreads();
#pragma unroll
        for (int k = 0; k < 2; ++k) { const int q = 2 * wave + k; const unsigned c1 = par[16 + q];
            dsa_scan(hist, q, 256u - c1, lane, par + 32 + q, par + 48 + q, par + 64 + q);
            if (lane == 0) { const unsigned b2 = par[32 + q], c2 = par[48 + q]; const bool all = (c.p0 + q) < 256;
                par[32 + q] = all ? 0xffffffffu : ((par[q] << 11) | b2); par[48 + q] = all ? 0u : (256u - c1 - c2); if (all) par[64 + q] = 0u; } }
        __syncthreads();
        for (int i = tid; i < 2048; i += NTHR) ((LAS v4u*)hist)[i] = (v4u){0u, 0u, 0u, 0u};
        __syncthreads();
        { LAS unsigned short* gt16 = (LAS unsigned short*)lds; LAS unsigned short* eq16 = (LAS unsigned short*)(lds + 16384);
          for (int s = 0; s < nsteps; ++s) { const int key0 = 128 * s + 16 * wave; if (key0 > c.p0 + 15) continue;
            unsigned k22[4]; bool valid[4]; dsa_scores(c, IKB, key0, lane, k22, valid);
#pragma unroll
            for (int r = 0; r < 4; ++r) { const int t22 = (int)par[32 + c.g4 + r];
                const bool gt = valid[r] && ((int)k22[r] > t22), eq = valid[r] && ((int)k22[r] == t22);
                const unsigned long long bg = __ballot(gt), be = __ballot(eq);
                if (lane < 4) { gt16[(4 * lane + r) * 512 + (key0 >> 4)] = (unsigned short)(bg >> (16 * lane)); eq16[(4 * lane + r) * 512 + (key0 >> 4)] = (unsigned short)(be >> (16 * lane)); } } } }
        __syncthreads();
        { LAS unsigned* gt32 = (LAS unsigned*)lds; LAS unsigned* eq32 = (LAS unsigned*)(lds + 16384);
#pragma unroll
          for (int k = 0; k < 2; ++k) { const int q = 2 * wave + k; const unsigned quota = par[48 + q], eqcnt = par[64 + q]; unsigned base = 0u;
            for (int rnd = 0; rnd < 4; ++rnd) { const int wi = q * 256 + rnd * 64 + lane; const unsigned e = eq32[wi]; unsigned kw = e;
                if (eqcnt > quota) { const unsigned cn = __popc(e); unsigned inc = cn;
#pragma unroll
                    for (int o = 1; o < 64; o <<= 1) { const unsigned t = __shfl_up(inc, o); if (lane >= o) inc += t; }
                    const unsigned exc = base + inc - cn; base += __shfl(inc, 63);
                    if (exc + cn <= quota) kw = e; else if (exc >= quota) kw = 0u; else { unsigned rem = quota - exc, w = e; kw = 0u; while (rem > 0u) { const unsigned low = w & (0u - w); kw |= low; w ^= low; --rem; } } }
                gt32[wi] |= kw; } } }
        __syncthreads();
        { const LAS unsigned long long* gt64 = (const LAS unsigned long long*)lds;
#pragma unroll
          for (int k = 0; k < 4; ++k) { const int idx = tid + NTHR * k, qq = idx & 15, t = idx >> 4;
              MASKT[((size_t)(c.b * 128 + t)) * SEQ + c.p0 + qq] = gt64[qq * 128 + t]; } }
    }
    __syncthreads();
}
typedef __attribute__((ext_vector_type(8))) short s_bf16x8;
typedef __attribute__((ext_vector_type(16))) float s_f32x16;
__device__ __forceinline__ int crow_(int r, int hi) { return (r & 3) + 8 * (r >> 2) + 4 * hi; }
__device__ __forceinline__ void ssd_prep_phase(const bf16* UA, const float* MISCF, const float* conv_w, const float* conv_b, const float* dt_bias, const float* a_log, const float* fbias,
                                               float* CF2, float* ACS, float* DTA, bf16* XT, bf16* BT, bf16* BC, bf16* CC, LAS unsigned char* lds, int G, int bx, int tid, int lane, int wave) {
    const int NU = 16 + 64 + 256;
    for (int unit = bx; unit < NU; unit += G) {
        __syncthreads();
        if (unit < 16) {
            const int b = unit >> 3, h = unit & 7; const float fb = fbias[h];
            float v[16]; float run = 0.f;
#pragma unroll
            for (int i = 0; i < 16; ++i) { const int t = 16 * tid + i; run += logsigmoid_(MISCF[((size_t)b * SEQ + t) * 128 + 76 + h] + fb) * LOG2E; v[i] = run; }
            float inc = run;
#pragma unroll
            for (int o = 1; o < 64; o <<= 1) { const float t_ = __shfl_up(inc, o); if (lane >= o) inc += t_; }
            LAS float* wt = (LAS float*)lds;
            if (lane == 63) wt[wave] = inc;
            __syncthreads();
            float off = inc - run;
            for (int w = 0; w < wave; ++w) off += wt[w];
#pragma unroll
            for (int i = 0; i < 16; ++i) CF2[((size_t)b * 8 + h) * SEQ + 16 * tid + i] = off + v[i];
        } else if (unit < 80) {
            const int u = unit - 16, b = u >> 5, cch = u & 31, h = wave;
            const float bias = dt_bias[h], a = -expf(a_log[h]);
            float dtv[4], cs[4]; float run = 0.f;
#pragma unroll
            for (int i = 0; i < 4; ++i) { const int t = cch * 256 + 4 * lane + i; dtv[i] = softplus_(MISCF[((size_t)b * SEQ + t) * 128 + 68 + h] + bias); run += dtv[i] * a; cs[i] = run; }
            float inc = run;
#pragma unroll
            for (int o = 1; o < 64; o <<= 1) { const float t_ = __shfl_up(inc, o); if (lane >= o) inc += t_; }
            const float off = inc - run;
#pragma unroll
            for (int i = 0; i < 4; ++i) { const size_t o_ = ((size_t)b * 8 + h) * SEQ + cch * 256 + 4 * lane + i; ACS[o_] = off + cs[i]; DTA[o_] = dtv[i]; }
        } else {
            const int u = unit - 80, b = u >> 7, t0 = (u & 127) * 64; const int ch0 = 2 * tid;
            LAS unsigned short* tl = (LAS unsigned short*)lds;
            float cw[4][2], cb[2];
#pragma unroll
            for (int w = 0; w < 4; ++w) { cw[w][0] = conv_w[w * 1024 + ch0]; cw[w][1] = conv_w[w * 1024 + ch0 + 1]; }
            cb[0] = conv_b[ch0]; cb[1] = conv_b[ch0 + 1];
            const bf16* src = UA + ((size_t)b * SEQ) * UA_P + 512 + ch0;
            float r0[2] = {0.f, 0.f}, r1[2] = {0.f, 0.f}, r2[2] = {0.f, 0.f};
            if (t0 > 0) { const unsigned w0 = *(const unsigned*)(src + (size_t)(t0 - 3) * UA_P), w1 = *(const unsigned*)(src + (size_t)(t0 - 2) * UA_P), w2 = *(const unsigned*)(src + (size_t)(t0 - 1) * UA_P);
                r0[0] = bfl(w0); r0[1] = bfh(w0); r1[0] = bfl(w1); r1[1] = bfh(w1); r2[0] = bfl(w2); r2[1] = bfh(w2); }
#pragma unroll 8
            for (int tt = 0; tt < 64; ++tt) {
                const unsigned wv = *(const unsigned*)(src + (size_t)(t0 + tt) * UA_P); const float c0 = bfl(wv), c1 = bfh(wv);
                const float y0 = cb[0] + cw[0][0] * r0[0] + cw[1][0] * r1[0] + cw[2][0] * r2[0] + cw[3][0] * c0;
                const float y1 = cb[1] + cw[0][1] * r0[1] + cw[1][1] * r1[1] + cw[2][1] * r2[1] + cw[3][1] * c1;
                r0[0] = r1[0]; r0[1] = r1[1]; r1[0] = r2[0]; r1[1] = r2[1]; r2[0] = c0; r2[1] = c1;
                const unsigned o0 = f2bf(silu_(y0)), o1 = f2bf(silu_(y1));
                if (ch0 < 768) { tl[ch0 * 68 + tt] = (unsigned short)o0; tl[(ch0 + 1) * 68 + tt] = (unsigned short)o1; }
                if (ch0 >= 512) { const size_t row = (size_t)b * SEQ + t0 + tt;
                    if (ch0 < 768) *(unsigned*)(BC + row * 256 + (ch0 - 512)) = o0 | (o1 << 16); else *(unsigned*)(CC + row * 256 + (ch0 - 768)) = o0 | (o1 << 16); }
            }
            __syncthreads();
#pragma unroll
            for (int k = 0; k < 12; ++k) { const int idx = tid + NTHR * k, rowc = idx >> 3, chunk = idx & 7;
                const LAS unsigned long long* sp = (const LAS unsigned long long*)(tl + rowc * 68 + chunk * 8);
                const unsigned long long lo = sp[0], hi = sp[1];
                bf16* dst = (rowc < 512) ? XT + (((size_t)b * 8 + (rowc >> 6)) * 64 + (rowc & 63)) * SEQ + t0 + chunk * 8
                                         : BT + (((size_t)b * 2 + ((rowc - 512) >> 7)) * 128 + ((rowc - 512) & 127)) * SEQ + t0 + chunk * 8;
                v4u o; o.x = (unsigned)lo; o.y = (unsigned)(lo >> 32); o.z = (unsigned)hi; o.w = (unsigned)(hi >> 32); *(v4u*)dst = o; }
        }
    }
    __syncthreads();
}
__device__ __forceinline__ void ssd_state_phase(const bf16* XT, const bf16* BT, const float* ACS, const float* DTA, float* STATE, LAS unsigned char* lds, int G, int bx, int tid, int lane, int wave) {
    LAS float* wl = (LAS float*)lds;
    const int r32 = lane & 31, hi = lane >> 5, d0 = wave & 1, nb = wave >> 1;
    for (int unit = bx; unit < NB * 32 * 8; unit += G) {
        const int h = unit & 7, cch = (unit >> 3) & 31, b = unit >> 8, g = h >> 2;
        __syncthreads();
        if (tid < 256) { const size_t o_ = ((size_t)b * 8 + h) * SEQ + cch * 256; wl[tid] = DTA[o_ + tid] * expf(ACS[o_ + 255] - ACS[o_ + tid]); }
        __syncthreads();
        const bf16* xp = XT + (((size_t)b * 8 + h) * 64 + 32 * d0 + r32) * SEQ + cch * 256 + 8 * hi;
        const bf16* bp = BT + (((size_t)b * 2 + g) * 128 + 32 * nb + r32) * SEQ + cch * 256 + 8 * hi;
        s_f32x16 acc = {};
#pragma unroll 4
        for (int k = 0; k < 16; ++k) {
            const v4u xa = *(const v4u*)(xp + 16 * k); const s_bf16x8 bb = *(const s_bf16x8*)(bp + 16 * k);
            const LAS f32x4* w4 = (const LAS f32x4*)(wl + 16 * k + 8 * hi); const f32x4 wa = w4[0], wb = w4[1];
            v4u xs; xs.x = pk2(bfl(xa.x) * wa.x, bfh(xa.x) * wa.y); xs.y = pk2(bfl(xa.y) * wa.z, bfh(xa.y) * wa.w); xs.z = pk2(bfl(xa.z) * wb.x, bfh(xa.z) * wb.y); xs.w = pk2(bfl(xa.w) * wb.z, bfh(xa.w) * wb.w);
            acc = __builtin_amdgcn_mfma_f32_32x32x16_bf16(__builtin_bit_cast(s_bf16x8, xs), bb, acc, 0, 0, 0);
        }
        float* sp = STATE + ((((size_t)b * 32 + cch) * 8 + h) * 64 + 32 * d0) * 128 + 32 * nb + r32;
#pragma unroll
        for (int r = 0; r < 16; ++r) sp[(size_t)crow_(r, hi) * 128] = acc[r];
    }
    __syncthreads();
}
__device__ __forceinline__ void ssd_scan_phase(const float* STATE, const float* ACS, bf16* PREV, int G, int bx, int tid) {
    for (int idx = bx * NTHR + tid; idx < NB * 8 * 8192; idx += G * NTHR) {
        const int b = idx >> 16, h = (idx >> 13) & 7, pn = idx & 8191; float run = 0.f;
#pragma unroll 4
        for (int cch = 0; cch < 32; ++cch) { const size_t o_ = (((size_t)b * 32 + cch) * 8 + h) * 8192 + pn;
            const float s = STATE[o_]; PREV[o_] = (bf16)f2bf(run);
            run = run * expf(ACS[((size_t)b * 8 + h) * SEQ + cch * 256 + 255]) + s; }
    }
}
__device__ __forceinline__ void ssd_out_phase(const bf16* UA, const bf16* XT, const bf16* BC, const bf16* CC, const bf16* PREV, const float* ACS, const float* DTA, const float* d_skip, bf16* Y0,
                                              int G, int bx, int lane, int wave) {
    const int r32 = lane & 31, hi = lane >> 5;
    for (int unit = bx; unit < NB * 32 * 8; unit += G) {
        const int h = unit & 7, cch = (unit >> 3) & 31, b = unit >> 8, g = h >> 2;
        const int ql = 32 * wave + r32; const size_t rowl = (size_t)b * SEQ + cch * 256 + ql;
        const size_t abase = ((size_t)b * 8 + h) * SEQ + cch * 256;
        const float acs_l = ACS[abase + ql], Dh = d_skip[h];
        s_bf16x8 cf[8];
#pragma unroll
        for (int kn = 0; kn < 8; ++kn) cf[kn] = *(const s_bf16x8*)(CC + rowl * 256 + g * 128 + 16 * kn + 8 * hi);
        s_f32x16 o[2]; o[0] = s_f32x16{}; o[1] = s_f32x16{};
        { const bf16* pp = PREV + ((((size_t)b * 32 + cch) * 8 + h) * 64 + r32) * 128 + 8 * hi;
#pragma unroll
          for (int d0 = 0; d0 < 2; ++d0)
#pragma unroll
              for (int kn = 0; kn < 8; ++kn) o[d0] = __builtin_amdgcn_mfma_f32_32x32x16_bf16(*(const s_bf16x8*)(pp + (size_t)d0 * 32 * 128 + 16 * kn), cf[kn], o[d0], 0, 0, 0);
          const float e = expf(acs_l);
#pragma unroll
          for (int r = 0; r < 16; ++r) { o[0][r] *= e; o[1][r] *= e; } }
        const bf16* xp = XT + (((size_t)b * 8 + h) * 64 + r32) * SEQ + cch * 256 + 4 * hi;
        for (int st = 0; st <= wave; ++st) {
            s_f32x16 s = {};
            { const bf16* bp = BC + ((size_t)b * SEQ + cch * 256 + 32 * st + r32) * 256 + g * 128 + 8 * hi;
#pragma unroll
              for (int kn = 0; kn < 8; ++kn) s = __builtin_amdgcn_mfma_f32_32x32x16_bf16(*(const s_bf16x8*)(bp + 16 * kn), cf[kn], s, 0, 0, 0); }
            float P[16];
#pragma unroll
            for (int gq = 0; gq < 4; ++gq) { const f32x4 a4 = *(const f32x4*)(ACS + abase + 32 * st + 8 * gq + 4 * hi), d4 = *(const f32x4*)(DTA + abase + 32 * st + 8 * gq + 4 * hi);
#pragma unroll
                for (int j = 0; j < 4; ++j) { const int key = 32 * st + 8 * gq + 4 * hi + j;
                    const float f = (key <= ql) ? expf(fminf(acs_l - a4[j], 0.f)) * d4[j] : 0.f;
                    float p = s[4 * gq + j] * f; if (key == ql) p += Dh; P[4 * gq + j] = p; } }
            v4u pf0, pf1;
            pf0.x = pk2(P[0], P[1]); pf0.y = pk2(P[2], P[3]); pf0.z = pk2(P[4], P[5]); pf0.w = pk2(P[6], P[7]);
            pf1.x = pk2(P[8], P[9]); pf1.y = pk2(P[10], P[11]); pf1.z = pk2(P[12], P[13]); pf1.w = pk2(P[14], P[15]);
#pragma unroll
            for (int d0 = 0; d0 < 2; ++d0) { const bf16* xq = xp + (size_t)d0 * 32 * SEQ + 32 * st;
                const unsigned long long a0 = *(const unsigned long long*)(xq), a1 = *(const unsigned long long*)(xq + 8), a2 = *(const unsigned long long*)(xq + 16), a3 = *(const unsigned long long*)(xq + 24);
                v4u x0, x1; x0.x = (unsigned)a0; x0.y = (unsigned)(a0 >> 32); x0.z = (unsigned)a1; x0.w = (unsigned)(a1 >> 32); x1.x = (unsigned)a2; x1.y = (unsigned)(a2 >> 32); x1.z = (unsigned)a3; x1.w = (unsigned)(a3 >> 32);
                o[d0] = __builtin_amdgcn_mfma_f32_32x32x16_bf16(__builtin_bit_cast(s_bf16x8, x0), __builtin_bit_cast(s_bf16x8, pf0), o[d0], 0, 0, 0);
                o[d0] = __builtin_amdgcn_mfma_f32_32x32x16_bf16(__builtin_bit_cast(s_bf16x8, x1), __builtin_bit_cast(s_bf16x8, pf1), o[d0], 0, 0, 0); }
        }
#pragma unroll
        for (int d0 = 0; d0 < 2; ++d0)
#pragma unroll
            for (int gq = 0; gq < 4; ++gq) { const int p = 32 * d0 + 8 * gq + 4 * hi;
                const unsigned long long zw = *(const unsigned long long*)(UA + rowl * UA_P + h * 64 + p); const unsigned z0 = (unsigned)zw, z1 = (unsigned)(zw >> 32);
                const float y0 = o[d0][4 * gq] * silu_(bfl(z0)), y1 = o[d0][4 * gq + 1] * silu_(bfh(z0)), y2 = o[d0][4 * gq + 2] * silu_(bfl(z1)), y3 = o[d0][4 * gq + 3] * silu_(bfh(z1));
                *(unsigned long long*)(Y0 + rowl * 512 + h * 64 + p) = (unsigned long long)pk2(y0, y1) | ((unsigned long long)pk2(y2, y3) << 32); }
    }
}
__device__ __forceinline__ void ssd_gnorm_phase(bf16* Y0, const float* normw, int gw, int NGW, int lane) {
    for (int m = gw; m < T; m += NGW) {
        v4u* p = (v4u*)(Y0 + (size_t)m * 512) + lane; const v4u w = *p;
        float v[8] = {bfl(w.x), bfh(w.x), bfl(w.y), bfh(w.y), bfl(w.z), bfh(w.z), bfl(w.w), bfh(w.w)}; float s = 0.f;
#pragma unroll
        for (int j = 0; j < 8; ++j) s += v[j] * v[j];
#pragma unroll
        for (int o = 1; o < 32; o <<= 1) s += __shfl_xor(s, o);
        const float rstd = 1.0f / sqrtf(s * (1.0f / 256.0f) + EPS);
        const f32x4 g0 = ((const f32x4*)normw)[2 * lane], g1 = ((const f32x4*)normw)[2 * lane + 1];
        v4u o; o.x = pk2(v[0] * rstd * g0.x, v[1] * rstd * g0.y); o.y = pk2(v[2] * rstd * g0.z, v[3] * rstd * g0.w); o.z = pk2(v[4] * rstd * g1.x, v[5] * rstd * g1.y); o.w = pk2(v[6] * rstd * g1.z, v[7] * rstd * g1.w);
        *p = o;
    }
}
typedef attn_body::bf16 abf;
__device__ __forceinline__ void attn_bd_phase(char* lds, const bf16* UB, bf16* Y2, bf16* Y3, const unsigned* SELM, const unsigned long long* MASKT, int G, int vcu, int tid) {
    for (int v = vcu; v < 256; v += G)
        for (int i = 0; i < 4; ++i) {
            const int s = v & 7, bh = v >> 3, qb = (i == 0) ? s : (i == 1) ? 15 - s : (i == 2) ? 16 + s : 31 - s;
            int tid_u = tid; asm volatile("" : "+v"(tid_u));
            const int branch = bh >> 4, b = (bh >> 3) & 1, h = bh & 7;
#ifdef ATT_BASE
            attn_body::attn_unit<8, 3, ATT_BASE_DM, ATT_BASE_ODM>(b, h, qb, (const abf*)UB, (const abf*)UB + 512, (const abf*)UB + 1024, (abf*)Y2, lds, SELM, tid_u);
#endif
#ifndef ATT_SKIP1
            if (branch == 0) attn_body::attn_unit<8, 1, UB_P, 512>(b, h, qb, (const abf*)UB, (const abf*)UB + 512, (const abf*)UB + 1024, (abf*)Y2, lds, SELM, tid_u);
#endif
#ifndef ATT_SKIP2
            if (branch == 1) attn_body::attn_unit<8, 2, UB_P, 512>(b, h, qb, (const abf*)UB + 1536, (const abf*)UB + 2048, (const abf*)UB + 2560, (abf*)Y3, lds, MASKT, tid_u);
#endif
        }
}
__device__ __forceinline__ void attn_fox_phase(char* lds, const bf16* UA, bf16* Y1, const float* CF2, int G, int vcu, int tid) {
    for (int v = vcu; v < 256; v += G)
        for (int i = 0; i < 2; ++i) {
            const int s = v & 15, bh = v >> 4, qb = (i == 0) ? s : 31 - s, b = bh >> 3, h = bh & 7;
            int tid_u = tid; asm volatile("" : "+v"(tid_u));
            attn_body::attn_unit<8, 0, UA_P, 512>(b, h, qb, (const abf*)UA + 1536, (const abf*)UA + 2048, (const abf*)UA + 2560, (abf*)Y1, lds, CF2, tid_u);
        }
}
template <class Epi> __device__ __forceinline__ void run_gemm(LAS unsigned char* lds, const bf16* A, int lda, const bf16* Bt, int ldb, int N, int K, int G, int bx, int tid, const Epi& E) {
    pg8::Gemm g{A, Bt, T, N, K, lda, ldb}; pg8::StaticOrder S; S.init(T, N, G, bx);
    pg8::gemm_phase<Epi, pg8::StaticOrder, true, true>(lds, g, S, E, tid);
}

constexpr int PH_PER_LAYER = 24, N_PHASES = 2 * PH_PER_LAYER;
struct Args { const float* in[19]; float* out; unsigned char* ws; int ph_lo, ph_hi; };
#define RC ((float*)(ws + WS_ROPEC))
#define RS ((float*)(ws + WS_ROPES))
#define CF2 ((float*)(ws + WS_CF2))
#define ACS ((float*)(ws + WS_ACS))
#define DTA ((float*)(ws + WS_DTA))
#define SELM ((unsigned*)(ws + WS_SELM))
#define KPART ((float*)(ws + WS_KPART))
#define IKB ((bf16*)(ws + WS_IKB))
#define WIN ((bf16*)(ws + WS_WIN))
#define WG ((bf16*)(ws + WS_WG))
#define WB ((bf16*)(ws + WS_WB))
#define H ((bf16*)(ws + WS_H))
#define Y ((bf16*)(ws + WS_Y))
#define U ((bf16*)(ws + WS_U))
#define XT ((bf16*)(ws + WS_XT))
#define MASKT ((unsigned long long*)(ws + WS_MASK))
#define BC ((bf16*)(ws + WS_BC))
#define CC ((bf16*)(ws + WS_CC))
#define MISCF ((float*)(ws + WS_MISC))
#define STATE ((float*)(ws + WS_STATE))
#define BT ((bf16*)(ws + WS_BT))
#define PREV ((bf16*)(ws + WS_PREV))
#define GB ((bf16*)(ws + WS_G))
#define MG ((float*)(ws + WS_MG))
#define WO ((bf16*)(ws + WS_WO))
#define WF1 ((bf16*)(ws + WS_WF1))
#define WF2 ((bf16*)(ws + WS_WF2))
#define HP ((bf16*)(ws + WS_HP))
#define Y0 (Y)
#define Y1 (Y + (size_t)T * 512)
#define Y2 (Y + (size_t)2 * T * 512)
#define Y3 (Y + (size_t)3 * T * 512)

#ifndef PH_MASK
#define PH_MASK 0xffffffu
#endif
#define PHASE_PROLOGUE \
    int tid = threadIdx.x; asm volatile("" : "+v"(tid)); \
    int G = gridDim.x, bx = blockIdx.x; asm volatile("" : "+s"(G), "+s"(bx)); \
    unsigned char* ws = args.ws; asm volatile("" : "+s"(ws)); \
    const int lane = tid & 63, wave = __builtin_amdgcn_readfirstlane(tid >> 6); \
    const int vcu = (G % 8 == 0) ? (bx % 8) * (G / 8) + bx / 8 : bx; \
    const int gw = vcu * NWAVES + wave, NGW = G * NWAVES, gtid = bx * NTHR + tid, NGT = G * NTHR; \
    LAS float* scr = (LAS float*)(lds + wave * 16384); \
    (void)lane; (void)vcu; (void)gw; (void)NGW; (void)gtid; (void)NGT; (void)scr; (void)ws;
#define IN(k) (lo <= (k) && (k) < hi && ((PH_MASK >> ((k) % PH_PER_LAYER)) & 1u))
#define INR(k) (lo <= (k) && (k) < hi)
#define SEAM(k) do { if (INR(k) && INR((k) + 1)) { if ((k) == 0) { asm volatile("s_waitcnt vmcnt(0)" ::: "memory"); cg::this_grid().sync(); } else xcd_barrier(bar); } } while (0)

template <int L> __device__ __forceinline__ void run_layer(const Args& args, const int lo, const int hi, const XcdBarrier& bar, LAS unsigned char* lds, unsigned char* lds_raw) {
    constexpr int B0 = L * PH_PER_LAYER;
    if (L == 0 && IN(B0 + 0)) { PHASE_PROLOGUE
        tr_items(args.in[2], 6484, 1024, WIN, NWIN, MapWin{}, scr, gw, NGW, lane);
        rope_tables(RC, RS, gtid, NGT);
        norm_rows_to_bf16(args.in[0], args.in[1], H, gw, NGW, lane);
    }
    if (L == 0) SEAM(B0 + 0);
    if (IN(B0 + 1)) { PHASE_PROLOGUE
        pg8::EpiIn E{U, UB_P, (1u << 0) | (1u << 1) | (1u << 6) | (1u << 7), C2, 13, MISCF};
        run_gemm(lds, H, 1024, WIN, 1024, NWIN_B, 1024, G, bx, tid, E);
    }
    SEAM(B0 + 1);
    if (IN(B0 + 2)) { PHASE_PROLOGUE rope_phase(U, MISCF, IKB, KPART, RC, RS, lds, G, bx, tid, lane, wave); }
    SEAM(B0 + 2);
    if (IN(B0 + 3)) { PHASE_PROLOGUE moba_gate_phase(U, KPART, SELM, lds, G, bx, tid, lane, wave); dsa_topk_phase(U, IKB, MISCF, MASKT, lds, G, bx, vcu, tid, lane, wave); }
    SEAM(B0 + 3);
    if (IN(B0 + 4)) { PHASE_PROLOGUE attn_bd_phase((char*)lds_raw, U, Y2, Y3, SELM, MASKT, G, vcu, tid); }
    SEAM(B0 + 4);
    if (IN(B0 + 5)) { PHASE_PROLOGUE
        pg8::EpiIn E{U, UA_P, (1u << 6) | (1u << 7), C2, -1, nullptr};
        run_gemm(lds, H, 1024, WIN + (size_t)NWIN_B * 1024, 1024, NWIN_A, 1024, G, bx, tid, E);
    }
    SEAM(B0 + 5);
    if (IN(B0 + 6)) { PHASE_PROLOGUE ssd_prep_phase(U, MISCF, args.in[3] + (size_t)L * 4096, args.in[4] + L * 1024, args.in[5] + L * 8, args.in[6] + L * 8, args.in[9] + L * 8, CF2, ACS, DTA, XT, BT, BC, CC, lds, G, bx, tid, lane, wave); }
    SEAM(B0 + 6);
    if (IN(B0 + 7)) { PHASE_PROLOGUE ssd_state_phase(XT, BT, ACS, DTA, STATE, lds, G, bx, tid, lane, wave); }
    SEAM(B0 + 7);
    if (IN(B0 + 8)) { PHASE_PROLOGUE ssd_scan_phase(STATE, ACS, PREV, G, bx, tid); }
    SEAM(B0 + 8);
    if (IN(B0 + 9)) { PHASE_PROLOGUE ssd_out_phase(U, XT, BC, CC, PREV, ACS, DTA, args.in[7] + L * 8, Y0, G, bx, lane, wave); }
    SEAM(B0 + 9);
    if (IN(B0 + 10)) { PHASE_PROLOGUE
        ssd_gnorm_phase(Y0, args.in[8] + L * 512, gw, NGW, lane);
        tr_items(args.in[10] + (size_t)L * 1024 * 4096, 4096, 1024, WG, 4096, MapId{0}, scr, gw, NGW, lane);
        for (int n = 0; n < 4; ++n) tr_items(args.in[12] + ((size_t)L * 4 + n) * 512 * 1024, 1024, 512, WB + (size_t)n * 1024 * 512, 1024, MapId{0}, scr, gw, NGW, lane);
        tr_items(args.in[13] + (size_t)L * 1024 * 1024, 1024, 1024, WO, 1024, MapId{0}, scr, gw, NGW, lane);
        tr_items(args.in[16] + (size_t)L * 1024 * 5632, 5632, 1024, WF1, 5632, MapFfn{}, scr, gw, NGW, lane);
        tr_items(args.in[17] + (size_t)L * FFH * 1024, 1024, FFH, WF2, 1024, MapId{0}, scr, gw, NGW, lane);
        __syncthreads();
    }
    if (IN(B0 + 10)) { PHASE_PROLOGUE attn_fox_phase((char*)lds_raw, U, Y1, CF2, G, vcu, tid); }
    SEAM(B0 + 10);
#pragma unroll
    for (int n = 0; n < 4; ++n) {
        if (IN(B0 + 11 + 2 * n)) { PHASE_PROLOGUE
            pg8::EpiSig E{GB, 1024, args.in[11] + (size_t)L * 4096 + n * 1024};
            run_gemm(lds, H, 1024, WG + (size_t)n * 1024 * 1024, 1024, 1024, 1024, G, bx, tid, E);
        }
        SEAM(B0 + 11 + 2 * n);
        if (IN(B0 + 12 + 2 * n)) { PHASE_PROLOGUE
            pg8::EpiBranch E{GB, MG, 1024, n == 0, n == 3};
            run_gemm(lds, Y + (size_t)n * T * 512, 512, WB + (size_t)n * 1024 * 512, 512, 1024, 512, G, bx, tid, E);
        }
        SEAM(B0 + 12 + 2 * n);
    }
    if (IN(B0 + 19)) { PHASE_PROLOGUE pg8::EpiF32 E{MG, 1024}; run_gemm(lds, GB, 1024, WO, 1024, 1024, 1024, G, bx, tid, E); }
    SEAM(B0 + 19);
    if (IN(B0 + 20)) { PHASE_PROLOGUE norm_res_rows(MG, args.in[14] + L * 1024, (L == 0) ? args.in[0] : (const float*)args.out, args.out, args.in[15] + L * 1024, H, gw, NGW, lane); }
    SEAM(B0 + 20);
    if (IN(B0 + 21)) { PHASE_PROLOGUE pg8::EpiSwi E{HP, FFH}; run_gemm(lds, H, 1024, WF1, 1024, 5632, 1024, G, bx, tid, E); }
    SEAM(B0 + 21);
    if (IN(B0 + 22)) { PHASE_PROLOGUE pg8::EpiF32 E{MG, 1024}; run_gemm(lds, HP, FFH, WF2, FFH, 1024, FFH, G, bx, tid, E); }
    SEAM(B0 + 22);
    if (IN(B0 + 23)) { PHASE_PROLOGUE
        norm_res_rows(MG, args.in[18] + L * 1024, args.out, args.out, (L == 0) ? args.in[1] + 1024 : nullptr, H, gw, NGW, lane);
        if (L == 0) tr_items(args.in[2] + (size_t)1024 * 6484, 6484, 1024, WIN, NWIN, MapWin{}, scr, gw, NGW, lane);
    }
    if (L == 0) SEAM(B0 + 23);
}

__global__ void __launch_bounds__(NTHR, 2) hybrid_fwd(Args args) {
    extern __shared__ __attribute__((aligned(16))) unsigned char lds_raw[];
    LAS unsigned char* lds = (LAS unsigned char*)lds_raw;
    for (int u = threadIdx.x; u < (LDS_BYTES - LDSCTL_OFF) / 4; u += NTHR) ((LAS unsigned*)(lds + LDSCTL_OFF))[u] = 0u;
    __syncthreads();
    const int lo = args.ph_lo, hi = args.ph_hi;
    XcdBarrier bar; bar.bar = (unsigned*)(args.ws + WS_CTL) + CW_BAR; bar.x = 0; bar.st = nullptr;
    if (hi - lo > 1) bar = xcd_barrier_post((unsigned*)(args.ws + WS_CTL) + CW_BAR, (volatile LAS unsigned*)(lds + MISC_OFF) + 8);
    run_layer<0>(args, lo, hi, bar, lds, lds_raw);
    run_layer<1>(args, lo, hi, bar, lds, lds_raw);
}

#ifndef MK_PER_PHASE
#define MK_PER_PHASE 0
#endif
extern "C" void kernel_launch(void* const* d_in, const int* in_sizes, int n_in, void* d_out, int out_size, void* d_ws, size_t ws_size, hipStream_t stream) {
    static int grid = 0;
    if (grid == 0) {
        if (n_in != 19 || in_sizes[0] != T * DMODEL || out_size != T * DMODEL || ws_size < WS_END) { fprintf(stderr, "kernel_launch: unexpected shapes (n_in %d, in0 %d, out %d, ws %zu); nothing launched\n", n_in, n_in > 0 ? in_sizes[0] : -1, out_size, ws_size); grid = -1; return; }
        int dev = 0, cus = 0, per_cu = 0;
        if (hipGetDevice(&dev) != hipSuccess || hipDeviceGetAttribute(&cus, hipDeviceAttributeMultiprocessorCount, dev) != hipSuccess) { grid = -1; return; }
        if (hipFuncSetAttribute((const void*)hybrid_fwd, hipFuncAttributeMaxDynamicSharedMemorySize, LDS_BYTES) != hipSuccess) { fprintf(stderr, "kernel_launch: hipFuncSetAttribute failed\n"); grid = -1; return; }
        if (hipOccupancyMaxActiveBlocksPerMultiprocessor(&per_cu, (const void*)hybrid_fwd, NTHR, LDS_BYTES) != hipSuccess || per_cu < 1) { fprintf(stderr, "kernel_launch: occupancy query says %d\n", per_cu); per_cu = 1; }
        (void)hipGetLastError();
        grid = cus * 1;
        if (grid > 256) grid = 256;
    }
    if (grid < 0) return;
    (void)hipMemsetAsync((char*)d_ws + WS_CTL, 0, CTL_ZERO_BYTES, stream);
    Args a{};
    for (int i = 0; i < 19; ++i) a.in[i] = (const float*)d_in[i];
    a.out = (float*)d_out; a.ws = (unsigned char*)d_ws;
#if MK_PER_PHASE
    for (int p = 0; p < N_PHASES; ++p) { a.ph_lo = p; a.ph_hi = p + 1; hipLaunchKernelGGL(hybrid_fwd, dim3(grid), dim3(NTHR), LDS_BYTES, stream, a); }
#else
    a.ph_lo = 0; a.ph_hi = N_PHASES;
    void* kargs[] = {&a};
    hipError_t e = hipLaunchCooperativeKernel((const void*)hybrid_fwd, dim3(grid), dim3(NTHR), kargs, LDS_BYTES, stream);
    if (e != hipSuccess) fprintf(stderr, "kernel_launch: cooperative launch failed: %s (grid %d)\n", hipGetErrorString(e), grid);
#endif
}
```

```cpp
#include <hip/hip_runtime.h>
#include <hip/hip_cooperative_groups.h>
#include <hip/hip_bf16.h>
#include <cstdio>
#include <cstdint>
#include <cmath>
namespace cg = cooperative_groups;
namespace pg8 {
#define PG8_LAS __attribute__((address_space(3)))
typedef unsigned short bf16_t;
typedef short bf16x8 __attribute__((ext_vector_type(8)));
typedef float f32x4 __attribute__((ext_vector_type(4)));
typedef unsigned u32x4 __attribute__((ext_vector_type(4)));
constexpr int BM = 256, BK = 64, HALF = 128, HTB = HALF * BK * 2  , STAGE_BYTES = 8 * HTB, NXCD = 8, WGM = 8;

__host__ __device__ __forceinline__ int lds_byte(int r, int c) { const int st = (r >> 4) * 2 + (c >> 5), rr = r & 15, cc = c & 31, ob = rr * 64 + cc * 2; return st * 1024 + (ob ^ (((ob >> 9) & 1) << 5)); }
__host__ __device__ __forceinline__ void stage_rc(int b, int& R, int& C) { const int st = b / 1024, sb = b % 1024, swz = sb ^ (((sb >> 9) & 1) << 5); R = (st >> 1) * 16 + swz / 64; C = (st & 1) * 32 + (swz % 64) / 2; }
__host__ __device__ __forceinline__ int perm32(int rho) { const int n = rho >> 4, i = rho & 15; return 8 * (i >> 2) + 4 * n + (i & 3); }

struct Unit { int pm, pn; };
struct Gemm { const bf16_t* A; const bf16_t* Bt; int M, N, K, lda, ldb; };

struct StaticOrder {
    int nM, nN, nwg, G, c;
    __host__ __device__ void init(int M, int N, int G_, int c_) { nM = M / BM; nN = N / BM; nwg = nM * nN; G = G_; c = c_; }
    __host__ __device__ bool next(int i, Unit& u) const {
        const long L = (long)i * G + c; if (L >= nwg) return false;
        int wgid = (int)L; { const int q = nwg / NXCD, r = nwg % NXCD, xcd = wgid % NXCD, off = wgid / NXCD; wgid = (xcd < r ? xcd * (q + 1) : r * (q + 1) + (xcd - r) * q) + off; }
        const int nig = WGM * nN, gid = wgid / nig, fm = gid * WGM, gsz = (nM - fm) < WGM ? (nM - fm) : WGM;
        u.pm = fm + ((wgid % nig) % gsz); u.pn = (wgid % nig) / gsz; return true;
    }
    __device__ __forceinline__ void a_ready(const Unit&) const {}
    __device__ __forceinline__ void done(const Unit&) const {}
};
typedef float f32x2 __attribute__((ext_vector_type(2)));
typedef __bf16 bf16x2_t __attribute__((ext_vector_type(2)));
typedef unsigned u32x2 __attribute__((ext_vector_type(2)));
__device__ __forceinline__ unsigned cvt_pk_bf16(float lo, float hi) { f32x2 v = {lo, hi}; bf16x2_t b = __builtin_convertvector(v, bf16x2_t); return __builtin_bit_cast(unsigned, b); }
__device__ __forceinline__ float bf_lo(unsigned w) { return __builtin_bit_cast(float, w << 16); }
__device__ __forceinline__ float bf_hi(unsigned w) { return __builtin_bit_cast(float, w & 0xffff0000u); }
__device__ __forceinline__ float sigmoidf_(float x) { return 1.0f / (1.0f + __expf(-x)); }

struct EpiIn {
    static constexpr bool PERM = true, AFTER_DRAIN = false;
    bf16_t* U; int ldu; unsigned scale_tiles; float scale; int misc_tile; float* misc;
    __device__ __forceinline__ void operator()(const f32x4 (&acc)[2][2][4][2], const Unit& u, int wr, int wc, int fr, int fq) const {
        const int row0 = u.pm * BM + wr * 64 + fr;
        if (u.pn == misc_tile) {
#pragma unroll
            for (int ai = 0; ai < 2; ++ai)
#pragma unroll
                for (int m = 0; m < 4; ++m) { float* rowp = misc + (size_t)(row0 + ai * HALF + m * 16) * 128 + wc * 32 + 8 * fq;
                    *(f32x4*)(rowp) = acc[ai][0][m][0]; *(f32x4*)(rowp + 4) = acc[ai][0][m][1]; }
            return;
        }
        const float sc = ((scale_tiles >> u.pn) & 1u) ? scale : 1.0f;
        const int col0 = u.pn * BM + wc * 32 + 8 * fq;
#pragma unroll
        for (int ai = 0; ai < 2; ++ai)
#pragma unroll
            for (int m = 0; m < 4; ++m) { bf16_t* rowp = U + (size_t)(row0 + ai * HALF + m * 16) * ldu + col0;
#pragma unroll
                for (int bj = 0; bj < 2; ++bj) { const f32x4 v0 = acc[ai][bj][m][0] * sc, v1 = acc[ai][bj][m][1] * sc;
                    u32x4 w; w.x = cvt_pk_bf16(v0[0], v0[1]); w.y = cvt_pk_bf16(v0[2], v0[3]); w.z = cvt_pk_bf16(v1[0], v1[1]); w.w = cvt_pk_bf16(v1[2], v1[3]);
                    *(u32x4*)(rowp + bj * HALF) = w; } }
    }
};
struct EpiSig {
    static constexpr bool PERM = true, AFTER_DRAIN = false;
    bf16_t* O; int ldc; const float* bias;
    __device__ __forceinline__ void operator()(const f32x4 (&acc)[2][2][4][2], const Unit& u, int wr, int wc, int fr, int fq) const {
        const int row0 = u.pm * BM + wr * 64 + fr, col0 = u.pn * BM + wc * 32 + 8 * fq;
        f32x4 bv[2][2];
#pragma unroll
        for (int bj = 0; bj < 2; ++bj)
#pragma unroll
            for (int n = 0; n < 2; ++n) bv[bj][n] = *(const f32x4*)(bias + col0 + bj * HALF + 4 * n);
#pragma unroll
        for (int ai = 0; ai < 2; ++ai)
#pragma unroll
            for (int m = 0; m < 4; ++m) { bf16_t* rowp = O + (size_t)(row0 + ai * HALF + m * 16) * ldc + col0;
#pragma unroll
                for (int bj = 0; bj < 2; ++bj) { f32x4 v0 = acc[ai][bj][m][0] + bv[bj][0], v1 = acc[ai][bj][m][1] + bv[bj][1];
#pragma unroll
                    for (int j = 0; j < 4; ++j) { v0[j] = sigmoidf_(v0[j]); v1[j] = sigmoidf_(v1[j]); }
                    u32x4 w; w.x = cvt_pk_bf16(v0[0], v0[1]); w.y = cvt_pk_bf16(v0[2], v0[3]); w.z = cvt_pk_bf16(v1[0], v1[1]); w.w = cvt_pk_bf16(v1[2], v1[3]);
                    *(u32x4*)(rowp + bj * HALF) = w; } }
    }
};
struct EpiBranch {
    static constexpr bool PERM = false, AFTER_DRAIN = false;
    bf16_t* G; float* Mg; int ldc; int first, last;
    __device__ __forceinline__ void operator()(const f32x4 (&acc)[2][2][4][2], const Unit& u, int wr, int wc, int fr, int fq) const {
        const int row0 = u.pm * BM + wr * 64 + fr, col0 = u.pn * BM + wc * 32 + 4 * fq;
#pragma unroll
        for (int ai = 0; ai < 2; ++ai)
#pragma unroll
            for (int m = 0; m < 4; ++m) { const size_t ro = (size_t)(row0 + ai * HALF + m * 16) * ldc + col0;
#pragma unroll
                for (int bj = 0; bj < 2; ++bj)
#pragma unroll
                    for (int n = 0; n < 2; ++n) { const size_t off = ro + bj * HALF + n * 16;
                        const u32x2 gw = *(const u32x2*)(G + off);
                        f32x4 v = acc[ai][bj][m][n]; v[0] *= bf_lo(gw.x); v[1] *= bf_hi(gw.x); v[2] *= bf_lo(gw.y); v[3] *= bf_hi(gw.y);
                        if (!first) v = v + *(const f32x4*)(Mg + off);
                        if (last) { u32x2 w; w.x = cvt_pk_bf16(v[0], v[1]); w.y = cvt_pk_bf16(v[2], v[3]); *(u32x2*)(G + off) = w; }
                        else *(f32x4*)(Mg + off) = v; } }
    }
};
struct EpiF32 {
    static constexpr bool PERM = false, AFTER_DRAIN = false;
    float* C; int ldc;
    __device__ __forceinline__ void operator()(const f32x4 (&acc)[2][2][4][2], const Unit& u, int wr, int wc, int fr, int fq) const {
        const int row0 = u.pm * BM + wr * 64 + fr, col0 = u.pn * BM + wc * 32 + 4 * fq;
#pragma unroll
        for (int ai = 0; ai < 2; ++ai)
#pragma unroll
            for (int m = 0; m < 4; ++m) { float* rowp = C + (size_t)(row0 + ai * HALF + m * 16) * ldc + col0;
#pragma unroll
                for (int bj = 0; bj < 2; ++bj)
#pragma unroll
                    for (int n = 0; n < 2; ++n) *(f32x4*)(rowp + bj * HALF + n * 16) = acc[ai][bj][m][n]; }
    }
};
struct EpiSwi {
    static constexpr bool PERM = true, AFTER_DRAIN = false;
    bf16_t* O; int ldc;
    __device__ __forceinline__ void operator()(const f32x4 (&acc)[2][2][4][2], const Unit& u, int wr, int wc, int fr, int fq) const {
        const int row0 = u.pm * BM + wr * 64 + fr, col0 = u.pn * HALF + wc * 32 + 8 * fq;
#pragma unroll
        for (int ai = 0; ai < 2; ++ai)
#pragma unroll
            for (int m = 0; m < 4; ++m) { bf16_t* rowp = O + (size_t)(row0 + ai * HALF + m * 16) * ldc + col0;
                f32x4 v0 = acc[ai][0][m][0], v1 = acc[ai][0][m][1]; const f32x4 u0 = acc[ai][1][m][0], u1 = acc[ai][1][m][1];
#pragma unroll
                for (int j = 0; j < 4; ++j) { v0[j] = v0[j] * sigmoidf_(v0[j]) * u0[j]; v1[j] = v1[j] * sigmoidf_(v1[j]) * u1[j]; }
                u32x4 w; w.x = cvt_pk_bf16(v0[0], v0[1]); w.y = cvt_pk_bf16(v0[2], v0[3]); w.z = cvt_pk_bf16(v1[0], v1[1]); w.w = cvt_pk_bf16(v1[2], v1[3]);
                *(u32x4*)(rowp) = w; }
    }
};

template <class Epi, class Sched, bool ALIGN_EPI = false, bool SP2 = false>
__device__ __forceinline__ void gemm_phase(PG8_LAS unsigned char* lds, const Gemm g, const Sched& S, const Epi& E, const int tid_in) {
    const int tid = tid_in, wid = __builtin_amdgcn_readfirstlane(tid >> 6), lane = tid & 63, wr = wid >> 2, wc = wid & 3, fr = lane & 15, fq = lane >> 4;
    const int K = g.K, nt = K / BK;
    unsigned voffA[2], voffB[2];
#pragma unroll
    for (int i = 0; i < 2; ++i) { int R, C; stage_rc(tid * 16 + i * 8192, R, C); const int Rb = Epi::PERM ? ((R & ~31) + perm32(R & 31)) : R;
        voffA[i] = (unsigned)(R * g.lda + C) * 2u; voffB[i] = (unsigned)(Rb * g.ldb + C) * 2u; }
    const size_t kstep = (size_t)(BK * 2);
    const size_t hstepA = (size_t)HALF * g.lda * 2, hstepB = (size_t)HALF * g.ldb * 2;
    const size_t tstepA = 2 * hstepA, tstepB = 2 * hstepB;
    const unsigned ldsw = (unsigned)wid * 1024u;
    const int aoff = lds_byte(wr * 64 + fr, fq * 8), boff = lds_byte(wc * 32 + fr, fq * 8);
#define PG8_SA(b, h) (((b) * 2 + (h)) * HTB)
#define PG8_SB(b, h) ((4 + (b) * 2 + (h)) * HTB)
#define PG8_STAGE(bufoff, gbase, voff) do { _Pragma("unroll") for (int _i = 0; _i < 2; ++_i) \
        __builtin_amdgcn_global_load_lds((const unsigned*)((const char*)(gbase) + (voff)[_i]), (PG8_LAS unsigned*)(lds + (bufoff) + ldsw + _i * 8192), 16, 0, 0); } while (0)
#define PG8_LDA(dst, b, h) do { _Pragma("unroll") for (int m = 0; m < 4; ++m) _Pragma("unroll") for (int k = 0; k < 2; ++k) dst[m][k] = *(const PG8_LAS bf16x8*)(lds + PG8_SA(b, h) + aoff + m * 2048 + k * 1024); } while (0)
#define PG8_LDB(dst, b, h) do { _Pragma("unroll") for (int n = 0; n < 2; ++n) _Pragma("unroll") for (int k = 0; k < 2; ++k) dst[n][k] = *(const PG8_LAS bf16x8*)(lds + PG8_SB(b, h) + boff + n * 2048 + k * 1024); } while (0)
#define PG8_MMA(ai, bj, At, Bt) do { __builtin_amdgcn_s_setprio(1); _Pragma("unroll") for (int m = 0; m < 4; ++m) _Pragma("unroll") for (int n = 0; n < 2; ++n) _Pragma("unroll") for (int k = 0; k < 2; ++k) \
        acc[ai][bj][m][n] = __builtin_amdgcn_mfma_f32_16x16x32_bf16(Bt[n][k], At[m][k], acc[ai][bj][m][n], 0, 0, 0); __builtin_amdgcn_s_setprio(0); } while (0)
#define PG8_WAIT_V(n) asm volatile("s_waitcnt vmcnt(" #n ")" ::: "memory")
#define PG8_WAIT_L(n) asm volatile("s_waitcnt lgkmcnt(" #n ")" ::: "memory")
#define PG8_BAR __builtin_amdgcn_s_barrier()
#define PG8_SCHED __builtin_amdgcn_sched_barrier(0)
    Unit cur, nxt; int ui = 0;
    if (!S.next(0, cur)) return;
    f32x4 acc[2][2][4][2];
#pragma unroll
    for (int a = 0; a < 2; ++a)
#pragma unroll
        for (int b = 0; b < 2; ++b)
#pragma unroll
            for (int m = 0; m < 4; ++m)
#pragma unroll
                for (int n = 0; n < 2; ++n) acc[a][b][m][n] = (f32x4){0.f, 0.f, 0.f, 0.f};
    bf16x8 At[4][2], B0[2][2], B1[2][2];
    const char* cA = (const char*)g.A + (size_t)cur.pm * tstepA; const char* cB = (const char*)g.Bt + (size_t)cur.pn * tstepB;
    S.a_ready(cur);
    if constexpr (SP2) {
        PG8_STAGE(PG8_SB(0, 0), cB, voffB); PG8_STAGE(PG8_SB(0, 1), cB + hstepB, voffB); PG8_STAGE(PG8_SA(0, 0), cA, voffA); PG8_STAGE(PG8_SA(0, 1), cA + hstepA, voffA);
        if (wr == 1) PG8_BAR;
        PG8_WAIT_V(2); PG8_BAR;
        PG8_STAGE(PG8_SB(1, 0), cB + kstep, voffB); PG8_STAGE(PG8_SA(1, 0), cA + kstep, voffA); PG8_STAGE(PG8_SB(1, 1), cB + hstepB + kstep, voffB);
        PG8_WAIT_V(6); PG8_BAR;
    } else {
        PG8_STAGE(PG8_SB(0, 0), cB, voffB); PG8_STAGE(PG8_SA(0, 0), cA, voffA); PG8_STAGE(PG8_SB(0, 1), cB + hstepB, voffB); PG8_STAGE(PG8_SA(0, 1), cA + hstepA, voffA);
        if (wr == 1) PG8_BAR;
        PG8_WAIT_V(4); PG8_BAR;
        PG8_STAGE(PG8_SB(1, 0), cB + kstep, voffB); PG8_STAGE(PG8_SA(1, 0), cA + kstep, voffA); PG8_STAGE(PG8_SB(1, 1), cB + hstepB + kstep, voffB);
        PG8_WAIT_V(6); PG8_BAR;
    }
    for (;;) {
        const bool has_next = S.next(ui + 1, nxt);
        const char* nA = has_next ? (const char*)g.A + (size_t)nxt.pm * tstepA : cA; const char* nB = has_next ? (const char*)g.Bt + (size_t)nxt.pn * tstepB : cB;
        for (int t = 0; t < nt; t += 2) {
            const bool last = (t == nt - 2);
            const char* a1 = cA + (size_t)(t + 1) * kstep;
            const char* a2 = last ? nA : cA + (size_t)(t + 2) * kstep; const char* b2 = last ? nB : cB + (size_t)(t + 2) * kstep;
            const char* a3 = a2 + kstep; const char* b3 = b2 + kstep;
            if (last && has_next) S.a_ready(nxt);
            if constexpr (SP2) {
            PG8_LDB(B0, 0, 0); PG8_LDB(B1, 0, 1); PG8_SCHED; PG8_LDA(At, 0, 0); PG8_STAGE(PG8_SA(1, 1), a1 + hstepA, voffA);
            PG8_WAIT_V(8); PG8_WAIT_L(0); PG8_BAR; PG8_MMA(0, 0, At, B0); PG8_MMA(0, 1, At, B1); PG8_BAR; PG8_SCHED;
            PG8_LDA(At, 0, 1); PG8_STAGE(PG8_SB(0, 0), b2, voffB); PG8_STAGE(PG8_SB(0, 1), b2 + hstepB, voffB); PG8_STAGE(PG8_SA(0, 0), a2, voffA);
            PG8_WAIT_V(8); PG8_WAIT_L(0); PG8_BAR; PG8_MMA(1, 0, At, B0); PG8_MMA(1, 1, At, B1); PG8_BAR; PG8_SCHED;
            PG8_LDB(B0, 1, 0); PG8_LDB(B1, 1, 1); PG8_SCHED; PG8_LDA(At, 1, 0); PG8_STAGE(PG8_SA(0, 1), a2 + hstepA, voffA);
            PG8_WAIT_V(8); PG8_WAIT_L(0); PG8_BAR; PG8_MMA(0, 0, At, B0); PG8_MMA(0, 1, At, B1); PG8_BAR; PG8_SCHED;
            PG8_LDA(At, 1, 1); PG8_STAGE(PG8_SB(1, 0), b3, voffB); PG8_STAGE(PG8_SB(1, 1), b3 + hstepB, voffB); PG8_STAGE(PG8_SA(1, 0), a3, voffA);
            PG8_WAIT_V(8); PG8_WAIT_L(0); PG8_BAR; PG8_MMA(1, 0, At, B0); PG8_MMA(1, 1, At, B1); PG8_BAR; PG8_SCHED;
            } else {
            PG8_LDB(B0, 0, 0); PG8_SCHED; PG8_LDA(At, 0, 0); PG8_STAGE(PG8_SA(1, 1), a1 + hstepA, voffA);
            PG8_WAIT_L(8); PG8_BAR; PG8_WAIT_L(0); PG8_MMA(0, 0, At, B0); PG8_BAR; PG8_SCHED;
            PG8_LDB(B1, 0, 1); PG8_STAGE(PG8_SB(0, 0), b2, voffB);
            PG8_BAR; PG8_WAIT_L(0); PG8_MMA(0, 1, At, B1); PG8_BAR;
            PG8_LDA(At, 0, 1); PG8_STAGE(PG8_SA(0, 0), a2, voffA);
            PG8_BAR; PG8_WAIT_L(0); PG8_MMA(1, 0, At, B0); PG8_BAR; PG8_SCHED;
            PG8_STAGE(PG8_SB(0, 1), b2 + hstepB, voffB);
            PG8_WAIT_V(6); PG8_BAR; PG8_MMA(1, 1, At, B1); PG8_BAR;
            PG8_LDB(B0, 1, 0); PG8_SCHED; PG8_LDA(At, 1, 0); PG8_STAGE(PG8_SA(0, 1), a2 + hstepA, voffA);
            PG8_WAIT_L(8); PG8_BAR; PG8_WAIT_L(0); PG8_MMA(0, 0, At, B0); PG8_BAR; PG8_SCHED;
            PG8_LDB(B1, 1, 1); PG8_STAGE(PG8_SB(1, 0), b3, voffB);
            PG8_BAR; PG8_WAIT_L(0); PG8_MMA(0, 1, At, B1); PG8_BAR;
            PG8_LDA(At, 1, 1); PG8_STAGE(PG8_SA(1, 0), a3, voffA);
            PG8_BAR; PG8_WAIT_L(0); PG8_MMA(1, 0, At, B0); PG8_BAR; PG8_SCHED;
            PG8_STAGE(PG8_SB(1, 1), b3 + hstepB, voffB);
            PG8_WAIT_V(6); PG8_BAR; PG8_MMA(1, 1, At, B1); PG8_BAR;
            }
        }
        if constexpr (ALIGN_EPI) { if (wr == 0) PG8_BAR; }
        if constexpr (!Epi::AFTER_DRAIN) { E(acc, cur, wr, wc, fr, fq); S.done(cur); }
        if (!has_next) break;
#pragma unroll
        for (int a = 0; a < 2; ++a)
#pragma unroll
            for (int b = 0; b < 2; ++b)
#pragma unroll
                for (int m = 0; m < 4; ++m)
#pragma unroll
                    for (int n = 0; n < 2; ++n) acc[a][b][m][n] = (f32x4){0.f, 0.f, 0.f, 0.f};
        cur = nxt; cA = nA; cB = nB; ++ui;
        if constexpr (ALIGN_EPI) { if (wr == 1) PG8_BAR; }
    }
    PG8_WAIT_V(0);
    if constexpr (!ALIGN_EPI) { if (wr == 0) PG8_BAR; }
    PG8_BAR;
    if constexpr (Epi::AFTER_DRAIN) { E.fused(acc, cur, wr, wc, fr, fq, lds, wid, lane); S.done(cur); }
#undef PG8_SA
#undef PG8_SB
#undef PG8_STAGE
#undef PG8_LDA
#undef PG8_LDB
#undef PG8_MMA
#undef PG8_WAIT_V
#undef PG8_WAIT_L
#undef PG8_BAR
#undef PG8_SCHED
}
}

#include <hip/hip_bf16.h>
#include <cmath>
namespace attn_body {
using bf16=__hip_bfloat16;
using bf16x8=__attribute__((ext_vector_type(8)))short;
using s16x4=__attribute__((ext_vector_type(4)))short;
using f32x16=__attribute__((ext_vector_type(16)))float;
using u32x4=__attribute__((ext_vector_type(4)))unsigned;
constexpr int BATCH=2,SEQ=8192,D=64;
constexpr int NW=8,QBLK=32,QB=QBLK*NW,KVBLK=64,NQB=SEQ/QB;
constexpr int ATTN_UNIT_ROWS=QB;
__device__ __forceinline__ int crow(int r,int hi){return (r&3)+8*(r>>2)+4*hi;}
#define SBAR() __builtin_amdgcn_sched_barrier(0)
__device__ __forceinline__ void cmask(f32x16&p0,f32x16&p1,int jb,int qrel,int hi){
  const float NEG=-INFINITY; int kb=64*jb+4*hi;
  #pragma unroll
  for(int r=0;r<16;++r){int kv=kb+(r&3)+8*(r>>2); if(kv>qrel)p0[r]=NEG; if(kv+32>qrel)p1[r]=NEG;}
}

constexpr int NSLOT=3, SLOTB=8192;
constexpr int LDS_K=0, LDS_V=NSLOT*SLOTB, LDS_WS=2*NSLOT*SLOTB, LDS_OST=LDS_WS+NW*64*4, LDS_BYTES=LDS_OST+NW*4096, LDS_CF=LDS_BYTES, LDS_TOTAL=LDS_CF+32768;
constexpr float C2=0.125f*1.4426950408889634f;
__device__ __forceinline__ void glds16(const void*gsrc,unsigned lds_dst){unsigned keep;
  asm volatile("s_mov_b32 %0, m0\n\ts_mov_b32 m0, %2\n\ts_nop 0\n\tglobal_load_lds_dwordx4 %1, off\n\ts_mov_b32 m0, %0":"=&s"(keep):"v"(gsrc),"s"(lds_dst):"memory");}
__device__ __forceinline__ void glds4(const void*gsrc,unsigned lds_dst){unsigned keep;
  asm volatile("s_mov_b32 %0, m0\n\ts_mov_b32 m0, %2\n\ts_nop 0\n\tglobal_load_lds_dword %1, off\n\ts_mov_b32 m0, %0":"=&s"(keep):"v"(gsrc),"s"(lds_dst):"memory");}
__device__ __forceinline__ float max3f(float a,float b,float c){float r;asm("v_max3_f32 %0, %1, %2, %3":"=v"(r):"v"(a),"v"(b),"v"(c));return r;}
__device__ __forceinline__ float max2f(float a,float b){float r;asm("v_max_f32_e32 %0, %1, %2":"=v"(r):"v"(a),"v"(b));return r;}
__device__ __forceinline__ float fadd_s(float a,float b){float r;asm("v_add_f32_e32 %0, %1, %2":"=v"(r):"v"(a),"v"(b));return r;}
__device__ __forceinline__ float fsub_s(float a,float b){float r;asm("v_sub_f32_e32 %0, %1, %2":"=v"(r):"v"(a),"v"(b));return r;}
typedef float f32x2_t __attribute__((ext_vector_type(2))); typedef __bf16 bf16x2_t __attribute__((ext_vector_type(2)));
__device__ __forceinline__ unsigned cvtpk_s(float lo,float hi){f32x2_t v={lo,hi};bf16x2_t b=__builtin_convertvector(v,bf16x2_t);return __builtin_bit_cast(unsigned,b);}
#define WAIT_BAR(N) asm volatile("s_waitcnt vmcnt(" #N ") lgkmcnt(0)\n\ts_barrier":::"memory")

__device__ __forceinline__ void qkt(f32x16&p0,f32x16&p1,const char*Kslot,const bf16x8*qr,const f32x16&negm,int r32,int hi){
  const char*kb=Kslot+hi*1024+r32*16;
  #pragma unroll
  for(int d0=0;d0<4;++d0){
    const bf16x8 b0=*reinterpret_cast<const bf16x8*>(kb+d0*2048);
    const bf16x8 b1=*reinterpret_cast<const bf16x8*>(kb+d0*2048+512);
    if(d0==0){p0=__builtin_amdgcn_mfma_f32_32x32x16_bf16(b0,qr[0],negm,0,0,0);p1=__builtin_amdgcn_mfma_f32_32x32x16_bf16(b1,qr[0],negm,0,0,0);}
    else{p0=__builtin_amdgcn_mfma_f32_32x32x16_bf16(b0,qr[d0],p0,0,0,0);p1=__builtin_amdgcn_mfma_f32_32x32x16_bf16(b1,qr[d0],p1,0,0,0);}}
}
typedef __attribute__((address_space(3))) const char* lds_cptr;
typedef short v4i16_t __attribute__((ext_vector_type(4)));
__device__ __forceinline__ void kload8(bf16x8*kf,lds_cptr kp){
  kf[0]=*(const __attribute__((address_space(3))) bf16x8*)(kp);      kf[1]=*(const __attribute__((address_space(3))) bf16x8*)(kp+512);
  kf[2]=*(const __attribute__((address_space(3))) bf16x8*)(kp+2048); kf[3]=*(const __attribute__((address_space(3))) bf16x8*)(kp+2560);
  kf[4]=*(const __attribute__((address_space(3))) bf16x8*)(kp+4096); kf[5]=*(const __attribute__((address_space(3))) bf16x8*)(kp+4608);
  kf[6]=*(const __attribute__((address_space(3))) bf16x8*)(kp+6144); kf[7]=*(const __attribute__((address_space(3))) bf16x8*)(kp+6656);
}
__device__ __forceinline__ void kload2(bf16x8*kf,lds_cptr kp,int j){ kf[2*j]=*(const __attribute__((address_space(3))) bf16x8*)(kp+j*2048); kf[2*j+1]=*(const __attribute__((address_space(3))) bf16x8*)(kp+j*2048+512); }
__device__ __forceinline__ s16x4 vtr(lds_cptr p){ return __builtin_bit_cast(s16x4,__builtin_amdgcn_ds_read_tr16_b64_v4i16((__attribute__((address_space(3))) v4i16_t*)p)); }
__device__ __forceinline__ float rowmax(const f32x16&p0,const f32x16&p1){
  float a=max3f(p0[0],p0[1],p1[0]),b=max3f(p0[2],p0[3],p1[1]);a=max3f(a,p1[2],p1[3]);
  #pragma unroll
  for(int r=4;r<16;r+=4){a=max3f(a,p0[r],p0[r+1]);b=max3f(b,p0[r+2],p0[r+3]);a=max3f(a,p1[r],p1[r+1]);b=max3f(b,p1[r+2],p1[r+3]);}
  const float m=max2f(a,b);
  auto rr=__builtin_amdgcn_permlane32_swap(__float_as_uint(m),__float_as_uint(m),false,false);
  return max2f(__uint_as_float(rr[0]),__uint_as_float(rr[1]));
}
__device__ __forceinline__ void pv(f32x16*o,int vb,bf16x8 pa0,bf16x8 pa1,bf16x8 pa2,bf16x8 pa3){
  #pragma unroll
  for(int d0=0;d0<2;++d0){s16x4 lo[4],hi[4];
    #pragma unroll
    for(int ks=0;ks<4;++ks){
      asm volatile("ds_read_b64_tr_b16 %0,%1 offset:%c2":"=&v"(lo[ks]):"v"(vb),"i"(d0*4096+ks*1024):"memory");
      asm volatile("ds_read_b64_tr_b16 %0,%1 offset:%c2":"=&v"(hi[ks]):"v"(vb),"i"(d0*4096+ks*1024+512):"memory");}
    asm volatile("s_waitcnt lgkmcnt(0)":::"memory");SBAR();
    #define PK(k) (bf16x8){lo[k][0],lo[k][1],lo[k][2],lo[k][3],hi[k][0],hi[k][1],hi[k][2],hi[k][3]}
    o[d0]=__builtin_amdgcn_mfma_f32_32x32x16_bf16(pa0,PK(0),o[d0],0,0,0);
    o[d0]=__builtin_amdgcn_mfma_f32_32x32x16_bf16(pa1,PK(1),o[d0],0,0,0);
    o[d0]=__builtin_amdgcn_mfma_f32_32x32x16_bf16(pa2,PK(2),o[d0],0,0,0);
    o[d0]=__builtin_amdgcn_mfma_f32_32x32x16_bf16(pa3,PK(3),o[d0],0,0,0);
    #undef PK
  }
}


typedef __attribute__((address_space(3))) const float* lds_cfptr;
typedef float f32x4m __attribute__((ext_vector_type(4)));
template<int MODE,bool BAND> __device__ __forceinline__ void tile_mask(f32x16&p0,f32x16&p1,int t,int NT,int qrel,int hi,lds_cfptr cfl,lds_cptr mring){
  const float NEG=-INFINITY;
  const int jb=t-(NT-4); const int dq=qrel-((BAND && jb>=0)?(64*jb+4*hi):-(1<<20));
  if constexpr(MODE==0){
    const __attribute__((address_space(3))) f32x4m* c4=(const __attribute__((address_space(3))) f32x4m*)(cfl+64*t+4*hi);
    #pragma unroll
    for(int g=0;g<4;++g){ const f32x4m a=c4[2*g], bq=c4[8+2*g];
      #pragma unroll
      for(int j=0;j<4;++j){ const int kc=j+8*g; const float v0=p0[4*g+j]-a[j], v1=p1[4*g+j]-bq[j];
        if constexpr(BAND){ p0[4*g+j]=(kc>dq)?NEG:v0; p1[4*g+j]=(kc+32>dq)?NEG:v1; } else { p0[4*g+j]=v0; p1[4*g+j]=v1; } }
      __builtin_amdgcn_sched_barrier(0); }
  }
  if constexpr(MODE==1 || MODE==3){
    if constexpr(BAND){
      #pragma unroll
      for(int r=0;r<16;++r){ const int kc=(r&3)+8*(r>>2); p0[r]=(kc>dq)?NEG:p0[r]; p1[r]=(kc+32>dq)?NEG:p1[r]; } }
  }
  if constexpr(MODE==2){
    const unsigned long long mw=*(const __attribute__((address_space(3))) unsigned long long*)(mring+(t&3)*256);
    const int lo=(int)((unsigned)mw>>(4*hi)), hw=(int)((unsigned)(mw>>32)>>(4*hi));
    #pragma unroll
    for(int r=0;r<16;++r){ const int sh=(r&3)+8*(r>>2);
      p0[r]=(((unsigned)lo>>sh)&1u)?p0[r]:NEG; p1[r]=(((unsigned)hw>>sh)&1u)?p1[r]:NEG; }
  }
}
#ifndef ATTN_STORE16
#define ATTN_STORE16(p,v) (*(u32x4*)(p)=(v))
#endif
template<int THRL,int MODE,int DM,int ODM> __device__ __forceinline__ void attn_unit(int b,int h,int qb,const bf16*Q,const bf16*__restrict__ K,const bf16*__restrict__ V,bf16*O,char*shm,const void*aux,const float*aux2,const int tid_in){
  const int tid=tid_in,lane=tid&63,r32=lane&31,hi=lane>>5; const int wid=__builtin_amdgcn_readfirstlane(tid>>6);
  const long rowbase=(long)b*SEQ; const int q0=qb*QB;
  const bf16*Qw=Q+(rowbase+q0+wid*QBLK)*DM+h*D;
  int t0=0;
  if constexpr(MODE==0){ const float*cf=(const float*)aux+((long)b*8+h)*SEQ; const float smax=sqrtf(aux2[(b*8+h)*2]*aux2[(b*8+h)*2+1]);
    const float bnd=cf[q0]+2.f*smax+40.f; const int ntl=(q0+QB)/KVBLK-4;
    const int j0=lane, j1=lane+64; const bool d0_=(j0<ntl)&&(cf[64*j0+63]>=bnd), d1_=(j1<ntl)&&(cf[64*j1+63]>=bnd);
    t0=(__popcll(__ballot(d0_))+__popcll(__ballot(d1_)))&~1; t0=__builtin_amdgcn_readfirstlane(t0); }
  const bf16*Kh=K+(rowbase+(long)t0*KVBLK)*DM+h*D,*Vh=V+(rowbase+(long)t0*KVBLK)*DM+h*D;
  const unsigned lds0=(unsigned)(uintptr_t)shm;
  float*wsf=(float*)(shm+LDS_WS)+wid*64;
  const bf16*ksrc=Kh+(long)lane*DM+wid*8;
  const bf16*vsrc=Vh+(long)(16*(wid&3)+(lane>>2))*DM+(wid>>2)*32+(lane&3)*8;
  const unsigned kdst=lds0+LDS_K+wid*1024, vdst=lds0+LDS_V+wid*1024;
  #define DMA_K(t,slot) glds16(ksrc+(long)(t)*KVBLK*DM,(unsigned)__builtin_amdgcn_readfirstlane(kdst+(slot)))
  #define DMA_V(t,slot) glds16(vsrc+(long)(t)*KVBLK*DM,(unsigned)__builtin_amdgcn_readfirstlane(vdst+(slot)))
  const int vb0=(int)(lds0+LDS_V)+((lane>>4)&1)*32+(lane&3)*8+(4*hi+((lane&15)>>2))*64;
  const char*Kbase=shm+LDS_K; bf16x8 kf[8];
  const lds_cptr shm3=(lds_cptr)shm; const lds_cptr kp0=shm3+LDS_K+hi*1024+r32*16; const lds_cptr vp0=shm3+LDS_V+((lane>>4)&1)*32+(lane&3)*8+(4*hi+((lane&15)>>2))*64;
  const int NT=(q0+QB)/KVBLK-t0;
  const char*msrc=nullptr; const unsigned mdst=lds0+LDS_CF+wid*1024;
  if constexpr(MODE==2){ msrc=(const char*)((const unsigned long long*)aux+(long)b*128*SEQ+q0+wid*QBLK)+lane*4; }
  #define DMA_M(t) glds4(msrc+(long)(t)*SEQ*8,(unsigned)__builtin_amdgcn_readfirstlane(mdst+(((t)&3)*256)))
  if constexpr(MODE==2){ DMA_M(0);DMA_M(1);DMA_M(2); }
  DMA_K(0,0);DMA_V(0,0);DMA_K(1,SLOTB);
  bf16x8 qr[4];
  #pragma unroll
  for(int d0=0;d0<4;++d0)qr[d0]=*reinterpret_cast<const bf16x8*>(&Qw[(long)r32*DM+d0*16+hi*8]);
  const int qrel=wid*QBLK+r32;
  float cfq2=0.f; unsigned selw=0u;
  const lds_cfptr cfl3=(lds_cfptr)(shm+LDS_CF); const lds_cptr mring=(lds_cptr)shm+LDS_CF+wid*1024+r32*8;
  if constexpr(MODE==0){ const float*cf=(const float*)aux+((long)b*8+h)*SEQ; cfq2=cf[q0+qrel];
    __attribute__((address_space(3))) f32x4m* cw=(__attribute__((address_space(3))) f32x4m*)(shm+LDS_CF);
    for(int i=tid;i<(q0+QB-t0*KVBLK)/4;i+=NW*64) cw[i]=((const f32x4m*)(cf+t0*KVBLK))[i]; }
  if constexpr(MODE==1){ selw=((const unsigned*)aux)[(rowbase+q0+qrel)*8+h]; }
  float mhat=0.f,l_reg=0.f;f32x16 o[2];o[0]=f32x16{};o[1]=f32x16{};f32x16 negm;
  #define SETNEGM(tt) do{ float v_=cfq2-mhat; if constexpr(MODE==1){ if(!((tt)>=NT-4 || ((selw>>((tt)>>2))&1u))) v_=-INFINITY; } \
      _Pragma("unroll") for(int r=0;r<16;++r)negm[r]=v_; asm volatile("":"+v"(negm)); }while(0)
  SETNEGM(0);
  #define CMASK(P0,P1,t) tile_mask<MODE,true>(P0,P1,(t),NT,qrel,hi,cfl3,mring)
  bool resc=false;
  #define START(P0,P1) do{ const float rm=max2f(rowmax(P0,P1),-100.f); resc=false; \
    { const float dl=rm; mhat=fadd_s(mhat,dl); \
      _Pragma("unroll") for(int r=0;r<16;++r){P0[r]=fsub_s(P0[r],dl);P1[r]=fsub_s(P1[r],dl);} \
      SETNEGM(1); } \
    _Pragma("unroll") for(int r=0;r<16;++r)P0[r]=__builtin_amdgcn_exp2f(P0[r]); }while(0)
  #define RESC() do{ if(resc){ asm volatile("s_waitcnt lgkmcnt(0)":::"memory"); \
      _Pragma("unroll") for(int d_=0;d_<2;++d_) _Pragma("unroll") for(int r=0;r<16;++r)o[d_][r]*=wsf[crow(r,hi)]; } }while(0)
  f32x16 pA0,pA1,pB0,pB1;
  int sl_prev=0,sl_cur=0,sl_next=SLOTB;
  #define ROT() do{sl_prev=sl_cur;sl_cur=sl_next;sl_next=(sl_next==(NSLOT-1)*SLOTB)?0:sl_next+SLOTB; }while(0)
  DMA_K(2,2*SLOTB);
  WAIT_BAR(3);
  qkt(pA0,pA1,Kbase,qr,negm,r32,hi);asm volatile("s_nop 15\n\ts_nop 7":"+v"(pA0),"+v"(pA1));CMASK(pA0,pA1,0);
  START(pA0,pA1);
  _Pragma("unroll") for(int r=0;r<16;++r)pA1[r]=__builtin_amdgcn_exp2f(pA1[r]);
  WAIT_BAR(0);
  DMA_K(3,0);DMA_V(1,SLOTB);
  ROT();
  kload8(kf,kp0+sl_cur);
  WAIT_BAR(2);
  s16x4 vlo[8],vhi[8]; u32x4 pw0,pw1,pw2,pw3;
  #define PKW(P,B) cvtpk_s(P[B],P[B+1])
  #define PAF(k) __builtin_bit_cast(bf16x8,pw##k)
  #define VFR(i) (bf16x8){vlo[i][0],vlo[i][1],vlo[i][2],vlo[i][3],vhi[i][0],vhi[i][1],vhi[i][2],vhi[i][3]}
  #define PIN(x) asm volatile("":"+v"(x))
  #define MX3(a,b,c) __builtin_fmaxf(__builtin_fmaxf((a),(b)),(c))
  #define GAPA(MF,A0,A1,A2,A3,W0,W1,PW) do{ MF; sacc+=A0; sacc+=A1; sacc+=A2; sacc+=A3; PIN(sacc); W0; W1; PIN(PW); SBAR(); }while(0)
  #define EX(v) __builtin_amdgcn_exp2f(v)
  #define GAPB(MF,X,B) do{ MF; X[B]=EX(X[B]); X[B+1]=EX(X[B+1]); X[B+2]=EX(X[B+2]); X[B+3]=EX(X[B+3]); PIN(X); SBAR(); }while(0)
  #define VRD(i) do{ vlo[i]=vtr(vp_+(((i)>>2)*4096+((i)&3)*1024)); vhi[i]=vtr(vp_+(((i)>>2)*4096+((i)&3)*1024+512)); }while(0)
  #define KRD(G,j) do{ if(G){ kload2(kf,kp0+sl_next,j); SBAR(); } }while(0)
  #define STEP(C0,C1,P0,P1,t,GK,GV,GL) do{ SBAR(); if constexpr(MODE==2){ if((t)+2<NT){DMA_M((t)+2);} } \
    const lds_cptr vp_=vp0+sl_prev; \
    VRD(0); SBAR(); float sacc=(P0[0]+P0[1]); \
    GAPA(C0=__builtin_amdgcn_mfma_f32_32x32x16_bf16(kf[0],qr[0],negm,0,0,0), P0[2],P0[3],P0[4],P0[5],     pw0[0]=PKW(P0,0), pw0[1]=PKW(P0,2), pw0); \
    VRD(4); SBAR(); GAPA(C1=__builtin_amdgcn_mfma_f32_32x32x16_bf16(kf[1],qr[0],negm,0,0,0), P0[6],P0[7],P0[8],P0[9],     pw0[2]=PKW(P0,4), pw0[3]=PKW(P0,6), pw0); \
    VRD(1); SBAR(); GAPA(C0=__builtin_amdgcn_mfma_f32_32x32x16_bf16(kf[2],qr[1],C0,0,0,0),   P0[10],P0[11],P0[12],P0[13], pw1[0]=PKW(P0,8), pw1[1]=PKW(P0,10), pw1); \
    VRD(5); SBAR(); GAPA(C1=__builtin_amdgcn_mfma_f32_32x32x16_bf16(kf[3],qr[1],C1,0,0,0),   P0[14],P0[15],P1[0],P1[1],   pw1[2]=PKW(P0,12),pw1[3]=PKW(P0,14), pw1); \
    VRD(2); SBAR(); GAPA(C0=__builtin_amdgcn_mfma_f32_32x32x16_bf16(kf[4],qr[2],C0,0,0,0),   P1[2],P1[3],P1[4],P1[5],     pw2[0]=PKW(P1,0), pw2[1]=PKW(P1,2), pw2); \
    VRD(6); SBAR(); GAPA(C1=__builtin_amdgcn_mfma_f32_32x32x16_bf16(kf[5],qr[2],C1,0,0,0),   P1[6],P1[7],P1[8],P1[9],     pw2[2]=PKW(P1,4), pw2[3]=PKW(P1,6), pw2); \
    VRD(3); SBAR(); GAPA(C0=__builtin_amdgcn_mfma_f32_32x32x16_bf16(kf[6],qr[3],C0,0,0,0),   P1[10],P1[11],P1[12],P1[13], pw3[0]=PKW(P1,8), pw3[1]=PKW(P1,10), pw3); \
    VRD(7); SBAR(); GAPA(C1=__builtin_amdgcn_mfma_f32_32x32x16_bf16(kf[7],qr[3],C1,0,0,0),   P1[14],P1[15],0.f,0.f,       pw3[2]=PKW(P1,12),pw3[3]=PKW(P1,14), pw3); \
    l_reg+=sacc; \
    if(GK){DMA_K((t)+3,sl_cur);} if(GV){DMA_V((t)+1,sl_next);} \
    CMASK(C0,C1,t); \
    { float a=MX3(C0[0],C0[1],C1[0]),b=MX3(C0[2],C0[3],C1[1]); a=MX3(a,C1[2],C1[3]); \
      _Pragma("unroll") for(int r=4;r<16;r+=4){a=MX3(a,C0[r],C0[r+1]);b=MX3(b,C0[r+2],C0[r+3]);a=MX3(a,C1[r],C1[r+1]);b=MX3(b,C1[r+2],C1[r+3]);} \
      float rm=__builtin_fmaxf(a,b); { auto rr=__builtin_amdgcn_permlane32_swap(__float_as_uint(rm),__float_as_uint(rm),false,false); rm=__builtin_fmaxf(__uint_as_float(rr[0]),__uint_as_float(rr[1])); } \
      resc=false; \
      if(__builtin_expect(__any(rm>(float)THRL),0)){ const float dl=__builtin_fmaxf(rm,0.f); mhat+=dl; \
        _Pragma("unroll") for(int r=0;r<16;++r){C0[r]-=dl;C1[r]-=dl;} \
        const float f=__builtin_amdgcn_exp2f(-dl); l_reg*=f; if(hi==0)wsf[r32]=f; resc=true; } \
      if constexpr(MODE==1){ if(resc || ((((t)+1)&3)==0)) SETNEGM((t)+1); } else { if(resc) SETNEGM((t)+1); } } \
    SBAR(); \
    GAPB(o[0]=__builtin_amdgcn_mfma_f32_32x32x16_bf16(PAF(0),VFR(0),o[0],0,0,0), C0,0); \
    GAPB(o[1]=__builtin_amdgcn_mfma_f32_32x32x16_bf16(PAF(0),VFR(4),o[1],0,0,0), C0,4); \
    KRD(GL,0); GAPB(o[0]=__builtin_amdgcn_mfma_f32_32x32x16_bf16(PAF(1),VFR(1),o[0],0,0,0), C0,8); \
    KRD(GL,1); GAPB(o[1]=__builtin_amdgcn_mfma_f32_32x32x16_bf16(PAF(1),VFR(5),o[1],0,0,0), C0,12); \
    KRD(GL,2); GAPB(o[0]=__builtin_amdgcn_mfma_f32_32x32x16_bf16(PAF(2),VFR(2),o[0],0,0,0), C1,0); \
    KRD(GL,3); GAPB(o[1]=__builtin_amdgcn_mfma_f32_32x32x16_bf16(PAF(2),VFR(6),o[1],0,0,0), C1,4); \
    GAPB(o[0]=__builtin_amdgcn_mfma_f32_32x32x16_bf16(PAF(3),VFR(3),o[0],0,0,0), C1,8); \
    GAPB(o[1]=__builtin_amdgcn_mfma_f32_32x32x16_bf16(PAF(3),VFR(7),o[1],0,0,0), C1,12); \
    }while(0)
  int t=1;
  #undef CMASK
  #define CMASK(P0,P1,t) tile_mask<MODE,false>(P0,P1,(t),NT,qrel,hi,cfl3,mring)
  for(;t+5<NT;t+=2){
    STEP(pB0,pB1,pA0,pA1,t,true,true,true);     WAIT_BAR(2); RESC(); ROT();
    STEP(pA0,pA1,pB0,pB1,t+1,true,true,true);   WAIT_BAR(2); RESC(); ROT();
  }
  #undef CMASK
  #define CMASK(P0,P1,t) tile_mask<MODE,true>(P0,P1,(t),NT,qrel,hi,cfl3,mring)
  #define ENDW(tt) do{ if((tt)+3<NT){WAIT_BAR(2);} else if((tt)+2<NT){WAIT_BAR(1);} else {WAIT_BAR(0);} }while(0)
  for(;t+1<NT;t+=2){
    STEP(pB0,pB1,pA0,pA1,t,(t+3<NT),(t+1<NT),(t+1<NT));       ENDW(t);   RESC(); ROT();
    STEP(pA0,pA1,pB0,pB1,t+1,(t+4<NT),(t+2<NT),(t+2<NT));     ENDW(t+1); RESC(); ROT();
  }
  STEP(pB0,pB1,pA0,pA1,NT-1,false,false,false); RESC();
  { float sacc=pB0[0]+pB0[1]; _Pragma("unroll") for(int r=2;r<16;++r)sacc+=pB0[r]; _Pragma("unroll") for(int r=0;r<16;++r)sacc+=pB1[r]; l_reg+=sacc;
    pw0=(u32x4){PKW(pB0,0),PKW(pB0,2),PKW(pB0,4),PKW(pB0,6)};pw1=(u32x4){PKW(pB0,8),PKW(pB0,10),PKW(pB0,12),PKW(pB0,14)};pw2=(u32x4){PKW(pB1,0),PKW(pB1,2),PKW(pB1,4),PKW(pB1,6)};pw3=(u32x4){PKW(pB1,8),PKW(pB1,10),PKW(pB1,12),PKW(pB1,14)};
    SBAR(); pv(o,vb0+sl_cur,PAF(0),PAF(1),PAF(2),PAF(3)); }
  #undef PKW
  #undef PAF
  #undef VFR
  #undef PIN
  #undef MX3
  #undef GAPA
  #undef GAPB
  #undef EX
  #undef VRD
  #undef KRD
  #undef STEP
  #undef ENDW
  {auto rr=__builtin_amdgcn_permlane32_swap(__float_as_uint(l_reg),__float_as_uint(l_reg),false,false);l_reg=__uint_as_float(rr[0])+__uint_as_float(rr[1]);}
  if(hi==0)wsf[32+r32]=l_reg;asm volatile("s_waitcnt lgkmcnt(0)":::"memory");
  float rli[16];
  #pragma unroll
  for(int r=0;r<16;++r)rli[r]=__builtin_amdgcn_rcpf(wsf[32+crow(r,hi)]);
  bf16*Ow=O+(rowbase+q0+wid*QBLK)*ODM+h*D;
  { bf16*stg=(bf16*)(shm+LDS_OST)+wid*2048;
    #pragma unroll
    for(int r=0;r<16;++r){const int orow=crow(r,hi);
      #pragma unroll
      for(int d0=0;d0<2;++d0)stg[orow*64+d0*32+r32]=__float2bfloat16(o[d0][r]*rli[r]);}
    asm volatile("s_waitcnt lgkmcnt(0)":::"memory");
    #pragma unroll
    for(int i=0;i<4;++i){const int row=i*8+(lane>>3),ch=lane&7; const u32x4 v=*(const u32x4*)(stg+row*64+ch*8); ATTN_STORE16(Ow+(long)row*ODM+ch*8,v);} }
  asm volatile("s_waitcnt lgkmcnt(0)\n\ts_barrier":::"memory");
  #undef DMA_K
  #undef DMA_V
  #undef DMA_M
  #undef CMASK
  #undef START
  #undef RESC
  #undef ROT
  #undef SETNEGM
}
constexpr int ATTN_LDS_BYTES=LDS_TOTAL;
#undef SBAR
#undef WAIT_BAR
}
#define GAS __attribute__((address_space(1)))
#define LAS __attribute__((address_space(3)))
typedef unsigned short bf16;
typedef unsigned v4u __attribute__((ext_vector_type(4)));
typedef float f32x4 __attribute__((ext_vector_type(4)));
typedef short bf16x8 __attribute__((ext_vector_type(8)));
typedef GAS unsigned gu32;
typedef GAS unsigned long long gu64;
#define RLX_AGENT __ATOMIC_RELAXED, __HIP_MEMORY_SCOPE_AGENT
#define LDS_WAIT() asm volatile("s_waitcnt lgkmcnt(0)" ::: "memory")
#define VM_WAIT() asm volatile("s_waitcnt vmcnt(0)" ::: "memory")
__device__ __forceinline__ unsigned long long rt() { return __builtin_amdgcn_s_memrealtime(); }
__device__ __forceinline__ unsigned f2bf(float f) { unsigned u = __builtin_bit_cast(unsigned, f); return (u + 0x7fffu + ((u >> 16) & 1u)) >> 16; }
__device__ __forceinline__ unsigned pk2(float lo, float hi) { return f2bf(lo) | (f2bf(hi) << 16); }

#define XB_TMO      128
#define XB_XCNT(j)  (256  + 64 * (j))
#define XB_XSUB(j)  (1280 + 64 * (j))
#define XB_XGEN(j)  (2304 + 64 * (j))
#define XB_TOP      3328
#define XB_TOPGEN   3392
#define XCD_BAR_WORDS 3456
#define XB_SPIN_CAP (1u << 18)

__device__ __forceinline__ unsigned xb_ld(unsigned* p)              { return __hip_atomic_load(p, __ATOMIC_RELAXED, __HIP_MEMORY_SCOPE_AGENT); }
__device__ __forceinline__ unsigned xb_add(unsigned* p, unsigned v) { return __hip_atomic_fetch_add(p, v, __ATOMIC_RELAXED, __HIP_MEMORY_SCOPE_AGENT); }
__device__ __forceinline__ unsigned xb_xcc_id() { return (unsigned)__builtin_amdgcn_s_getreg((3 << 11) | 20) & 0xFu; }
#define XB_SPIN(cond, bar) do { unsigned _sp = 0; while (cond) { __builtin_amdgcn_s_sleep(1); \
    if ((++_sp & 255u) == 0u) { if (xb_ld(&(bar)[XB_TMO])) break; if (_sp > XB_SPIN_CAP) { atomicAdd(&(bar)[XB_TMO], 1u); break; } } } } while (0)

struct XcdBarrier {
    unsigned* bar; unsigned x;
    volatile LAS unsigned* st;
};

__device__ __forceinline__ XcdBarrier xcd_barrier_post(unsigned* bar, volatile LAS unsigned* st) {
    XcdBarrier b; b.bar = bar; b.x = xb_xcc_id(); b.st = st;
    if (threadIdx.x == 0) (void)xb_add(&bar[XB_XCNT(b.x)], 1u);
    return b;
}
__device__ __forceinline__ void xcd_barrier_complete(unsigned* bar, unsigned x, unsigned& nloc, unsigned& nx) {
    const unsigned G = gridDim.x * gridDim.y * gridDim.z;
    unsigned sum, cnt, mine, sp = 0u;
    for (;;) {
        sum = 0u; cnt = 0u; mine = 0u;
#pragma unroll
        for (unsigned j = 0; j < 16; ++j) { const unsigned c = xb_ld(&bar[XB_XCNT(j)]); sum += c; cnt += (c > 0u) ? 1u : 0u; mine = (j == x) ? c : mine; }
        if (sum == G) break;
        __builtin_amdgcn_s_sleep(1);
        if ((++sp & 255u) == 0u) { if (xb_ld(&bar[XB_TMO])) break; if (sp > XB_SPIN_CAP) { atomicAdd(&bar[XB_TMO], 1u); break; } }
    }
    nloc = mine > 0u ? mine : 1u; nx = cnt > 0u ? cnt : 1u;
}

__device__ __forceinline__ void xcd_barrier(const XcdBarrier& b) {
    asm volatile("s_waitcnt vmcnt(0)" ::: "memory");
    __syncthreads();
    if (threadIdx.x == 0) {
        unsigned* bar = b.bar;
        __builtin_amdgcn_s_waitcnt(0);
        unsigned nloc = b.st[0], nx = b.st[1];
        if (nloc == 0u) { xcd_barrier_complete(bar, b.x, nloc, nx); b.st[0] = nloc; b.st[1] = nx; }
        const unsigned old = xb_add(&bar[XB_XSUB(b.x)], 1u);
        const unsigned gen = old / nloc;
        if (old + 1u == (gen + 1u) * nloc) {
            __builtin_amdgcn_fence(__ATOMIC_RELEASE, "agent");
            asm volatile("s_waitcnt vmcnt(0)" ::: "memory");
            const unsigned og = xb_add(&bar[XB_TOP], 1u);
            const unsigned tg = og / nx;
            if (og + 1u == (tg + 1u) * nx) xb_add(&bar[XB_TOPGEN], 1u);
            else XB_SPIN(xb_ld(&bar[XB_TOPGEN]) == tg, bar);
            __builtin_amdgcn_fence(__ATOMIC_ACQUIRE, "agent");
            xb_add(&bar[XB_XGEN(b.x)], 1u);
            asm volatile("s_waitcnt vmcnt(0)" ::: "memory");
        } else {
            XB_SPIN(xb_ld(&bar[XB_XGEN(b.x)]) == gen, bar);
            __builtin_amdgcn_fence(__ATOMIC_ACQUIRE, "agent");
            asm volatile("s_waitcnt vmcnt(0)" ::: "memory");
        }
    }
    __syncthreads();
}

constexpr int NWAVES = 8, NTHR = 512;
constexpr int NB = 2, SEQ = 8192, T = NB * SEQ, DMODEL = 1024, FFH = 2816;
constexpr int UB_P = 3328, UA_P = 3072;
constexpr int NWIN = 6656, NWIN_B = 3584, NWIN_A = 3072;
constexpr float EPS = 1e-6f;
constexpr float LOG2E = 1.4426950408889634f;
constexpr float C2 = 0.125f * 1.4426950408889634f;
constexpr size_t MiB = 1u << 20;
constexpr size_t WS_CTL = 0, CTL_ZERO_BYTES = 1 * MiB;
constexpr size_t WS_ROPEC = 1 * MiB, WS_ROPES = 2 * MiB;
constexpr size_t WS_CF2 = 3 * MiB, WS_ACS = WS_CF2 + 512 * 1024, WS_DTA = WS_ACS + 512 * 1024;
constexpr size_t WS_SELM = WS_DTA + 512 * 1024, WS_KPART = WS_SELM + 512 * 1024, WS_IKB = WS_KPART + 512 * 1024;
constexpr size_t WS_WIN = 8 * MiB;
constexpr size_t WS_WG = 8 * MiB, WS_WB = 16 * MiB;
constexpr size_t WS_H = 24 * MiB;
constexpr size_t WS_Y = 56 * MiB;
constexpr size_t WS_U = 120 * MiB;
constexpr size_t WS_XT = 216 * MiB;
constexpr size_t WS_MASK = 232 * MiB;
constexpr size_t WS_BC = 232 * MiB, WS_CC = 240 * MiB;
constexpr size_t WS_MISC = 248 * MiB;
constexpr size_t WS_STATE = WS_Y;
constexpr size_t WS_BT = WS_Y + 16 * MiB, WS_PREV = WS_Y + 24 * MiB;
constexpr size_t WS_G = 120 * MiB, WS_MG = 152 * MiB;
constexpr size_t WS_W2B = 232 * MiB;
constexpr size_t WS_WO = WS_W2B, WS_WF1 = WS_W2B + 2 * MiB, WS_WF2 = WS_W2B + 13 * MiB;
constexpr size_t WS_HP = 56 * MiB;
constexpr size_t WS_END = 256 * MiB;
static_assert(WS_IKB + (size_t)T * 64 * 2 <= WS_WIN && WS_WIN + (size_t)NWIN * 1024 * 2 <= WS_H && WS_U + (size_t)T * UB_P * 2 <= WS_MASK && WS_U + (size_t)T * UA_P * 2 <= WS_XT, "ws map 1");
static_assert(WS_WF2 + (size_t)1024 * FFH * 2 <= WS_END && WS_HP + (size_t)T * FFH * 2 <= WS_MG && WS_MG + (size_t)T * 1024 * 4 <= WS_W2B && WS_MISC + (size_t)T * 128 * 4 <= WS_END, "ws map 2");
constexpr int CW_BAR = 4096;
constexpr int CW_QKN = 8192;
constexpr int CW_WQ = 8448;
constexpr int RING_BYTES = 131072;
constexpr int XTRA_OFF = RING_BYTES;
constexpr int LDSCTL_OFF = RING_BYTES + 8192, MISC_OFF = LDSCTL_OFF + 320;
constexpr int LDS_BYTES = 147456;
static_assert(MISC_OFF + 128 <= LDS_BYTES, "LDS map");

__device__ __forceinline__ float wave_sum(float v) {
#pragma unroll
    for (int o = 1; o < 64; o <<= 1) v += __shfl_xor(v, o);
    return v;
}
__device__ __forceinline__ float bfl(unsigned w) { return __builtin_bit_cast(float, w << 16); }
__device__ __forceinline__ float bfh(unsigned w) { return __builtin_bit_cast(float, w & 0xffff0000u); }
__device__ __forceinline__ float silu_(float x) { return x / (1.0f + __expf(-x)); }
__device__ __forceinline__ float softplus_(float x) { return fmaxf(x, 0.f) + log1pf(expf(-fabsf(x))); }
__device__ __forceinline__ float logsigmoid_(float x) { return fminf(x, 0.f) - log1pf(expf(-fabsf(x))); }

struct MapWin { __device__ __forceinline__ int operator()(int r) const {
    if (r < 3072) return 3088 + r;
    if (r < 3328) return 6160 + (r - 3072);
    if (r < 3584) { const int m = r - 3328; if (m < 64) return 6416 + m; if (m < 68) return 6480 + (m - 64); if (m < 76) return 1536 + (m - 68); if (m < 84) return 3080 + (m - 76); return -1; }
    const int a = r - 3584; if (a < 1536) return a;
    return 1544 + (a - 1536); } };
struct MapId { int off; __device__ __forceinline__ int operator()(int r) const { return off + r; } };
struct MapFfn { __device__ __forceinline__ int operator()(int r) const { const int t = r >> 8, w = r & 255; return w < 128 ? 128 * t + w : FFH + 128 * t + (w - 128); } };
template <class Map> __device__ __forceinline__ void tr_items(const float* W, int N, int K, bf16* WT, int nrows, Map map, LAS float* scr, int gw, int NGW, int lane) {
    const int nrb = nrows / 32, nitems = nrb * (K / 64);
    for (int it = gw; it < nitems; it += NGW) {
        const int rb = it % nrb, kb = it / nrb, r0 = rb * 32, k0 = kb * 64;
        const int c = map(r0 + (lane & 31));
#pragma unroll 8
        for (int i = 0; i < 32; ++i) { const int kk = 2 * i + (lane >> 5); scr[kk * 33 + (lane & 31)] = (c >= 0) ? W[(size_t)(k0 + kk) * N + c] : 0.f; }
        LDS_WAIT(); asm volatile("" ::: "memory");
        const int cc = lane & 7;
#pragma unroll
        for (int j = 0; j < 4; ++j) { const int n = (lane >> 3) + 8 * j; const LAS float* s = scr + (8 * cc) * 33 + n;
            v4u o; o.x = pk2(s[0 * 33], s[1 * 33]); o.y = pk2(s[2 * 33], s[3 * 33]); o.z = pk2(s[4 * 33], s[5 * 33]); o.w = pk2(s[6 * 33], s[7 * 33]);
            *(GAS v4u*)(WT + (size_t)(r0 + n) * K + k0 + 8 * cc) = o; }
        LDS_WAIT(); asm volatile("" ::: "memory");
    }
}
__device__ __forceinline__ void norm_rows_to_bf16(const float* X, const float* g, bf16* Hout, int gw, int NGW, int lane) {
    for (int m = gw; m < T; m += NGW) {
        const f32x4* xr = (const f32x4*)(X + (size_t)m * DMODEL) + lane;
        f32x4 v[4]; float s = 0.f;
#pragma unroll
        for (int j = 0; j < 4; ++j) { v[j] = xr[64 * j]; s += (v[j].x * v[j].x + v[j].y * v[j].y) + (v[j].z * v[j].z + v[j].w * v[j].w); }
        const float rstd = 1.0f / sqrtf(wave_sum(s) * (1.0f / DMODEL) + EPS);
        unsigned long long* o8 = (unsigned long long*)(Hout + (size_t)m * DMODEL) + lane;
#pragma unroll
        for (int j = 0; j < 4; ++j) { const f32x4 gv = ((const f32x4*)g)[lane + 64 * j];
            o8[64 * j] = (unsigned long long)pk2(v[j].x * rstd * gv.x, v[j].y * rstd * gv.y) | ((unsigned long long)pk2(v[j].z * rstd * gv.z, v[j].w * rstd * gv.w) << 32); }
    }
}
__device__ __forceinline__ void norm_res_rows(const float* V, const float* g1, const float* xold, float* xout, const float* g2, bf16* Hout, int gw, int NGW, int lane) {
    for (int m = gw; m < T; m += NGW) {
        const f32x4* vr = (const f32x4*)(V + (size_t)m * DMODEL) + lane; const f32x4* xr = (const f32x4*)(xold + (size_t)m * DMODEL) + lane;
        f32x4 v[4], x[4]; float s = 0.f;
#pragma unroll
        for (int j = 0; j < 4; ++j) { v[j] = vr[64 * j]; x[j] = xr[64 * j]; s += (v[j].x * v[j].x + v[j].y * v[j].y) + (v[j].z * v[j].z + v[j].w * v[j].w); }
        const float rstd = 1.0f / sqrtf(wave_sum(s) * (1.0f / DMODEL) + EPS);
        float s2 = 0.f; f32x4* xo = (f32x4*)(xout + (size_t)m * DMODEL) + lane;
#pragma unroll
        for (int j = 0; j < 4; ++j) { const f32x4 gv = ((const f32x4*)g1)[lane + 64 * j]; x[j] = x[j] + v[j] * rstd * gv; xo[64 * j] = x[j];
            s2 += (x[j].x * x[j].x + x[j].y * x[j].y) + (x[j].z * x[j].z + x[j].w * x[j].w); }
        if (g2) {
            const float rstd2 = 1.0f / sqrtf(wave_sum(s2) * (1.0f / DMODEL) + EPS);
            unsigned long long* o8 = (unsigned long long*)(Hout + (size_t)m * DMODEL) + lane;
#pragma unroll
            for (int j = 0; j < 4; ++j) { const f32x4 gv = ((const f32x4*)g2)[lane + 64 * j];
                o8[64 * j] = (unsigned long long)pk2(x[j].x * rstd2 * gv.x, x[j].y * rstd2 * gv.y) | ((unsigned long long)pk2(x[j].z * rstd2 * gv.z, x[j].w * rstd2 * gv.w) << 32); }
        }
    }
}
__device__ __forceinline__ void rope_tables(float* RC, float* RS, int gtid, int NGT) {
    for (int i = gtid; i < SEQ * 32; i += NGT) { const int pos = i >> 5, k = i & 31;
        const float inv = powf(10000.0f, -(float)(2 * k) / 64.0f); const float ang = (float)pos * inv;
        RC[i] = cosf(ang); RS[i] = sinf(ang); }
}
__device__ __forceinline__ void rope_pair4(unsigned long long& a, unsigned long long& b, const f32x4 c, const f32x4 s, f32x4& o1, f32x4& o2) {
    const unsigned a0 = (unsigned)a, a1 = (unsigned)(a >> 32), b0 = (unsigned)b, b1 = (unsigned)(b >> 32);
    const f32x4 x1 = {bfl(a0), bfh(a0), bfl(a1), bfh(a1)}, x2 = {bfl(b0), bfh(b0), bfl(b1), bfh(b1)};
    o1 = x1 * c - x2 * s; o2 = x2 * c + x1 * s;
    a = (unsigned long long)pk2(o1.x, o1.y) | ((unsigned long long)pk2(o1.z, o1.w) << 32); b = (unsigned long long)pk2(o2.x, o2.y) | ((unsigned long long)pk2(o2.z, o2.w) << 32);
}
__device__ __forceinline__ void rope_phase(bf16* UB, const float* MISCF, bf16* IKB, float* KPART, const float* RC, const float* RS, LAS unsigned char* lds, int G, int bx, int tid, int lane, int wave) {
    LAS float* red = (LAS float*)lds;
    for (int unit = bx; unit < T / 64; unit += G) {
        f32x4 ks1 = {0.f, 0.f, 0.f, 0.f}, ks2 = {0.f, 0.f, 0.f, 0.f};
        const int hd = lane >> 3, d = (lane & 7) * 4;
        for (int i = 0; i < 8; ++i) {
            const int m = unit * 64 + wave * 8 + i, pos = m & (SEQ - 1);
            const f32x4 c = *(const f32x4*)(RC + pos * 32 + d), s = *(const f32x4*)(RS + pos * 32 + d);
            bf16* row = UB + (size_t)m * UB_P;
            const int segs[4] = {0, 512, 1536, 2048};
#pragma unroll
            for (int sg = 0; sg < 4; ++sg) {
                unsigned long long* p1 = (unsigned long long*)(row + segs[sg] + hd * 64 + d); unsigned long long* p2 = (unsigned long long*)(row + segs[sg] + hd * 64 + 32 + d);
                unsigned long long a = *p1, b = *p2; f32x4 o1, o2; rope_pair4(a, b, c, s, o1, o2); *p1 = a; *p2 = b;
                if (sg == 1) { ks1 = ks1 + o1; ks2 = ks2 + o2; }
            }
            if (lane < 32) {
                unsigned long long* p1 = (unsigned long long*)(row + 3072 + hd * 64 + d); unsigned long long* p2 = (unsigned long long*)(row + 3072 + hd * 64 + 32 + d);
                unsigned long long a = *p1, b = *p2; f32x4 o1, o2; rope_pair4(a, b, c, s, o1, o2); *p1 = a; *p2 = b;
            }
            if (lane < 8) {
                const f32x4 x1 = *(const f32x4*)(MISCF + (size_t)m * 128 + d), x2 = *(const f32x4*)(MISCF + (size_t)m * 128 + 32 + d);
                const f32x4 o1 = x1 * c - x2 * s, o2 = x2 * c + x1 * s;
                *(unsigned long long*)(IKB + (size_t)m * 64 + d) = (unsigned long long)pk2(o1.x, o1.y) | ((unsigned long long)pk2(o1.z, o1.w) << 32);
                *(unsigned long long*)(IKB + (size_t)m * 64 + 32 + d) = (unsigned long long)pk2(o2.x, o2.y) | ((unsigned long long)pk2(o2.z, o2.w) << 32);
            }
        }
        *(LAS f32x4*)(red + wave * 512 + hd * 64 + d) = ks1; *(LAS f32x4*)(red + wave * 512 + hd * 64 + 32 + d) = ks2;
        __syncthreads();
        { float a = 0.f;
#pragma unroll
          for (int w = 0; w < 8; ++w) a += red[w * 512 + tid];
          KPART[(size_t)unit * 512 + tid] = a; }
        __syncthreads();
    }
}
__device__ __forceinline__ void moba_gate_phase(const bf16* UB, const float* KPART, unsigned* SELM, LAS unsigned char* lds, int G, int bx, int tid, int lane, int wave) {
    LAS float* km = (LAS float*)lds;
    for (int unit = bx; unit < T / 64; unit += G) {
        const int b = (unit * 64) / SEQ;
        __syncthreads();
#pragma unroll 4
        for (int i = tid; i < 8 * 32 * 64; i += NTHR) { const int dd = i & 63, n = (i >> 6) & 31, hh = i >> 11;
            const float* kp = KPART + (size_t)(b * 128 + 4 * n) * 512 + hh * 64 + dd;
            km[(hh * 32 + n) * 68 + dd] = ((kp[0] + kp[512]) + (kp[1024] + kp[1536])) * (1.0f / 256.0f); }
        __syncthreads();
        const int hd = lane >> 3, j = lane & 7;
#pragma unroll 1
        for (int i = 0; i < 8; ++i) {
            const int m = unit * 64 + wave * 8 + i, pos = m & (SEQ - 1), cur = pos >> 8;
            const v4u* qp = (const v4u*)(UB + (size_t)m * UB_P + hd * 64);
            v4u qv[8];
#pragma unroll
            for (int k = 0; k < 8; ++k) qv[k] = qp[k];
            float val[4];
#pragma unroll
            for (int ii = 0; ii < 4; ++ii) { const int n = j + 8 * ii; const LAS f32x4* kr = (const LAS f32x4*)(km + (hd * 32 + n) * 68); float acc = 0.f;
#pragma unroll
                for (int k = 0; k < 8; ++k) { const f32x4 k0 = kr[2 * k], k1 = kr[2 * k + 1]; const v4u q = qv[k];
                    acc += bfl(q.x) * k0.x + bfh(q.x) * k0.y + bfl(q.y) * k0.z + bfh(q.y) * k0.w + bfl(q.z) * k1.x + bfh(q.z) * k1.y + bfl(q.w) * k1.z + bfh(q.w) * k1.w; }
                val[ii] = (n < cur) ? acc : -INFINITY; asm volatile("" ::: "memory"); }
            unsigned selmask = 0u;
#pragma unroll
            for (int round = 0; round < 3; ++round) {
                float bv = val[0]; int bn = j;
#pragma unroll
                for (int ii = 1; ii < 4; ++ii) { if (val[ii] > bv) { bv = val[ii]; bn = j + 8 * ii; } }
#pragma unroll
                for (int o = 1; o < 8; o <<= 1) { const float ov = __shfl_xor(bv, o); const int on = __shfl_xor(bn, o); if (ov > bv || (ov == bv && on < bn)) { bv = ov; bn = on; } }
                if (bv > -INFINITY) selmask |= 1u << bn;
#pragma unroll
                for (int ii = 0; ii < 4; ++ii) if (bn == j + 8 * ii) val[ii] = -INFINITY;
            }
            if (j == 0) SELM[(size_t)m * 8 + hd] = selmask;
        }
    }
}
constexpr int DSA_CAP = 1792;
typedef __attribute__((ext_vector_type(8))) short dsa_bf16x8;
typedef __attribute__((ext_vector_type(4))) float dsa_f32x4;
struct DsaCtx { dsa_bf16x8 af[4][2]; float wq[4][4]; int b, p0, g4; };
struct DsaB { dsa_bf16x8 b0, b1; };
__device__ __forceinline__ DsaB dsa_loadb(const DsaCtx& c, const bf16* IKB, int key0, int lane) {
    const bf16* kp = IKB + ((size_t)c.b * SEQ + key0 + (lane & 15)) * 64 + 8 * (lane >> 4);
    DsaB r; r.b0 = *(const dsa_bf16x8*)(kp); r.b1 = *(const dsa_bf16x8*)(kp + 32); return r;
}
__device__ __forceinline__ DsaB dsa_loadbc(const DsaCtx& c, const bf16* IKB, int key0, int lane) {
    const bf16* kp = IKB + ((size_t)c.b * SEQ + min(key0 + (lane & 15), SEQ - 1)) * 64 + 8 * (lane >> 4);
    DsaB r; r.b0 = *(const dsa_bf16x8*)(kp); r.b1 = *(const dsa_bf16x8*)(kp + 32); return r;
}
struct DsaB4 { DsaB t[4]; };
__device__ __forceinline__ DsaB4 dsa_loadb4(const DsaCtx& c, const bf16* IKB, int key0g, int lane) {
    DsaB4 r;
#pragma unroll
    for (int j = 0; j < 4; ++j) { const int key = min(key0g + 16 * j + (lane & 15), SEQ - 1);
        const bf16* kp = IKB + ((size_t)c.b * SEQ + key) * 64 + 8 * (lane >> 4);
        r.t[j].b0 = *(const dsa_bf16x8*)(kp); r.t[j].b1 = *(const dsa_bf16x8*)(kp + 32); }
    return r;
}
template <bool CHECK> __device__ __forceinline__ void dsa_tile(const DsaCtx& c, const DsaB& bb, int key0, int lane, unsigned (&mono)[4], unsigned& vbits) {
    dsa_f32x4 a[4];
#pragma unroll
    for (int hh = 0; hh < 4; ++hh) { dsa_f32x4 z = {0.f, 0.f, 0.f, 0.f};
        z = __builtin_amdgcn_mfma_f32_16x16x32_bf16(c.af[hh][0], bb.b0, z, 0, 0, 0);
        a[hh] = __builtin_amdgcn_mfma_f32_16x16x32_bf16(c.af[hh][1], bb.b1, z, 0, 0, 0); }
    vbits = 0xfu;
    if constexpr (CHECK) { const int d = key0 + (lane & 15) - c.p0 - c.g4; vbits = (d <= 0 ? 1u : 0u) | (d <= 1 ? 2u : 0u) | (d <= 2 ? 4u : 0u) | (d <= 3 ? 8u : 0u); }
#pragma unroll
    for (int r = 0; r < 4; ++r) {
        float sc = c.wq[r][0] * __builtin_amdgcn_fmed3f(a[0][r], 0.f, INFINITY);
        sc = fmaf(c.wq[r][1], __builtin_amdgcn_fmed3f(a[1][r], 0.f, INFINITY), sc);
        sc = fmaf(c.wq[r][2], __builtin_amdgcn_fmed3f(a[2][r], 0.f, INFINITY), sc);
        sc = fmaf(c.wq[r][3], __builtin_amdgcn_fmed3f(a[3][r], 0.f, INFINITY), sc);
        const unsigned u = __builtin_bit_cast(unsigned, sc);
        mono[r] = u ^ ((unsigned)((int)u >> 31) | 0x80000000u);
    }
}
__device__ __forceinline__ void dsa_scores(const DsaCtx& c, const DsaB& bb, int key0, int lane, unsigned (&k22)[4], bool (&valid)[4]) {
    unsigned mono[4], vb; dsa_tile<true>(c, bb, key0, lane, mono, vb);
#pragma unroll
    for (int r = 0; r < 4; ++r) { k22[r] = mono[r] >> 10; valid[r] = (vb >> r) & 1u; }
}
__device__ __forceinline__ void dsa_scan(LAS unsigned* hist, int q, unsigned need, int lane, LAS unsigned* o_bin, LAS unsigned* o_above, LAS unsigned* o_cnt) {
    const LAS unsigned* hrow = hist + q * 2048; const int rot = 67 * q;
    unsigned cnt = 0;
#pragma unroll 8
    for (int i = 0; i < 32; ++i) cnt += hrow[(32 * lane + i + rot) & 2047];
    unsigned sfx = cnt;
#pragma unroll
    for (int o = 1; o < 64; o <<= 1) { const unsigned t = __shfl_down(sfx, o); if (lane + o < 64) sfx += t; }
    const unsigned above = sfx - cnt;
    if (lane == 0) { *o_bin = 0u; *o_above = 0u; *o_cnt = 0u; }
    if (above < need && sfx >= need) {
        unsigned cum = above;
        for (int i = 31; i >= 0; --i) { const unsigned h = hrow[(32 * lane + i + rot) & 2047];
            if (cum + h >= need) { *o_bin = (unsigned)(32 * lane + i); *o_above = cum; *o_cnt = h; break; }
            cum += h; }
    }
}
__device__ __forceinline__ void dsa_topk_phase(const bf16* UB, const bf16* IKB, const float* MISCF, unsigned long long* MASKT, LAS unsigned char* lds, int G, int bx, int vcu, int tid_in, int lane_in, int wave) {
    LAS unsigned* hist = (LAS unsigned*)lds;
    LAS unsigned* par = (LAS unsigned*)(lds + XTRA_OFF);
    const int nun = T / 16;
    for (int it = 0;; ++it) {
        int unit;
        if (G == 256) { if (it >= 4) break; unit = (it == 0) ? vcu : (it == 1) ? 511 - vcu : (it == 2) ? 512 + vcu : 1023 - vcu; }
        else { unit = bx + it * G; if (unit >= nun) break; }
        int tid = tid_in; asm volatile("" : "+v"(tid)); const int lane = tid & 63;
        DsaCtx c; const int row0 = unit * 16; c.b = row0 >> 13; c.p0 = row0 & (SEQ - 1); c.g4 = 4 * (lane >> 4);
        { const bf16* qp = UB + (size_t)(row0 + (lane & 15)) * UB_P + 3072 + 8 * (lane >> 4);
#pragma unroll
          for (int hh = 0; hh < 4; ++hh) { c.af[hh][0] = *(const dsa_bf16x8*)(qp + hh * 64); c.af[hh][1] = *(const dsa_bf16x8*)(qp + hh * 64 + 32); }
#pragma unroll
          for (int r = 0; r < 4; ++r) { const dsa_f32x4 w4 = *(const dsa_f32x4*)(MISCF + (size_t)(row0 + c.g4 + r) * 128 + 64);
              c.wq[r][0] = w4[0] * 0.0625f; c.wq[r][1] = w4[1] * 0.0625f; c.wq[r][2] = w4[2] * 0.0625f; c.wq[r][3] = w4[3] * 0.0625f; } }
        const int nmine = (c.p0 + 15 - 16 * wave >= 0) ? ((c.p0 + 15 - 16 * wave) >> 7) + 1 : 0;
        const int ngrp = (c.p0 + 15 - 64 * wave >= 0) ? ((c.p0 + 15 - 64 * wave) >> 9) + 1 : 0;
        int rotq[4], baseq[4];
#pragma unroll
        for (int r = 0; r < 4; ++r) { rotq[r] = 67 * (c.g4 + r); baseq[r] = (c.g4 + r) * 2048; }
        __syncthreads();
        for (int i = tid; i < 8192; i += NTHR) ((LAS v4u*)hist)[i] = (v4u){0u, 0u, 0u, 0u};
        if (tid == 0) par[96] = 0u;
        __syncthreads();
        { DsaB4 cur = dsa_loadb4(c, IKB, 64 * wave, lane);
          for (int s = 0; s < ngrp; ++s) { const int key0g = 512 * s + 64 * wave;
#pragma unroll
            for (int j = 0; j < 4; ++j) { const int key0 = key0g + 16 * j; const DsaB bt = cur.t[j];
              cur.t[j] = dsa_loadbc(c, IKB, (s + 1 < ngrp) ? key0 + 512 : key0, lane);
              if (key0 <= c.p0 + 15) { unsigned mono[4], vb; dsa_tile<true>(c, bt, key0, lane, mono, vb);
#pragma unroll
                for (int r = 0; r < 4; ++r) __hip_atomic_fetch_add(hist + baseq[r] + (((mono[r] >> 21) + rotq[r]) & 2047), (vb >> r) & 1u, __ATOMIC_RELAXED, __HIP_MEMORY_SCOPE_WORKGROUP); } } } }
        __syncthreads();
#pragma unroll
        for (int k = 0; k < 2; ++k) { const int q = 2 * wave + k; dsa_scan(hist, q, 256u, lane, par + q, par + 16 + q, par + 80 + q);
            if (lane == 0) { const bool all = (c.p0 + q) < 256;
                if (all) { par[q] = 0xffffffffu; par[16 + q] = 0u; par[80 + q] = 0u; } else if (par[80 + q] > (unsigned)DSA_CAP) par[96] = 1u; } }
        __syncthreads();
        const bool ovf = par[96] != 0u;
        LAS unsigned char* gtbase = lds;
        if (!ovf) {
            gtbase = lds + DSA_CAP * 64;
            LAS unsigned* cand = (LAS unsigned*)lds; LAS unsigned* cnt = par + 100;
            for (int i = tid; i < 1024; i += NTHR) ((LAS v4u*)gtbase)[i] = (v4u){0u, 0u, 0u, 0u};
            if (tid < 16) cnt[tid] = 0u;
            __syncthreads();
            { LAS unsigned short* gt16 = (LAS unsigned short*)gtbase;
              DsaB4 cur = dsa_loadb4(c, IKB, 64 * wave, lane); int pb1[4];
#pragma unroll
              for (int r = 0; r < 4; ++r) pb1[r] = (int)par[c.g4 + r];
              for (int s = 0; s < ngrp; ++s) { const int key0g = 512 * s + 64 * wave;
#pragma unroll
               for (int j = 0; j < 4; ++j) { const int key0 = key0g + 16 * j; const DsaB bt = cur.t[j];
                cur.t[j] = dsa_loadbc(c, IKB, (s + 1 < ngrp) ? key0 + 512 : key0, lane);
                if (key0 <= c.p0 + 15) { unsigned mono[4], vb; dsa_tile<true>(c, bt, key0, lane, mono, vb);
#pragma unroll
                for (int r = 0; r < 4; ++r) { const int bin = (int)(mono[r] >> 21); const bool v = (vb >> r) & 1u;
                    const unsigned long long bg = __ballot(v && bin > pb1[r]);
                    if (lane < 4) gt16[(4 * lane + r) * 512 + (key0 >> 4)] = (unsigned short)(bg >> (16 * lane));
                    if (v && bin == pb1[r]) { const int q = c.g4 + r; const unsigned pos = __hip_atomic_fetch_add(cnt + q, 1u, __ATOMIC_RELAXED, __HIP_MEMORY_SCOPE_WORKGROUP);
                        if (pos < (unsigned)DSA_CAP) cand[q * DSA_CAP + pos] = (((mono[r] >> 2) & 0x7ffffu) << 13) | (unsigned)(8191 - (key0 + (lane & 15))); } } } }
               } }
            __syncthreads();
            { LAS unsigned* gt32 = (LAS unsigned*)gtbase;
#pragma unroll 1
              for (int k = 0; k < 2; ++k) { const int q = 2 * wave + k; const unsigned n = min(cnt[q], (unsigned)DSA_CAP), need = 256u - par[16 + q];
                if ((int)par[q] != -1 && n > 0u) {
                    const LAS unsigned* cq = cand + q * DSA_CAP; unsigned thr = 0u;
                    for (int bit = 31; bit >= 0; --bit) { const unsigned trial = thr | (1u << bit); unsigned cge = 0u;
                        for (unsigned i = lane; i < n; i += 64) cge += (cq[i] >= trial) ? 1u : 0u;
#pragma unroll
                        for (int o = 1; o < 64; o <<= 1) cge += __shfl_xor(cge, o);
                        if (cge >= need) thr = trial; }
                    for (unsigned i = lane; i < n; i += 64) { const unsigned e = cq[i];
                        if (e >= thr) { const unsigned key = 8191u - (e & 8191u); __hip_atomic_fetch_or(gt32 + q * 256 + (key >> 5), 1u << (key & 31u), __ATOMIC_RELAXED, __HIP_MEMORY_SCOPE_WORKGROUP); } } } } }
            __syncthreads();
        } else {
            for (int i = tid; i < 8192; i += NTHR) ((LAS v4u*)hist)[i] = (v4u){0u, 0u, 0u, 0u};
            __syncthreads();
            { DsaB cur = dsa_loadb(c, IKB, 16 * wave, lane); unsigned pb1[4];
#pragma unroll
              for (int r = 0; r < 4; ++r) pb1[r] = par[c.g4 + r];
              for (int s = 0; s < nmine; ++s) { const int key0 = 128 * s + 16 * wave; const DsaB nxt = dsa_loadb(c, IKB, (s + 1 < nmine) ? key0 + 128 : key0, lane);
                unsigned k22[4]; bool valid[4]; dsa_scores(c, cur, key0, lane, k22, valid); cur = nxt;
#pragma unroll
                for (int r = 0; r < 4; ++r) { const int q = c.g4 + r; if (valid[r] && (k22[r] >> 11) == pb1[r]) __hip_atomic_fetch_add(hist + q * 2048 + (((k22[r] & 2047u) + 67 * q) & 2047), 1u, __ATOMIC_RELAXED, __HIP_MEMORY_SCOPE_WORKGROUP); } } }
            __syncthreads();
#pragma unroll
            for (int k = 0; k < 2; ++k) { const int q = 2 * wave + k; const unsigned c1 = par[16 + q];
                dsa_scan(hist, q, 256u - c1, lane, par + 32 + q, par + 48 + q, par + 64 + q);
                if (lane == 0) { const unsigned b2 = par[32 + q], c2 = par[48 + q]; const bool all = (c.p0 + q) < 256;
                    par[32 + q] = all ? 0xffffffffu : ((par[q] << 11) | b2); par[48 + q] = all ? 0u : (256u - c1 - c2); if (all) par[64 + q] = 0u; } }
            __syncthreads();
            for (int i = tid; i < 2048; i += NTHR) ((LAS v4u*)hist)[i] = (v4u){0u, 0u, 0u, 0u};
            __syncthreads();
            { LAS unsigned short* gt16 = (LAS unsigned short*)lds; LAS unsigned short* eq16 = (LAS unsigned short*)(lds + 16384);
              DsaB cur = dsa_loadb(c, IKB, 16 * wave, lane); int pt22[4];
#pragma unroll
              for (int r = 0; r < 4; ++r) pt22[r] = (int)par[32 + c.g4 + r];
              for (int s = 0; s < nmine; ++s) { const int key0 = 128 * s + 16 * wave; const DsaB nxt = dsa_loadb(c, IKB, (s + 1 < nmine) ? key0 + 128 : key0, lane);
                unsigned k22[4]; bool valid[4]; dsa_scores(c, cur, key0, lane, k22, valid); cur = nxt;
#pragma unroll
                for (int r = 0; r < 4; ++r) { const int t22 = pt22[r];
                    const bool gt = valid[r] && ((int)k22[r] > t22), eq = valid[r] && ((int)k22[r] == t22);
                    const unsigned long long bg = __ballot(gt), be = __ballot(eq);
                    if (lane < 4) { gt16[(4 * lane + r) * 512 + (key0 >> 4)] = (unsigned short)(bg >> (16 * lane)); eq16[(4 * lane + r) * 512 + (key0 >> 4)] = (unsigned short)(be >> (16 * lane)); } } } }
            __syncthreads();
            { LAS unsigned* gt32 = (LAS unsigned*)lds; LAS unsigned* eq32 = (LAS unsigned*)(lds + 16384);
#pragma unroll
              for (int k = 0; k < 2; ++k) { const int q = 2 * wave + k; const unsigned quota = par[48 + q], eqcnt = par[64 + q]; unsigned base = 0u;
                for (int rnd = 0; rnd < 4; ++rnd) { const int wi = q * 256 + rnd * 64 + lane; const unsigned e = eq32[wi]; unsigned kw = e;
                    if (eqcnt > quota) { const unsigned cn = __popc(e); unsigned inc = cn;
#pragma unroll
                        for (int o = 1; o < 64; o <<= 1) { const unsigned t = __shfl_up(inc, o); if (lane >= o) inc += t; }
                        const unsigned exc = base + inc - cn; base += __shfl(inc, 63);
                        if (exc + cn <= quota) kw = e; else if (exc >= quota) kw = 0u; else { unsigned rem = quota - exc, w = e; kw = 0u; while (rem > 0u) { const unsigned low = w & (0u - w); kw |= low; w ^= low; --rem; } } }
                    gt32[wi] |= kw; } } }
            __syncthreads();
        }
        { const LAS unsigned long long* gt64 = (const LAS unsigned long long*)gtbase;
#pragma unroll
          for (int k = 0; k < 4; ++k) { const int idx = tid + NTHR * k, qq = idx & 15, t = idx >> 4;
              MASKT[((size_t)(c.b * 128 + t)) * SEQ + c.p0 + qq] = gt64[qq * 128 + t]; } }
    }
    __syncthreads();
}
typedef __attribute__((ext_vector_type(8))) short s_bf16x8;
typedef __attribute__((ext_vector_type(16))) float s_f32x16;
__device__ __forceinline__ int crow_(int r, int hi) { return (r & 3) + 8 * (r >> 2) + 4 * hi; }
__device__ __forceinline__ void ssd_prep_phase(const bf16* UA, const float* MISCF, const float* conv_w, const float* conv_b, const float* dt_bias, const float* a_log, const float* fbias,
                                               float* CF2, float* ACS, float* DTA, bf16* XT, bf16* BT, bf16* BC, bf16* CC, unsigned* QKN, LAS unsigned char* lds, int G, int bx, int tid, int lane, int wave) {
    const int NU = 16 + 64 + 256;
    for (int unit = bx; unit < NU; unit += G) {
        __syncthreads();
        if (unit < 16) {
            const int b = unit >> 3, h = unit & 7; const float fb = fbias[h];
            float v[16]; float run = 0.f;
#pragma unroll
            for (int i = 0; i < 16; ++i) { const int t = 16 * tid + i; run += logsigmoid_(MISCF[((size_t)b * SEQ + t) * 128 + 76 + h] + fb) * LOG2E; v[i] = run; }
            float inc = run;
#pragma unroll
            for (int o = 1; o < 64; o <<= 1) { const float t_ = __shfl_up(inc, o); if (lane >= o) inc += t_; }
            LAS float* wt = (LAS float*)lds;
            if (lane == 63) wt[wave] = inc;
            __syncthreads();
            float off = inc - run;
            for (int w = 0; w < wave; ++w) off += wt[w];
#pragma unroll
            for (int i = 0; i < 16; ++i) CF2[((size_t)b * 8 + h) * SEQ + 16 * tid + i] = off + v[i];
        } else if (unit < 80) {
            const int u = unit - 16, b = u >> 5, cch = u & 31, h = wave;
            const float bias = dt_bias[h], a = -expf(a_log[h]);
            float dtv[4], cs[4]; float run = 0.f;
#pragma unroll
            for (int i = 0; i < 4; ++i) { const int t = cch * 256 + 4 * lane + i; dtv[i] = softplus_(MISCF[((size_t)b * SEQ + t) * 128 + 68 + h] + bias); run += dtv[i] * a; cs[i] = run; }
            float inc = run;
#pragma unroll
            for (int o = 1; o < 64; o <<= 1) { const float t_ = __shfl_up(inc, o); if (lane >= o) inc += t_; }
            const float off = inc - run;
#pragma unroll
            for (int i = 0; i < 4; ++i) { const size_t o_ = ((size_t)b * 8 + h) * SEQ + cch * 256 + 4 * lane + i; ACS[o_] = off + cs[i]; DTA[o_] = dtv[i]; }
        } else {
            const int u = unit - 80, b = u >> 7, t0 = (u & 127) * 64; const int ch0 = 2 * tid;
            {
                const int tt = tid >> 3, hd = tid & 7; const bf16* qrow = UA + ((size_t)b * SEQ + t0 + tt) * UA_P + 1536 + hd * 64;
                float q2 = 0.f, k2 = 0.f;
#pragma unroll
                for (int k8 = 0; k8 < 8; ++k8) { const v4u a4 = *(const v4u*)(qrow + 8 * k8), b4 = *(const v4u*)(qrow + 512 + 8 * k8);
                    q2 += bfl(a4.x) * bfl(a4.x) + bfh(a4.x) * bfh(a4.x) + bfl(a4.y) * bfl(a4.y) + bfh(a4.y) * bfh(a4.y) + bfl(a4.z) * bfl(a4.z) + bfh(a4.z) * bfh(a4.z) + bfl(a4.w) * bfl(a4.w) + bfh(a4.w) * bfh(a4.w);
                    k2 += bfl(b4.x) * bfl(b4.x) + bfh(b4.x) * bfh(b4.x) + bfl(b4.y) * bfl(b4.y) + bfh(b4.y) * bfh(b4.y) + bfl(b4.z) * bfl(b4.z) + bfh(b4.z) * bfh(b4.z) + bfl(b4.w) * bfl(b4.w) + bfh(b4.w) * bfh(b4.w); }
#pragma unroll
                for (int o = 8; o < 64; o <<= 1) { q2 = fmaxf(q2, __shfl_xor(q2, o)); k2 = fmaxf(k2, __shfl_xor(k2, o)); }
                if (lane < 8) { __hip_atomic_fetch_max(QKN + (b * 8 + hd) * 2, __builtin_bit_cast(unsigned, q2), __ATOMIC_RELAXED, __HIP_MEMORY_SCOPE_AGENT);
                                __hip_atomic_fetch_max(QKN + (b * 8 + hd) * 2 + 1, __builtin_bit_cast(unsigned, k2), __ATOMIC_RELAXED, __HIP_MEMORY_SCOPE_AGENT); }
            }
            LAS unsigned short* tl = (LAS unsigned short*)lds;
            float cw[4][2], cb[2];
#pragma unroll
            for (int w = 0; w < 4; ++w) { cw[w][0] = conv_w[w * 1024 + ch0]; cw[w][1] = conv_w[w * 1024 + ch0 + 1]; }
            cb[0] = conv_b[ch0]; cb[1] = conv_b[ch0 + 1];
            const bf16* src = UA + ((size_t)b * SEQ) * UA_P + 512 + ch0;
            float r0[2] = {0.f, 0.f}, r1[2] = {0.f, 0.f}, r2[2] = {0.f, 0.f};
            if (t0 > 0) { const unsigned w0 = *(const unsigned*)(src + (size_t)(t0 - 3) * UA_P), w1 = *(const unsigned*)(src + (size_t)(t0 - 2) * UA_P), w2 = *(const unsigned*)(src + (size_t)(t0 - 1) * UA_P);
                r0[0] = bfl(w0); r0[1] = bfh(w0); r1[0] = bfl(w1); r1[1] = bfh(w1); r2[0] = bfl(w2); r2[1] = bfh(w2); }
#pragma unroll 8
            for (int tt = 0; tt < 64; ++tt) {
                const unsigned wv = *(const unsigned*)(src + (size_t)(t0 + tt) * UA_P); const float c0 = bfl(wv), c1 = bfh(wv);
                const float y0 = cb[0] + cw[0][0] * r0[0] + cw[1][0] * r1[0] + cw[2][0] * r2[0] + cw[3][0] * c0;
                const float y1 = cb[1] + cw[0][1] * r0[1] + cw[1][1] * r1[1] + cw[2][1] * r2[1] + cw[3][1] * c1;
                r0[0] = r1[0]; r0[1] = r1[1]; r1[0] = r2[0]; r1[1] = r2[1]; r2[0] = c0; r2[1] = c1;
                const unsigned o0 = f2bf(silu_(y0)), o1 = f2bf(silu_(y1));
                if (ch0 < 768) { tl[ch0 * 68 + tt] = (unsigned short)o0; tl[(ch0 + 1) * 68 + tt] = (unsigned short)o1; }
                if (ch0 >= 512) { const size_t row = (size_t)b * SEQ + t0 + tt;
                    if (ch0 < 768) *(unsigned*)(BC + row * 256 + (ch0 - 512)) = o0 | (o1 << 16); else *(unsigned*)(CC + row * 256 + (ch0 - 768)) = o0 | (o1 << 16); }
            }
            __syncthreads();
#pragma unroll
            for (int k = 0; k < 12; ++k) { const int idx = tid + NTHR * k, rowc = idx >> 3, chunk = idx & 7;
                const LAS unsigned long long* sp = (const LAS unsigned long long*)(tl + rowc * 68 + chunk * 8);
                const unsigned long long lo = sp[0], hi = sp[1];
                bf16* dst = (rowc < 512) ? XT + (((size_t)b * 8 + (rowc >> 6)) * 64 + (rowc & 63)) * SEQ + t0 + chunk * 8
                                         : BT + (((size_t)b * 2 + ((rowc - 512) >> 7)) * 128 + ((rowc - 512) & 127)) * SEQ + t0 + chunk * 8;
                v4u o; o.x = (unsigned)lo; o.y = (unsigned)(lo >> 32); o.z = (unsigned)hi; o.w = (unsigned)(hi >> 32); *(v4u*)dst = o; }
        }
    }
    __syncthreads();
}
__device__ __forceinline__ void ssd_state_phase(const bf16* XT, const bf16* BT, const float* ACS, const float* DTA, float* STATE, LAS unsigned char* lds, int G, int bx, int tid, int lane, int wave) {
    LAS float* wl = (LAS float*)lds;
    const int r32 = lane & 31, hi = lane >> 5, d0 = wave & 1, nb = wave >> 1;
    for (int unit = bx; unit < NB * 32 * 8; unit += G) {
        const int h = unit & 7, cch = (unit >> 3) & 31, b = unit >> 8, g = h >> 2;
        __syncthreads();
        if (tid < 256) { const size_t o_ = ((size_t)b * 8 + h) * SEQ + cch * 256; wl[tid] = DTA[o_ + tid] * expf(ACS[o_ + 255] - ACS[o_ + tid]); }
        __syncthreads();
        const bf16* xp = XT + (((size_t)b * 8 + h) * 64 + 32 * d0 + r32) * SEQ + cch * 256 + 8 * hi;
        const bf16* bp = BT + (((size_t)b * 2 + g) * 128 + 32 * nb + r32) * SEQ + cch * 256 + 8 * hi;
        s_f32x16 acc = {};
#pragma unroll 4
        for (int k = 0; k < 16; ++k) {
            const v4u xa = *(const v4u*)(xp + 16 * k); const s_bf16x8 bb = *(const s_bf16x8*)(bp + 16 * k);
            const LAS f32x4* w4 = (const LAS f32x4*)(wl + 16 * k + 8 * hi); const f32x4 wa = w4[0], wb = w4[1];
            v4u xs; xs.x = pk2(bfl(xa.x) * wa.x, bfh(xa.x) * wa.y); xs.y = pk2(bfl(xa.y) * wa.z, bfh(xa.y) * wa.w); xs.z = pk2(bfl(xa.z) * wb.x, bfh(xa.z) * wb.y); xs.w = pk2(bfl(xa.w) * wb.z, bfh(xa.w) * wb.w);
            acc = __builtin_amdgcn_mfma_f32_32x32x16_bf16(__builtin_bit_cast(s_bf16x8, xs), bb, acc, 0, 0, 0);
        }
        float* sp = STATE + ((((size_t)b * 32 + cch) * 8 + h) * 64 + 32 * d0) * 128 + 32 * nb + r32;
#pragma unroll
        for (int r = 0; r < 16; ++r) sp[(size_t)crow_(r, hi) * 128] = acc[r];
    }
    __syncthreads();
}
__device__ __forceinline__ void ssd_scan_phase(const float* STATE, const float* ACS, bf16* PREV, int G, int bx, int tid) {
    for (int idx = bx * NTHR + tid; idx < NB * 8 * 8192; idx += G * NTHR) {
        const int b = idx >> 16, h = (idx >> 13) & 7, pn = idx & 8191; float run = 0.f;
#pragma unroll 4
        for (int cch = 0; cch < 32; ++cch) { const size_t o_ = (((size_t)b * 32 + cch) * 8 + h) * 8192 + pn;
            const float s = STATE[o_]; PREV[o_] = (bf16)f2bf(run);
            run = run * expf(ACS[((size_t)b * 8 + h) * SEQ + cch * 256 + 255]) + s; }
    }
}
__device__ __forceinline__ void ssd_out_phase(const bf16* UA, const bf16* XT, const bf16* BC, const bf16* CC, const bf16* PREV, const float* ACS, const float* DTA, const float* d_skip, bf16* Y0,
                                              int G, int bx, int lane, int wave) {
    const int r32 = lane & 31, hi = lane >> 5;
    for (int unit = bx; unit < NB * 32 * 8; unit += G) {
        const int h = unit & 7, cch = (unit >> 3) & 31, b = unit >> 8, g = h >> 2;
        const int ql = 32 * wave + r32; const size_t rowl = (size_t)b * SEQ + cch * 256 + ql;
        const size_t abase = ((size_t)b * 8 + h) * SEQ + cch * 256;
        const float acs_l = ACS[abase + ql], Dh = d_skip[h];
        s_bf16x8 cf[8];
#pragma unroll
        for (int kn = 0; kn < 8; ++kn) cf[kn] = *(const s_bf16x8*)(CC + rowl * 256 + g * 128 + 16 * kn + 8 * hi);
        s_f32x16 o[2]; o[0] = s_f32x16{}; o[1] = s_f32x16{};
        { const bf16* pp = PREV + ((((size_t)b * 32 + cch) * 8 + h) * 64 + r32) * 128 + 8 * hi;
#pragma unroll
          for (int d0 = 0; d0 < 2; ++d0)
#pragma unroll
              for (int kn = 0; kn < 8; ++kn) o[d0] = __builtin_amdgcn_mfma_f32_32x32x16_bf16(*(const s_bf16x8*)(pp + (size_t)d0 * 32 * 128 + 16 * kn), cf[kn], o[d0], 0, 0, 0);
          const float e = expf(acs_l);
#pragma unroll
          for (int r = 0; r < 16; ++r) { o[0][r] *= e; o[1][r] *= e; } }
        const bf16* xp = XT + (((size_t)b * 8 + h) * 64 + r32) * SEQ + cch * 256 + 4 * hi;
        for (int st = 0; st <= wave; ++st) {
            s_f32x16 s = {};
            { const bf16* bp = BC + ((size_t)b * SEQ + cch * 256 + 32 * st + r32) * 256 + g * 128 + 8 * hi;
#pragma unroll
              for (int kn = 0; kn < 8; ++kn) s = __builtin_amdgcn_mfma_f32_32x32x16_bf16(*(const s_bf16x8*)(bp + 16 * kn), cf[kn], s, 0, 0, 0); }
            float P[16];
#pragma unroll
            for (int gq = 0; gq < 4; ++gq) { const f32x4 a4 = *(const f32x4*)(ACS + abase + 32 * st + 8 * gq + 4 * hi), d4 = *(const f32x4*)(DTA + abase + 32 * st + 8 * gq + 4 * hi);
#pragma unroll
                for (int j = 0; j < 4; ++j) { const int key = 32 * st + 8 * gq + 4 * hi + j;
                    const float f = (key <= ql) ? expf(fminf(acs_l - a4[j], 0.f)) * d4[j] : 0.f;
                    float p = s[4 * gq + j] * f; if (key == ql) p += Dh; P[4 * gq + j] = p; } }
            v4u pf0, pf1;
            pf0.x = pk2(P[0], P[1]); pf0.y = pk2(P[2], P[3]); pf0.z = pk2(P[4], P[5]); pf0.w = pk2(P[6], P[7]);
            pf1.x = pk2(P[8], P[9]); pf1.y = pk2(P[10], P[11]); pf1.z = pk2(P[12], P[13]); pf1.w = pk2(P[14], P[15]);
#pragma unroll
            for (int d0 = 0; d0 < 2; ++d0) { const bf16* xq = xp + (size_t)d0 * 32 * SEQ + 32 * st;
                const unsigned long long a0 = *(const unsigned long long*)(xq), a1 = *(const unsigned long long*)(xq + 8), a2 = *(const unsigned long long*)(xq + 16), a3 = *(const unsigned long long*)(xq + 24);
                v4u x0, x1; x0.x = (unsigned)a0; x0.y = (unsigned)(a0 >> 32); x0.z = (unsigned)a1; x0.w = (unsigned)(a1 >> 32); x1.x = (unsigned)a2; x1.y = (unsigned)(a2 >> 32); x1.z = (unsigned)a3; x1.w = (unsigned)(a3 >> 32);
                o[d0] = __builtin_amdgcn_mfma_f32_32x32x16_bf16(__builtin_bit_cast(s_bf16x8, x0), __builtin_bit_cast(s_bf16x8, pf0), o[d0], 0, 0, 0);
                o[d0] = __builtin_amdgcn_mfma_f32_32x32x16_bf16(__builtin_bit_cast(s_bf16x8, x1), __builtin_bit_cast(s_bf16x8, pf1), o[d0], 0, 0, 0); }
        }
#pragma unroll
        for (int d0 = 0; d0 < 2; ++d0)
#pragma unroll
            for (int gq = 0; gq < 4; ++gq) { const int p = 32 * d0 + 8 * gq + 4 * hi;
                const unsigned long long zw = *(const unsigned long long*)(UA + rowl * UA_P + h * 64 + p); const unsigned z0 = (unsigned)zw, z1 = (unsigned)(zw >> 32);
                const float y0 = o[d0][4 * gq] * silu_(bfl(z0)), y1 = o[d0][4 * gq + 1] * silu_(bfh(z0)), y2 = o[d0][4 * gq + 2] * silu_(bfl(z1)), y3 = o[d0][4 * gq + 3] * silu_(bfh(z1));
                *(unsigned long long*)(Y0 + rowl * 512 + h * 64 + p) = (unsigned long long)pk2(y0, y1) | ((unsigned long long)pk2(y2, y3) << 32); }
    }
}
__device__ __forceinline__ void ssd_gnorm_phase(bf16* Y0, const float* normw, int gw, int NGW, int lane) {
    for (int m = gw; m < T; m += NGW) {
        v4u* p = (v4u*)(Y0 + (size_t)m * 512) + lane; const v4u w = *p;
        float v[8] = {bfl(w.x), bfh(w.x), bfl(w.y), bfh(w.y), bfl(w.z), bfh(w.z), bfl(w.w), bfh(w.w)}; float s = 0.f;
#pragma unroll
        for (int j = 0; j < 8; ++j) s += v[j] * v[j];
#pragma unroll
        for (int o = 1; o < 32; o <<= 1) s += __shfl_xor(s, o);
        const float rstd = 1.0f / sqrtf(s * (1.0f / 256.0f) + EPS);
        const f32x4 g0 = ((const f32x4*)normw)[2 * lane], g1 = ((const f32x4*)normw)[2 * lane + 1];
        v4u o; o.x = pk2(v[0] * rstd * g0.x, v[1] * rstd * g0.y); o.y = pk2(v[2] * rstd * g0.z, v[3] * rstd * g0.w); o.z = pk2(v[4] * rstd * g1.x, v[5] * rstd * g1.y); o.w = pk2(v[6] * rstd * g1.z, v[7] * rstd * g1.w);
        *p = o;
    }
}
typedef attn_body::bf16 abf;
template <int ONLY> __device__ __forceinline__ void attn_bd_phase(char* lds, const bf16* UB, bf16* Y2, bf16* Y3, const unsigned* SELM, const unsigned long long* MASKT, int G, int vcu, int tid) {
    for (int v = vcu; v < 256; v += G)
        for (int i = 0; i < 4; ++i) {
            const int s = v & 7, bh = v >> 3, qb = (i == 0) ? s : (i == 1) ? 15 - s : (i == 2) ? 16 + s : 31 - s;
            int tid_u = tid; asm volatile("" : "+v"(tid_u));
            const int branch = bh >> 4, b = (bh >> 3) & 1, h = bh & 7;
            if (ONLY >= 0 && branch != ONLY) continue;
#ifdef ATT_BASE
            attn_body::attn_unit<8, 3, ATT_BASE_DM, ATT_BASE_ODM>(b, h, qb, (const abf*)UB, (const abf*)UB + 512, (const abf*)UB + 1024, (abf*)Y2, lds, SELM, nullptr, tid_u);
#endif
#ifndef ATT_SKIP1
            if (branch == 0) attn_body::attn_unit<8, 1, UB_P, 512>(b, h, qb, (const abf*)UB, (const abf*)UB + 512, (const abf*)UB + 1024, (abf*)Y2, lds, SELM, nullptr, tid_u);
#endif
#ifndef ATT_SKIP2
            if (branch == 1) attn_body::attn_unit<8, 2, UB_P, 512>(b, h, qb, (const abf*)UB + 1536, (const abf*)UB + 2048, (const abf*)UB + 2560, (abf*)Y3, lds, MASKT, nullptr, tid_u);
#endif
        }
}
__device__ __forceinline__ void attn_fox_phase(char* lds, volatile LAS unsigned* slot, const bf16* UA, bf16* Y1, const float* CF2, const float* QKN, unsigned* counter, int tid) {
    for (;;) {
        if (tid == 0) *slot = __hip_atomic_fetch_add(counter, 1u, __ATOMIC_RELAXED, __HIP_MEMORY_SCOPE_AGENT);
        __syncthreads();
        const unsigned u = (unsigned)__builtin_amdgcn_readfirstlane((int)*slot);
        if (u >= 512u) break;
        const int qb = 31 - (int)(u >> 4), bh = (int)(u & 15u), b = bh >> 3, h = bh & 7;
        int tid_u = tid; asm volatile("" : "+v"(tid_u));
        attn_body::attn_unit<8, 0, UA_P, 512>(b, h, qb, (const abf*)UA + 1536, (const abf*)UA + 2048, (const abf*)UA + 2560, (abf*)Y1, lds, CF2, QKN, tid_u);
    }
}
template <class Epi> __device__ __forceinline__ void run_gemm(LAS unsigned char* lds, const bf16* A, int lda, const bf16* Bt, int ldb, int N, int K, int G, int bx, int tid, const Epi& E) {
    pg8::Gemm g{A, Bt, T, N, K, lda, ldb}; pg8::StaticOrder S; S.init(T, N, G, bx);
    pg8::gemm_phase<Epi, pg8::StaticOrder, true, true>(lds, g, S, E, tid);
}

constexpr int PH_PER_LAYER = 24, N_PHASES = 2 * PH_PER_LAYER;
struct Args { const float* in[19]; float* out; unsigned char* ws; int ph_lo, ph_hi; };
#define RC ((float*)(ws + WS_ROPEC))
#define RS ((float*)(ws + WS_ROPES))
#define CF2 ((float*)(ws + WS_CF2))
#define ACS ((float*)(ws + WS_ACS))
#define DTA ((float*)(ws + WS_DTA))
#define SELM ((unsigned*)(ws + WS_SELM))
#define KPART ((float*)(ws + WS_KPART))
#define IKB ((bf16*)(ws + WS_IKB))
#define WIN ((bf16*)(ws + WS_WIN))
#define WG ((bf16*)(ws + WS_WG))
#define WB ((bf16*)(ws + WS_WB))
#define H ((bf16*)(ws + WS_H))
#define Y ((bf16*)(ws + WS_Y))
#define U ((bf16*)(ws + WS_U))
#define XT ((bf16*)(ws + WS_XT))
#define MASKT ((unsigned long long*)(ws + WS_MASK))
#define BC ((bf16*)(ws + WS_BC))
#define CC ((bf16*)(ws + WS_CC))
#define MISCF ((float*)(ws + WS_MISC))
#define STATE ((float*)(ws + WS_STATE))
#define BT ((bf16*)(ws + WS_BT))
#define PREV ((bf16*)(ws + WS_PREV))
#define GB ((bf16*)(ws + WS_G))
#define MG ((float*)(ws + WS_MG))
#define WO ((bf16*)(ws + WS_WO))
#define WF1 ((bf16*)(ws + WS_WF1))
#define WF2 ((bf16*)(ws + WS_WF2))
#define HP ((bf16*)(ws + WS_HP))
#define Y0 (Y)
#define Y1 (Y + (size_t)T * 512)
#define Y2 (Y + (size_t)2 * T * 512)
#define Y3 (Y + (size_t)3 * T * 512)

#ifndef PH_MASK
#define PH_MASK 0xffffffu
#endif
#define PHASE_PROLOGUE \
    int tid = threadIdx.x; asm volatile("" : "+v"(tid)); \
    int G = gridDim.x, bx = blockIdx.x; asm volatile("" : "+s"(G), "+s"(bx)); \
    unsigned long long wsi_ = (unsigned long long)args.ws; asm volatile("" : "+s"(wsi_)); unsigned char* ws = (unsigned char*)(GAS unsigned char*)wsi_;     \
    const int lane = tid & 63, wave = __builtin_amdgcn_readfirstlane(tid >> 6); \
    const int vcu = (G % 8 == 0) ? (bx % 8) * (G / 8) + bx / 8 : bx; \
    const int gw = vcu * NWAVES + wave, NGW = G * NWAVES, gtid = bx * NTHR + tid, NGT = G * NTHR; \
    LAS float* scr = (LAS float*)(lds + wave * 16384); \
    (void)lane; (void)vcu; (void)gw; (void)NGW; (void)gtid; (void)NGT; (void)scr; (void)ws;
#define IN(k) (lo <= (k) && (k) < hi && ((PH_MASK >> ((k) % PH_PER_LAYER)) & 1u))
#define INR(k) (lo <= (k) && (k) < hi)
#define SEAM(k) do { if (INR(k) && INR((k) + 1)) { if ((k) == 0) { asm volatile("s_waitcnt vmcnt(0)" ::: "memory"); cg::this_grid().sync(); } else xcd_barrier(bar); } } while (0)

#ifndef DUP_MASK
#define DUP_MASK 0u
#endif
#ifndef XTRA_BAR
#define XTRA_BAR 0
#endif
#define DUP(k) (((DUP_MASK >> ((k) % PH_PER_LAYER)) & 1u) != 0u)
#define PHASE(k, ...) do { if (IN(k)) { PHASE_PROLOGUE __VA_ARGS__ } if (DUP(k) && IN(k)) { PHASE_PROLOGUE __VA_ARGS__ } } while (0)
#undef SEAM
#define SEAM(k) do { if (INR(k) && INR((k) + 1)) { if ((k) == 0) { asm volatile("s_waitcnt vmcnt(0)" ::: "memory"); cg::this_grid().sync(); } else xcd_barrier(bar); \
    for (int xb_ = 0; xb_ < XTRA_BAR; ++xb_) xcd_barrier(bar); } } while (0)

template <int L> __device__ __forceinline__ void run_layer(const Args& args, const int lo, const int hi, const XcdBarrier& bar, LAS unsigned char* lds, unsigned char* lds_raw) {
    constexpr int B0 = L * PH_PER_LAYER;
    if (L == 0) {
        PHASE(B0 + 0,
            tr_items(args.in[2], 6484, 1024, WIN, NWIN, MapWin{}, scr, gw, NGW, lane);
            rope_tables(RC, RS, gtid, NGT);
            norm_rows_to_bf16(args.in[0], args.in[1], H, gw, NGW, lane); );
        SEAM(B0 + 0);
    }
    PHASE(B0 + 1,
        pg8::EpiIn E{U, UB_P, (1u << 0) | (1u << 1) | (1u << 6) | (1u << 7), C2, 13, MISCF};
        run_gemm(lds, H, 1024, WIN, 1024, NWIN_B, 1024, G, bx, tid, E); );
    SEAM(B0 + 1);
    PHASE(B0 + 2, rope_phase(U, MISCF, IKB, KPART, RC, RS, lds, G, bx, tid, lane, wave); );
    SEAM(B0 + 2);
    if (IN(B0 + 3)) { PHASE_PROLOGUE moba_gate_phase(U, KPART, SELM, lds, G, bx, tid, lane, wave); }
    if (IN(B0 + 3) && ((DUP_MASK >> 24) & 1u)) { PHASE_PROLOGUE moba_gate_phase(U, KPART, SELM, lds, G, bx, tid, lane, wave); }
    if (IN(B0 + 3)) { PHASE_PROLOGUE dsa_topk_phase(U, IKB, MISCF, MASKT, lds, G, bx, vcu, tid, lane, wave); }
    if (IN(B0 + 3) && ((DUP_MASK >> 25) & 1u)) { PHASE_PROLOGUE dsa_topk_phase(U, IKB, MISCF, MASKT, lds, G, bx, vcu, tid, lane, wave); }
    SEAM(B0 + 3);
    PHASE(B0 + 4, attn_bd_phase<-1>((char*)lds_raw, U, Y2, Y3, SELM, MASKT, G, vcu, tid); );
    if (IN(B0 + 4) && ((DUP_MASK >> 26) & 1u)) { PHASE_PROLOGUE attn_bd_phase<0>((char*)lds_raw, U, Y2, Y3, SELM, MASKT, G, vcu, tid); }
    if (IN(B0 + 4) && ((DUP_MASK >> 27) & 1u)) { PHASE_PROLOGUE attn_bd_phase<1>((char*)lds_raw, U, Y2, Y3, SELM, MASKT, G, vcu, tid); }
    SEAM(B0 + 4);
    PHASE(B0 + 5,
        pg8::EpiIn E{U, UA_P, (1u << 6) | (1u << 7), C2, -1, nullptr};
        run_gemm(lds, H, 1024, WIN + (size_t)NWIN_B * 1024, 1024, NWIN_A, 1024, G, bx, tid, E); );
    SEAM(B0 + 5);
    PHASE(B0 + 6, ssd_prep_phase(U, MISCF, args.in[3] + (size_t)L * 4096, args.in[4] + L * 1024, args.in[5] + L * 8, args.in[6] + L * 8, args.in[9] + L * 8, CF2, ACS, DTA, XT, BT, BC, CC, (unsigned*)(ws + WS_CTL) + CW_QKN + L * 32, lds, G, bx, tid, lane, wave); );
    SEAM(B0 + 6);
    PHASE(B0 + 7, ssd_state_phase(XT, BT, ACS, DTA, STATE, lds, G, bx, tid, lane, wave); );
    SEAM(B0 + 7);
    PHASE(B0 + 8, ssd_scan_phase(STATE, ACS, PREV, G, bx, tid); );
    SEAM(B0 + 8);
    PHASE(B0 + 9, ssd_out_phase(U, XT, BC, CC, PREV, ACS, DTA, args.in[7] + L * 8, Y0, G, bx, lane, wave); );
    SEAM(B0 + 9);
    if (IN(B0 + 10)) { PHASE_PROLOGUE ssd_gnorm_phase(Y0, args.in[8] + L * 512, gw, NGW, lane); }
#ifndef DUP10_ATTN_ONLY
#define DUP10_ATTN_ONLY 1
#endif
    if (IN(B0 + 10)) { PHASE_PROLOGUE
        tr_items(args.in[10] + (size_t)L * 1024 * 4096, 4096, 1024, WG, 4096, MapId{0}, scr, gw, NGW, lane);
        for (int n = 0; n < 4; ++n) tr_items(args.in[12] + ((size_t)L * 4 + n) * 512 * 1024, 1024, 512, WB + (size_t)n * 1024 * 512, 1024, MapId{0}, scr, gw, NGW, lane);
        tr_items(args.in[13] + (size_t)L * 1024 * 1024, 1024, 1024, WO, 1024, MapId{0}, scr, gw, NGW, lane);
        tr_items(args.in[16] + (size_t)L * 1024 * 5632, 5632, 1024, WF1, 5632, MapFfn{}, scr, gw, NGW, lane);
        tr_items(args.in[17] + (size_t)L * FFH * 1024, 1024, FFH, WF2, 1024, MapId{0}, scr, gw, NGW, lane);
        __syncthreads();
    }
    if (IN(B0 + 10)) { PHASE_PROLOGUE attn_fox_phase((char*)lds_raw, (volatile LAS unsigned*)(lds + MISC_OFF) + 16, U, Y1, CF2, (const float*)(ws + WS_CTL) + CW_QKN + L * 32, (unsigned*)(ws + WS_CTL) + CW_WQ + 128 * L, tid); }
    if (DUP(B0 + 10) && IN(B0 + 10)) { PHASE_PROLOGUE attn_fox_phase((char*)lds_raw, (volatile LAS unsigned*)(lds + MISC_OFF) + 16, U, Y1, CF2, (const float*)(ws + WS_CTL) + CW_QKN + L * 32, (unsigned*)(ws + WS_CTL) + CW_WQ + 128 * L + 64, tid); }
    SEAM(B0 + 10);
#pragma unroll
    for (int n = 0; n < 4; ++n) {
        PHASE(B0 + 11 + 2 * n,
            pg8::EpiSig E{GB, 1024, args.in[11] + (size_t)L * 4096 + n * 1024};
            run_gemm(lds, H, 1024, WG + (size_t)n * 1024 * 1024, 1024, 1024, 1024, G, bx, tid, E); );
        SEAM(B0 + 11 + 2 * n);
        if (IN(B0 + 12 + 2 * n)) { PHASE_PROLOGUE
            pg8::EpiBranch E{GB, MG, 1024, n == 0, n == 3};
            run_gemm(lds, Y + (size_t)n * T * 512, 512, WB + (size_t)n * 1024 * 512, 512, 1024, 512, G, bx, tid, E); }
        if (n == 0 && DUP(B0 + 12) && IN(B0 + 12)) { PHASE_PROLOGUE
            pg8::EpiBranch E{GB, MG, 1024, 1, 0};
            run_gemm(lds, Y, 512, WB, 512, 1024, 512, G, bx, tid, E); }
        SEAM(B0 + 12 + 2 * n);
    }
    PHASE(B0 + 19, pg8::EpiF32 E{MG, 1024}; run_gemm(lds, GB, 1024, WO, 1024, 1024, 1024, G, bx, tid, E); );
    SEAM(B0 + 19);
    if (IN(B0 + 20)) { PHASE_PROLOGUE norm_res_rows(MG, args.in[14] + L * 1024, (L == 0) ? args.in[0] : (const float*)args.out, args.out, args.in[15] + L * 1024, H, gw, NGW, lane); }
    SEAM(B0 + 20);
    PHASE(B0 + 21, pg8::EpiSwi E{HP, FFH}; run_gemm(lds, H, 1024, WF1, 1024, 5632, 1024, G, bx, tid, E); );
    SEAM(B0 + 21);
    PHASE(B0 + 22, pg8::EpiF32 E{MG, 1024}; run_gemm(lds, HP, FFH, WF2, FFH, 1024, FFH, G, bx, tid, E); );
    SEAM(B0 + 22);
    if (IN(B0 + 23)) { PHASE_PROLOGUE
        norm_res_rows(MG, args.in[18] + L * 1024, args.out, args.out, (L == 0) ? args.in[1] + 1024 : nullptr, H, gw, NGW, lane);
        if (L == 0) tr_items(args.in[2] + (size_t)1024 * 6484, 6484, 1024, WIN, NWIN, MapWin{}, scr, gw, NGW, lane);
    }
    if (L == 0) SEAM(B0 + 23);
}

__global__ void __launch_bounds__(NTHR, 2) hybrid_fwd(Args args) {
    extern __shared__ __attribute__((aligned(16))) unsigned char lds_raw[];
    LAS unsigned char* lds = (LAS unsigned char*)lds_raw;
    for (int u = threadIdx.x; u < (LDS_BYTES - LDSCTL_OFF) / 4; u += NTHR) ((LAS unsigned*)(lds + LDSCTL_OFF))[u] = 0u;
    __syncthreads();
    const int lo = args.ph_lo, hi = args.ph_hi;
    XcdBarrier bar; bar.bar = (unsigned*)(args.ws + WS_CTL) + CW_BAR; bar.x = 0; bar.st = nullptr;
    if (hi - lo > 1) bar = xcd_barrier_post((unsigned*)(args.ws + WS_CTL) + CW_BAR, (volatile LAS unsigned*)(lds + MISC_OFF) + 8);
    run_layer<0>(args, lo, hi, bar, lds, lds_raw);
    run_layer<1>(args, lo, hi, bar, lds, lds_raw);
}

#ifndef MK_PER_PHASE
#define MK_PER_PHASE 0
#endif
extern "C" void kernel_launch(void* const* d_in, const int* in_sizes, int n_in, void* d_out, int out_size, void* d_ws, size_t ws_size, hipStream_t stream) {
    static int grid = 0;
    if (grid == 0) {
        if (n_in != 19 || in_sizes[0] != T * DMODEL || out_size != T * DMODEL || ws_size < WS_END) { fprintf(stderr, "kernel_launch: unexpected shapes (n_in %d, in0 %d, out %d, ws %zu); nothing launched\n", n_in, n_in > 0 ? in_sizes[0] : -1, out_size, ws_size); grid = -1; return; }
        int dev = 0, cus = 0, per_cu = 0;
        if (hipGetDevice(&dev) != hipSuccess || hipDeviceGetAttribute(&cus, hipDeviceAttributeMultiprocessorCount, dev) != hipSuccess) { grid = -1; return; }
        if (hipFuncSetAttribute((const void*)hybrid_fwd, hipFuncAttributeMaxDynamicSharedMemorySize, LDS_BYTES) != hipSuccess) { fprintf(stderr, "kernel_launch: hipFuncSetAttribute failed\n"); grid = -1; return; }
        if (hipOccupancyMaxActiveBlocksPerMultiprocessor(&per_cu, (const void*)hybrid_fwd, NTHR, LDS_BYTES) != hipSuccess || per_cu < 1) { fprintf(stderr, "kernel_launch: occupancy query says %d\n", per_cu); per_cu = 1; }
        (void)hipGetLastError();
        grid = cus * 1;
        if (grid > 256) grid = 256;
    }
    if (grid < 0) return;
    (void)hipMemsetAsync((char*)d_ws + WS_CTL, 0, CTL_ZERO_BYTES, stream);
    Args a{};
    for (int i = 0; i < 19; ++i) a.in[i] = (const float*)d_in[i];
    a.out = (float*)d_out; a.ws = (unsigned char*)d_ws;
#if MK_PER_PHASE
    for (int p = 0; p < N_PHASES; ++p) { a.ph_lo = p; a.ph_hi = p + 1; hipLaunchKernelGGL(hybrid_fwd, dim3(grid), dim3(NTHR), LDS_BYTES, stream, a); }
#else
    a.ph_lo = 0; a.ph_hi = N_PHASES;
    void* kargs[] = {&a};
    hipError_t e = hipLaunchCooperativeKernel((const void*)hybrid_fwd, dim3(grid), dim3(NTHR), kargs, LDS_BYTES, stream);
    if (e != hipSuccess) fprintf(stderr, "kernel_launch: cooperative launch failed: %s (grid %d)\n", hipGetErrorString(e), grid);
#endif
}
```

```cpp
#include <hip/hip_runtime.h>
#include <hip/hip_cooperative_groups.h>
#include <hip/hip_bf16.h>
#include <cstdio>
#include <cstdint>
#include <cmath>
namespace cg = cooperative_groups;
namespace pg8 {
#define PG8_LAS __attribute__((address_space(3)))
typedef unsigned short bf16_t;
typedef short bf16x8 __attribute__((ext_vector_type(8)));
typedef float f32x4 __attribute__((ext_vector_type(4)));
typedef unsigned u32x4 __attribute__((ext_vector_type(4)));
constexpr int BM = 256, BK = 64, HALF = 128, HTB = HALF * BK * 2  , STAGE_BYTES = 8 * HTB, NXCD = 8, WGM = 8;

__host__ __device__ __forceinline__ int lds_byte(int r, int c) { const int st = (r >> 4) * 2 + (c >> 5), rr = r & 15, cc = c & 31, ob = rr * 64 + cc * 2; return st * 1024 + (ob ^ (((ob >> 9) & 1) << 5)); }
__host__ __device__ __forceinline__ void stage_rc(int b, int& R, int& C) { const int st = b / 1024, sb = b % 1024, swz = sb ^ (((sb >> 9) & 1) << 5); R = (st >> 1) * 16 + swz / 64; C = (st & 1) * 32 + (swz % 64) / 2; }
__host__ __device__ __forceinline__ int perm32(int rho) { const int n = rho >> 4, i = rho & 15; return 8 * (i >> 2) + 4 * n + (i & 3); }

struct Unit { int pm, pn; };
struct Gemm { const bf16_t* A; const bf16_t* Bt; int M, N, K, lda, ldb; };

struct StaticOrder {
    int nM, nN, nwg, G, c;
    __host__ __device__ void init(int M, int N, int G_, int c_) { nM = M / BM; nN = N / BM; nwg = nM * nN; G = G_; c = c_; }
    __host__ __device__ bool next(int i, Unit& u) const {
        const long L = (long)i * G + c; if (L >= nwg) return false;
        int wgid = (int)L; { const int q = nwg / NXCD, r = nwg % NXCD, xcd = wgid % NXCD, off = wgid / NXCD; wgid = (xcd < r ? xcd * (q + 1) : r * (q + 1) + (xcd - r) * q) + off; }
        const int nig = WGM * nN, gid = wgid / nig, fm = gid * WGM, gsz = (nM - fm) < WGM ? (nM - fm) : WGM;
        u.pm = fm + ((wgid % nig) % gsz); u.pn = (wgid % nig) / gsz; return true;
    }
    __device__ __forceinline__ void a_ready(const Unit&) const {}
    __device__ __forceinline__ void done(const Unit&) const {}
};
typedef float f32x2 __attribute__((ext_vector_type(2)));
typedef __bf16 bf16x2_t __attribute__((ext_vector_type(2)));
typedef unsigned u32x2 __attribute__((ext_vector_type(2)));
__device__ __forceinline__ unsigned cvt_pk_bf16(float lo, float hi) { f32x2 v = {lo, hi}; bf16x2_t b = __builtin_convertvector(v, bf16x2_t); return __builtin_bit_cast(unsigned, b); }
__device__ __forceinline__ float bf_lo(unsigned w) { return __builtin_bit_cast(float, w << 16); }
__device__ __forceinline__ float bf_hi(unsigned w) { return __builtin_bit_cast(float, w & 0xffff0000u); }
__device__ __forceinline__ float sigmoidf_(float x) { return 1.0f / (1.0f + __expf(-x)); }

struct EpiIn {
    static constexpr bool PERM = true, AFTER_DRAIN = false;
    bf16_t* U; int ldu; unsigned scale_tiles; float scale; int misc_tile; float* misc;
    __device__ __forceinline__ void operator()(const f32x4 (&acc)[2][2][4][2], const Unit& u, int wr, int wc, int fr, int fq) const {
        const int row0 = u.pm * BM + wr * 64 + fr;
        if (u.pn == misc_tile) {
#pragma unroll
            for (int ai = 0; ai < 2; ++ai)
#pragma unroll
                for (int m = 0; m < 4; ++m) { float* rowp = misc + (size_t)(row0 + ai * HALF + m * 16) * 128 + wc * 32 + 8 * fq;
                    *(f32x4*)(rowp) = acc[ai][0][m][0]; *(f32x4*)(rowp + 4) = acc[ai][0][m][1]; }
            return;
        }
        const float sc = ((scale_tiles >> u.pn) & 1u) ? scale : 1.0f;
        const int col0 = u.pn * BM + wc * 32 + 8 * fq;
#pragma unroll
        for (int ai = 0; ai < 2; ++ai)
#pragma unroll
            for (int m = 0; m < 4; ++m) { bf16_t* rowp = U + (size_t)(row0 + ai * HALF + m * 16) * ldu + col0;
#pragma unroll
                for (int bj = 0; bj < 2; ++bj) { const f32x4 v0 = acc[ai][bj][m][0] * sc, v1 = acc[ai][bj][m][1] * sc;
                    u32x4 w; w.x = cvt_pk_bf16(v0[0], v0[1]); w.y = cvt_pk_bf16(v0[2], v0[3]); w.z = cvt_pk_bf16(v1[0], v1[1]); w.w = cvt_pk_bf16(v1[2], v1[3]);
                    *(u32x4*)(rowp + bj * HALF) = w; } }
    }
};
struct EpiSig {
    static constexpr bool PERM = true, AFTER_DRAIN = false;
    bf16_t* O; int ldc; const float* bias;
    __device__ __forceinline__ void operator()(const f32x4 (&acc)[2][2][4][2], const Unit& u, int wr, int wc, int fr, int fq) const {
        const int row0 = u.pm * BM + wr * 64 + fr, col0 = u.pn * BM + wc * 32 + 8 * fq;
        f32x4 bv[2][2];
#pragma unroll
        for (int bj = 0; bj < 2; ++bj)
#pragma unroll
            for (int n = 0; n < 2; ++n) bv[bj][n] = *(const f32x4*)(bias + col0 + bj * HALF + 4 * n);
#pragma unroll
        for (int ai = 0; ai < 2; ++ai)
#pragma unroll
            for (int m = 0; m < 4; ++m) { bf16_t* rowp = O + (size_t)(row0 + ai * HALF + m * 16) * ldc + col0;
#pragma unroll
                for (int bj = 0; bj < 2; ++bj) { f32x4 v0 = acc[ai][bj][m][0] + bv[bj][0], v1 = acc[ai][bj][m][1] + bv[bj][1];
#pragma unroll
                    for (int j = 0; j < 4; ++j) { v0[j] = sigmoidf_(v0[j]); v1[j] = sigmoidf_(v1[j]); }
                    u32x4 w; w.x = cvt_pk_bf16(v0[0], v0[1]); w.y = cvt_pk_bf16(v0[2], v0[3]); w.z = cvt_pk_bf16(v1[0], v1[1]); w.w = cvt_pk_bf16(v1[2], v1[3]);
                    *(u32x4*)(rowp + bj * HALF) = w; } }
    }
};
struct EpiBranch {
    static constexpr bool PERM = false, AFTER_DRAIN = false;
    bf16_t* G; float* Mg; int ldc; int first, last;
    __device__ __forceinline__ void operator()(const f32x4 (&acc)[2][2][4][2], const Unit& u, int wr, int wc, int fr, int fq) const {
        const int row0 = u.pm * BM + wr * 64 + fr, col0 = u.pn * BM + wc * 32 + 4 * fq;
#pragma unroll
        for (int ai = 0; ai < 2; ++ai)
#pragma unroll
            for (int m = 0; m < 4; ++m) { const size_t ro = (size_t)(row0 + ai * HALF + m * 16) * ldc + col0;
#pragma unroll
                for (int bj = 0; bj < 2; ++bj)
#pragma unroll
                    for (int n = 0; n < 2; ++n) { const size_t off = ro + bj * HALF + n * 16;
                        const u32x2 gw = *(const u32x2*)(G + off);
                        f32x4 v = acc[ai][bj][m][n]; v[0] *= bf_lo(gw.x); v[1] *= bf_hi(gw.x); v[2] *= bf_lo(gw.y); v[3] *= bf_hi(gw.y);
                        if (!first) v = v + *(const f32x4*)(Mg + off);
                        if (last) { u32x2 w; w.x = cvt_pk_bf16(v[0], v[1]); w.y = cvt_pk_bf16(v[2], v[3]); *(u32x2*)(G + off) = w; }
                        else *(f32x4*)(Mg + off) = v; } }
    }
};
struct EpiF32 {
    static constexpr bool PERM = false, AFTER_DRAIN = false;
    float* C; int ldc;
    __device__ __forceinline__ void operator()(const f32x4 (&acc)[2][2][4][2], const Unit& u, int wr, int wc, int fr, int fq) const {
        const int row0 = u.pm * BM + wr * 64 + fr, col0 = u.pn * BM + wc * 32 + 4 * fq;
#pragma unroll
        for (int ai = 0; ai < 2; ++ai)
#pragma unroll
            for (int m = 0; m < 4; ++m) { float* rowp = C + (size_t)(row0 + ai * HALF + m * 16) * ldc + col0;
#pragma unroll
                for (int bj = 0; bj < 2; ++bj)
#pragma unroll
                    for (int n = 0; n < 2; ++n) *(f32x4*)(rowp + bj * HALF + n * 16) = acc[ai][bj][m][n]; }
    }
};
struct EpiSwi {
    static constexpr bool PERM = true, AFTER_DRAIN = false;
    bf16_t* O; int ldc;
    __device__ __forceinline__ void operator()(const f32x4 (&acc)[2][2][4][2], const Unit& u, int wr, int wc, int fr, int fq) const {
        const int row0 = u.pm * BM + wr * 64 + fr, col0 = u.pn * HALF + wc * 32 + 8 * fq;
#pragma unroll
        for (int ai = 0; ai < 2; ++ai)
#pragma unroll
            for (int m = 0; m < 4; ++m) { bf16_t* rowp = O + (size_t)(row0 + ai * HALF + m * 16) * ldc + col0;
                f32x4 v0 = acc[ai][0][m][0], v1 = acc[ai][0][m][1]; const f32x4 u0 = acc[ai][1][m][0], u1 = acc[ai][1][m][1];
#pragma unroll
                for (int j = 0; j < 4; ++j) { v0[j] = v0[j] * sigmoidf_(v0[j]) * u0[j]; v1[j] = v1[j] * sigmoidf_(v1[j]) * u1[j]; }
                u32x4 w; w.x = cvt_pk_bf16(v0[0], v0[1]); w.y = cvt_pk_bf16(v0[2], v0[3]); w.z = cvt_pk_bf16(v1[0], v1[1]); w.w = cvt_pk_bf16(v1[2], v1[3]);
                *(u32x4*)(rowp) = w; }
    }
};

template <class Epi, class Sched, bool ALIGN_EPI = false, bool SP2 = false>
__device__ __forceinline__ void gemm_phase(PG8_LAS unsigned char* lds, const Gemm g, const Sched& S, const Epi& E, const int tid_in) {
    const int tid = tid_in, wid = __builtin_amdgcn_readfirstlane(tid >> 6), lane = tid & 63, wr = wid >> 2, wc = wid & 3, fr = lane & 15, fq = lane >> 4;
    const int K = g.K, nt = K / BK;
    unsigned voffA[2], voffB[2];
#pragma unroll
    for (int i = 0; i < 2; ++i) { int R, C; stage_rc(tid * 16 + i * 8192, R, C); const int Rb = Epi::PERM ? ((R & ~31) + perm32(R & 31)) : R;
        voffA[i] = (unsigned)(R * g.lda + C) * 2u; voffB[i] = (unsigned)(Rb * g.ldb + C) * 2u; }
    const size_t kstep = (size_t)(BK * 2);
    const size_t hstepA = (size_t)HALF * g.lda * 2, hstepB = (size_t)HALF * g.ldb * 2;
    const size_t tstepA = 2 * hstepA, tstepB = 2 * hstepB;
    const unsigned ldsw = (unsigned)wid * 1024u;
    const int aoff = lds_byte(wr * 64 + fr, fq * 8), boff = lds_byte(wc * 32 + fr, fq * 8);
#define PG8_SA(b, h) (((b) * 2 + (h)) * HTB)
#define PG8_SB(b, h) ((4 + (b) * 2 + (h)) * HTB)
#define PG8_STAGE(bufoff, gbase, voff) do { _Pragma("unroll") for (int _i = 0; _i < 2; ++_i) \
        __builtin_amdgcn_global_load_lds((const unsigned*)((const char*)(gbase) + (voff)[_i]), (PG8_LAS unsigned*)(lds + (bufoff) + ldsw + _i * 8192), 16, 0, 0); } while (0)
#define PG8_LDA(dst, b, h) do { _Pragma("unroll") for (int m = 0; m < 4; ++m) _Pragma("unroll") for (int k = 0; k < 2; ++k) dst[m][k] = *(const PG8_LAS bf16x8*)(lds + PG8_SA(b, h) + aoff + m * 2048 + k * 1024); } while (0)
#define PG8_LDB(dst, b, h) do { _Pragma("unroll") for (int n = 0; n < 2; ++n) _Pragma("unroll") for (int k = 0; k < 2; ++k) dst[n][k] = *(const PG8_LAS bf16x8*)(lds + PG8_SB(b, h) + boff + n * 2048 + k * 1024); } while (0)
#define PG8_MMA(ai, bj, At, Bt) do { __builtin_amdgcn_s_setprio(1); _Pragma("unroll") for (int m = 0; m < 4; ++m) _Pragma("unroll") for (int n = 0; n < 2; ++n) _Pragma("unroll") for (int k = 0; k < 2; ++k) \
        acc[ai][bj][m][n] = __builtin_amdgcn_mfma_f32_16x16x32_bf16(Bt[n][k], At[m][k], acc[ai][bj][m][n], 0, 0, 0); __builtin_amdgcn_s_setprio(0); } while (0)
#define PG8_WAIT_V(n) asm volatile("s_waitcnt vmcnt(" #n ")" ::: "memory")
#define PG8_WAIT_L(n) asm volatile("s_waitcnt lgkmcnt(" #n ")" ::: "memory")
#define PG8_BAR __builtin_amdgcn_s_barrier()
#define PG8_SCHED __builtin_amdgcn_sched_barrier(0)
    Unit cur, nxt; int ui = 0;
    if (!S.next(0, cur)) return;
    f32x4 acc[2][2][4][2];
#pragma unroll
    for (int a = 0; a < 2; ++a)
#pragma unroll
        for (int b = 0; b < 2; ++b)
#pragma unroll
            for (int m = 0; m < 4; ++m)
#pragma unroll
                for (int n = 0; n < 2; ++n) acc[a][b][m][n] = (f32x4){0.f, 0.f, 0.f, 0.f};
    bf16x8 At[4][2], B0[2][2], B1[2][2];
    const char* cA = (const char*)g.A + (size_t)cur.pm * tstepA; const char* cB = (const char*)g.Bt + (size_t)cur.pn * tstepB;
    S.a_ready(cur);
    if constexpr (SP2) {
        PG8_STAGE(PG8_SB(0, 0), cB, voffB); PG8_STAGE(PG8_SB(0, 1), cB + hstepB, voffB); PG8_STAGE(PG8_SA(0, 0), cA, voffA); PG8_STAGE(PG8_SA(0, 1), cA + hstepA, voffA);
        if (wr == 1) PG8_BAR;
        PG8_WAIT_V(2); PG8_BAR;
        PG8_STAGE(PG8_SB(1, 0), cB + kstep, voffB); PG8_STAGE(PG8_SA(1, 0), cA + kstep, voffA); PG8_STAGE(PG8_SB(1, 1), cB + hstepB + kstep, voffB);
        PG8_WAIT_V(6); PG8_BAR;
    } else {
        PG8_STAGE(PG8_SB(0, 0), cB, voffB); PG8_STAGE(PG8_SA(0, 0), cA, voffA); PG8_STAGE(PG8_SB(0, 1), cB + hstepB, voffB); PG8_STAGE(PG8_SA(0, 1), cA + hstepA, voffA);
        if (wr == 1) PG8_BAR;
        PG8_WAIT_V(4); PG8_BAR;
        PG8_STAGE(PG8_SB(1, 0), cB + kstep, voffB); PG8_STAGE(PG8_SA(1, 0), cA + kstep, voffA); PG8_STAGE(PG8_SB(1, 1), cB + hstepB + kstep, voffB);
        PG8_WAIT_V(6); PG8_BAR;
    }
    for (;;) {
        const bool has_next = S.next(ui + 1, nxt);
        const char* nA = has_next ? (const char*)g.A + (size_t)nxt.pm * tstepA : cA; const char* nB = has_next ? (const char*)g.Bt + (size_t)nxt.pn * tstepB : cB;
        for (int t = 0; t < nt; t += 2) {
            const bool last = (t == nt - 2);
            const char* a1 = cA + (size_t)(t + 1) * kstep;
            const char* a2 = last ? nA : cA + (size_t)(t + 2) * kstep; const char* b2 = last ? nB : cB + (size_t)(t + 2) * kstep;
            const char* a3 = a2 + kstep; const char* b3 = b2 + kstep;
            if (last && has_next) S.a_ready(nxt);
            if constexpr (SP2) {
            PG8_LDB(B0, 0, 0); PG8_LDB(B1, 0, 1); PG8_SCHED; PG8_LDA(At, 0, 0); PG8_STAGE(PG8_SA(1, 1), a1 + hstepA, voffA);
            PG8_WAIT_V(8); PG8_WAIT_L(0); PG8_BAR; PG8_MMA(0, 0, At, B0); PG8_MMA(0, 1, At, B1); PG8_BAR; PG8_SCHED;
            PG8_LDA(At, 0, 1); PG8_STAGE(PG8_SB(0, 0), b2, voffB); PG8_STAGE(PG8_SB(0, 1), b2 + hstepB, voffB); PG8_STAGE(PG8_SA(0, 0), a2, voffA);
            PG8_WAIT_V(8); PG8_WAIT_L(0); PG8_BAR; PG8_MMA(1, 0, At, B0); PG8_MMA(1, 1, At, B1); PG8_BAR; PG8_SCHED;
            PG8_LDB(B0, 1, 0); PG8_LDB(B1, 1, 1); PG8_SCHED; PG8_LDA(At, 1, 0); PG8_STAGE(PG8_SA(0, 1), a2 + hstepA, voffA);
            PG8_WAIT_V(8); PG8_WAIT_L(0); PG8_BAR; PG8_MMA(0, 0, At, B0); PG8_MMA(0, 1, At, B1); PG8_BAR; PG8_SCHED;
            PG8_LDA(At, 1, 1); PG8_STAGE(PG8_SB(1, 0), b3, voffB); PG8_STAGE(PG8_SB(1, 1), b3 + hstepB, voffB); PG8_STAGE(PG8_SA(1, 0), a3, voffA);
            PG8_WAIT_V(8); PG8_WAIT_L(0); PG8_BAR; PG8_MMA(1, 0, At, B0); PG8_MMA(1, 1, At, B1); PG8_BAR; PG8_SCHED;
            } else {
            PG8_LDB(B0, 0, 0); PG8_SCHED; PG8_LDA(At, 0, 0); PG8_STAGE(PG8_SA(1, 1), a1 + hstepA, voffA);
            PG8_WAIT_L(8); PG8_BAR; PG8_WAIT_L(0); PG8_MMA(0, 0, At, B0); PG8_BAR; PG8_SCHED;
            PG8_LDB(B1, 0, 1); PG8_STAGE(PG8_SB(0, 0), b2, voffB);
            PG8_BAR; PG8_WAIT_L(0); PG8_MMA(0, 1, At, B1); PG8_BAR;
            PG8_LDA(At, 0, 1); PG8_STAGE(PG8_SA(0, 0), a2, voffA);
            PG8_BAR; PG8_WAIT_L(0); PG8_MMA(1, 0, At, B0); PG8_BAR; PG8_SCHED;
            PG8_STAGE(PG8_SB(0, 1), b2 + hstepB, voffB);
            PG8_WAIT_V(6); PG8_BAR; PG8_MMA(1, 1, At, B1); PG8_BAR;
            PG8_LDB(B0, 1, 0); PG8_SCHED; PG8_LDA(At, 1, 0); PG8_STAGE(PG8_SA(0, 1), a2 + hstepA, voffA);
            PG8_WAIT_L(8); PG8_BAR; PG8_WAIT_L(0); PG8_MMA(0, 0, At, B0); PG8_BAR; PG8_SCHED;
            PG8_LDB(B1, 1, 1); PG8_STAGE(PG8_SB(1, 0), b3, voffB);
            PG8_BAR; PG8_WAIT_L(0); PG8_MMA(0, 1, At, B1); PG8_BAR;
            PG8_LDA(At, 1, 1); PG8_STAGE(PG8_SA(1, 0), a3, voffA);
            PG8_BAR; PG8_WAIT_L(0); PG8_MMA(1, 0, At, B0); PG8_BAR; PG8_SCHED;
            PG8_STAGE(PG8_SB(1, 1), b3 + hstepB, voffB);
            PG8_WAIT_V(6); PG8_BAR; PG8_MMA(1, 1, At, B1); PG8_BAR;
            }
        }
        if constexpr (ALIGN_EPI) { if (wr == 0) PG8_BAR; }
        if constexpr (!Epi::AFTER_DRAIN) { E(acc, cur, wr, wc, fr, fq); S.done(cur); }
        if (!has_next) break;
#pragma unroll
        for (int a = 0; a < 2; ++a)
#pragma unroll
            for (int b = 0; b < 2; ++b)
#pragma unroll
                for (int m = 0; m < 4; ++m)
#pragma unroll
                    for (int n = 0; n < 2; ++n) acc[a][b][m][n] = (f32x4){0.f, 0.f, 0.f, 0.f};
        cur = nxt; cA = nA; cB = nB; ++ui;
        if constexpr (ALIGN_EPI) { if (wr == 1) PG8_BAR; }
    }
    PG8_WAIT_V(0);
    if constexpr (!ALIGN_EPI) { if (wr == 0) PG8_BAR; }
    PG8_BAR;
    if constexpr (Epi::AFTER_DRAIN) { E.fused(acc, cur, wr, wc, fr, fq, lds, wid, lane); S.done(cur); }
#undef PG8_SA
#undef PG8_SB
#undef PG8_STAGE
#undef PG8_LDA
#undef PG8_LDB
#undef PG8_MMA
#undef PG8_WAIT_V
#undef PG8_WAIT_L
#undef PG8_BAR
#undef PG8_SCHED
}
}

#include <hip/hip_bf16.h>
#include <cmath>
namespace attn_body {
using bf16=__hip_bfloat16;
using bf16x8=__attribute__((ext_vector_type(8)))short;
using s16x4=__attribute__((ext_vector_type(4)))short;
using f32x16=__attribute__((ext_vector_type(16)))float;
using u32x4=__attribute__((ext_vector_type(4)))unsigned;
constexpr int BATCH=2,SEQ=8192,D=64;
constexpr int NW=8,QBLK=32,QB=QBLK*NW,KVBLK=64,NQB=SEQ/QB;
constexpr int ATTN_UNIT_ROWS=QB;
__device__ __forceinline__ int crow(int r,int hi){return (r&3)+8*(r>>2)+4*hi;}
#define SBAR() __builtin_amdgcn_sched_barrier(0)
__device__ __forceinline__ void cmask(f32x16&p0,f32x16&p1,int jb,int qrel,int hi){
  const float NEG=-INFINITY; int kb=64*jb+4*hi;
  #pragma unroll
  for(int r=0;r<16;++r){int kv=kb+(r&3)+8*(r>>2); if(kv>qrel)p0[r]=NEG; if(kv+32>qrel)p1[r]=NEG;}
}

constexpr int NSLOT=3, SLOTB=8192;
constexpr int LDS_K=0, LDS_V=NSLOT*SLOTB, LDS_WS=2*NSLOT*SLOTB, LDS_OST=LDS_WS+NW*64*4, LDS_BYTES=LDS_OST+NW*4096, LDS_CF=LDS_BYTES, LDS_TOTAL=LDS_CF+32768;
constexpr float C2=0.125f*1.4426950408889634f;
__device__ __forceinline__ void glds16(const void*gsrc,unsigned lds_dst){unsigned keep;
  asm volatile("s_mov_b32 %0, m0\n\ts_mov_b32 m0, %2\n\ts_nop 0\n\tglobal_load_lds_dwordx4 %1, off\n\ts_mov_b32 m0, %0":"=&s"(keep):"v"(gsrc),"s"(lds_dst):"memory");}
__device__ __forceinline__ void glds4(const void*gsrc,unsigned lds_dst){unsigned keep;
  asm volatile("s_mov_b32 %0, m0\n\ts_mov_b32 m0, %2\n\ts_nop 0\n\tglobal_load_lds_dword %1, off\n\ts_mov_b32 m0, %0":"=&s"(keep):"v"(gsrc),"s"(lds_dst):"memory");}
__device__ __forceinline__ float max3f(float a,float b,float c){float r;asm("v_max3_f32 %0, %1, %2, %3":"=v"(r):"v"(a),"v"(b),"v"(c));return r;}
__device__ __forceinline__ float max2f(float a,float b){float r;asm("v_max_f32_e32 %0, %1, %2":"=v"(r):"v"(a),"v"(b));return r;}
__device__ __forceinline__ float fadd_s(float a,float b){float r;asm("v_add_f32_e32 %0, %1, %2":"=v"(r):"v"(a),"v"(b));return r;}
__device__ __forceinline__ float fsub_s(float a,float b){float r;asm("v_sub_f32_e32 %0, %1, %2":"=v"(r):"v"(a),"v"(b));return r;}
typedef float f32x2_t __attribute__((ext_vector_type(2))); typedef __bf16 bf16x2_t __attribute__((ext_vector_type(2)));
__device__ __forceinline__ unsigned cvtpk_s(float lo,float hi){f32x2_t v={lo,hi};bf16x2_t b=__builtin_convertvector(v,bf16x2_t);return __builtin_bit_cast(unsigned,b);}
#define WAIT_BAR(N) asm volatile("s_waitcnt vmcnt(" #N ") lgkmcnt(0)\n\ts_barrier":::"memory")

__device__ __forceinline__ void qkt(f32x16&p0,f32x16&p1,const char*Kslot,const bf16x8*qr,const f32x16&negm,int r32,int hi){
  const char*kb=Kslot+hi*1024+r32*16;
  #pragma unroll
  for(int d0=0;d0<4;++d0){
    const bf16x8 b0=*reinterpret_cast<const bf16x8*>(kb+d0*2048);
    const bf16x8 b1=*reinterpret_cast<const bf16x8*>(kb+d0*2048+512);
    if(d0==0){p0=__builtin_amdgcn_mfma_f32_32x32x16_bf16(b0,qr[0],negm,0,0,0);p1=__builtin_amdgcn_mfma_f32_32x32x16_bf16(b1,qr[0],negm,0,0,0);}
    else{p0=__builtin_amdgcn_mfma_f32_32x32x16_bf16(b0,qr[d0],p0,0,0,0);p1=__builtin_amdgcn_mfma_f32_32x32x16_bf16(b1,qr[d0],p1,0,0,0);}}
}
typedef __attribute__((address_space(3))) const char* lds_cptr;
typedef short v4i16_t __attribute__((ext_vector_type(4)));
__device__ __forceinline__ void kload8(bf16x8*kf,lds_cptr kp){
  kf[0]=*(const __attribute__((address_space(3))) bf16x8*)(kp);      kf[1]=*(const __attribute__((address_space(3))) bf16x8*)(kp+512);
  kf[2]=*(const __attribute__((address_space(3))) bf16x8*)(kp+2048); kf[3]=*(const __attribute__((address_space(3))) bf16x8*)(kp+2560);
  kf[4]=*(const __attribute__((address_space(3))) bf16x8*)(kp+4096); kf[5]=*(const __attribute__((address_space(3))) bf16x8*)(kp+4608);
  kf[6]=*(const __attribute__((address_space(3))) bf16x8*)(kp+6144); kf[7]=*(const __attribute__((address_space(3))) bf16x8*)(kp+6656);
}
__device__ __forceinline__ void kload2(bf16x8*kf,lds_cptr kp,int j){ kf[2*j]=*(const __attribute__((address_space(3))) bf16x8*)(kp+j*2048); kf[2*j+1]=*(const __attribute__((address_space(3))) bf16x8*)(kp+j*2048+512); }
__device__ __forceinline__ s16x4 vtr(lds_cptr p){ return __builtin_bit_cast(s16x4,__builtin_amdgcn_ds_read_tr16_b64_v4i16((__attribute__((address_space(3))) v4i16_t*)p)); }
__device__ __forceinline__ float rowmax(const f32x16&p0,const f32x16&p1){
  float a=max3f(p0[0],p0[1],p1[0]),b=max3f(p0[2],p0[3],p1[1]);a=max3f(a,p1[2],p1[3]);
  #pragma unroll
  for(int r=4;r<16;r+=4){a=max3f(a,p0[r],p0[r+1]);b=max3f(b,p0[r+2],p0[r+3]);a=max3f(a,p1[r],p1[r+1]);b=max3f(b,p1[r+2],p1[r+3]);}
  const float m=max2f(a,b);
  auto rr=__builtin_amdgcn_permlane32_swap(__float_as_uint(m),__float_as_uint(m),false,false);
  return max2f(__uint_as_float(rr[0]),__uint_as_float(rr[1]));
}
__device__ __forceinline__ void pv(f32x16*o,int vb,bf16x8 pa0,bf16x8 pa1,bf16x8 pa2,bf16x8 pa3){
  #pragma unroll
  for(int d0=0;d0<2;++d0){s16x4 lo[4],hi[4];
    #pragma unroll
    for(int ks=0;ks<4;++ks){
      asm volatile("ds_read_b64_tr_b16 %0,%1 offset:%c2":"=&v"(lo[ks]):"v"(vb),"i"(d0*4096+ks*1024):"memory");
      asm volatile("ds_read_b64_tr_b16 %0,%1 offset:%c2":"=&v"(hi[ks]):"v"(vb),"i"(d0*4096+ks*1024+512):"memory");}
    asm volatile("s_waitcnt lgkmcnt(0)":::"memory");SBAR();
    #define PK(k) (bf16x8){lo[k][0],lo[k][1],lo[k][2],lo[k][3],hi[k][0],hi[k][1],hi[k][2],hi[k][3]}
    o[d0]=__builtin_amdgcn_mfma_f32_32x32x16_bf16(pa0,PK(0),o[d0],0,0,0);
    o[d0]=__builtin_amdgcn_mfma_f32_32x32x16_bf16(pa1,PK(1),o[d0],0,0,0);
    o[d0]=__builtin_amdgcn_mfma_f32_32x32x16_bf16(pa2,PK(2),o[d0],0,0,0);
    o[d0]=__builtin_amdgcn_mfma_f32_32x32x16_bf16(pa3,PK(3),o[d0],0,0,0);
    #undef PK
  }
}


typedef __attribute__((address_space(3))) const float* lds_cfptr;
typedef float f32x4m __attribute__((ext_vector_type(4)));
template<int MODE,bool BAND> __device__ __forceinline__ void tile_mask(f32x16&p0,f32x16&p1,int t,int NT,int qrel,int hi,lds_cfptr cfl,lds_cptr mring){
  const float NEG=-INFINITY;
  const int jb=t-(NT-4); const int dq=qrel-((BAND && jb>=0)?(64*jb+4*hi):-(1<<20));
  if constexpr(MODE==0){
    const __attribute__((address_space(3))) f32x4m* c4=(const __attribute__((address_space(3))) f32x4m*)(cfl+64*t+4*hi);
    #pragma unroll
    for(int g=0;g<4;++g){ const f32x4m a=c4[2*g], bq=c4[8+2*g];
      #pragma unroll
      for(int j=0;j<4;++j){ const int kc=j+8*g; const float v0=p0[4*g+j]-a[j], v1=p1[4*g+j]-bq[j];
        if constexpr(BAND){ p0[4*g+j]=(kc>dq)?NEG:v0; p1[4*g+j]=(kc+32>dq)?NEG:v1; } else { p0[4*g+j]=v0; p1[4*g+j]=v1; } }
      __builtin_amdgcn_sched_barrier(0); }
  }
  if constexpr(MODE==1 || MODE==3){
    if constexpr(BAND){
      #pragma unroll
      for(int r=0;r<16;++r){ const int kc=(r&3)+8*(r>>2); p0[r]=(kc>dq)?NEG:p0[r]; p1[r]=(kc+32>dq)?NEG:p1[r]; } }
  }
  if constexpr(MODE==2){
    const unsigned long long mw=*(const __attribute__((address_space(3))) unsigned long long*)(mring+(t&3)*256);
    const int lo=(int)((unsigned)mw>>(4*hi)), hw=(int)((unsigned)(mw>>32)>>(4*hi));
    #pragma unroll
    for(int r=0;r<16;++r){ const int sh=(r&3)+8*(r>>2);
      p0[r]=(((unsigned)lo>>sh)&1u)?p0[r]:NEG; p1[r]=(((unsigned)hw>>sh)&1u)?p1[r]:NEG; }
  }
}
#ifndef ATTN_STORE16
#define ATTN_STORE16(p,v) (*(u32x4*)(p)=(v))
#endif
template<int THRL,int MODE,int DM,int ODM> __device__ __forceinline__ void attn_unit(int b,int h,int qb,const bf16*Q,const bf16*__restrict__ K,const bf16*__restrict__ V,bf16*O,char*shm,const void*aux,const float*aux2,const int tid_in){
  const int tid=tid_in,lane=tid&63,r32=lane&31,hi=lane>>5; const int wid=__builtin_amdgcn_readfirstlane(tid>>6);
  const long rowbase=(long)b*SEQ; const int q0=qb*QB;
  const bf16*Qw=Q+(rowbase+q0+wid*QBLK)*DM+h*D;
  int t0=0;
  if constexpr(MODE==0){ const float*cf=(const float*)aux+((long)b*8+h)*SEQ; const float smax=sqrtf(aux2[(b*8+h)*2]*aux2[(b*8+h)*2+1]);
    const float bnd=cf[q0]+2.f*smax+40.f; const int ntl=(q0+QB)/KVBLK-4;
    const int j0=lane, j1=lane+64; const bool d0_=(j0<ntl)&&(cf[64*j0+63]>=bnd), d1_=(j1<ntl)&&(cf[64*j1+63]>=bnd);
    t0=(__popcll(__ballot(d0_))+__popcll(__ballot(d1_)))&~1; t0=__builtin_amdgcn_readfirstlane(t0); }
  const bf16*Kh=K+(rowbase+(long)t0*KVBLK)*DM+h*D,*Vh=V+(rowbase+(long)t0*KVBLK)*DM+h*D;
  const unsigned lds0=(unsigned)(uintptr_t)shm;
  float*wsf=(float*)(shm+LDS_WS)+wid*64;
  const bf16*ksrc=Kh+(long)lane*DM+wid*8;
  const bf16*vsrc=Vh+(long)(16*(wid&3)+(lane>>2))*DM+(wid>>2)*32+(lane&3)*8;
  const unsigned kdst=lds0+LDS_K+wid*1024, vdst=lds0+LDS_V+wid*1024;
  #define DMA_K(t,slot) glds16(ksrc+(long)(t)*KVBLK*DM,(unsigned)__builtin_amdgcn_readfirstlane(kdst+(slot)))
  #define DMA_V(t,slot) glds16(vsrc+(long)(t)*KVBLK*DM,(unsigned)__builtin_amdgcn_readfirstlane(vdst+(slot)))
  const int vb0=(int)(lds0+LDS_V)+((lane>>4)&1)*32+(lane&3)*8+(4*hi+((lane&15)>>2))*64;
  const char*Kbase=shm+LDS_K; bf16x8 kf[8];
  const lds_cptr shm3=(lds_cptr)shm; const lds_cptr kp0=shm3+LDS_K+hi*1024+r32*16; const lds_cptr vp0=shm3+LDS_V+((lane>>4)&1)*32+(lane&3)*8+(4*hi+((lane&15)>>2))*64;
  const int NT=(q0+QB)/KVBLK-t0;
  const char*msrc=nullptr; const unsigned mdst=lds0+LDS_CF+wid*1024;
  if constexpr(MODE==2){ msrc=(const char*)((const unsigned long long*)aux+(long)b*128*SEQ+q0+wid*QBLK)+lane*4; }
  #define DMA_M(t) glds4(msrc+(long)(t)*SEQ*8,(unsigned)__builtin_amdgcn_readfirstlane(mdst+(((t)&3)*256)))
  if constexpr(MODE==2){ DMA_M(0);DMA_M(1);DMA_M(2); }
  DMA_K(0,0);DMA_V(0,0);DMA_K(1,SLOTB);
  bf16x8 qr[4];
  #pragma unroll
  for(int d0=0;d0<4;++d0)qr[d0]=*reinterpret_cast<const bf16x8*>(&Qw[(long)r32*DM+d0*16+hi*8]);
  const int qrel=wid*QBLK+r32;
  float cfq2=0.f; unsigned selw=0u;
  const lds_cfptr cfl3=(lds_cfptr)(shm+LDS_CF); const lds_cptr mring=(lds_cptr)shm+LDS_CF+wid*1024+r32*8;
  if constexpr(MODE==0){ const float*cf=(const float*)aux+((long)b*8+h)*SEQ; cfq2=cf[q0+qrel];
    __attribute__((address_space(3))) f32x4m* cw=(__attribute__((address_space(3))) f32x4m*)(shm+LDS_CF);
    for(int i=tid;i<(q0+QB-t0*KVBLK)/4;i+=NW*64) cw[i]=((const f32x4m*)(cf+t0*KVBLK))[i]; }
  if constexpr(MODE==1){ selw=((const unsigned*)aux)[(rowbase+q0+qrel)*8+h]; }
  float mhat=0.f,l_reg=0.f;f32x16 o[2];o[0]=f32x16{};o[1]=f32x16{};f32x16 negm;
  #define SETNEGM(tt) do{ float v_=cfq2-mhat; if constexpr(MODE==1){ if(!((tt)>=NT-4 || ((selw>>((tt)>>2))&1u))) v_=-INFINITY; } \
      _Pragma("unroll") for(int r=0;r<16;++r)negm[r]=v_; asm volatile("":"+v"(negm)); }while(0)
  SETNEGM(0);
  #define CMASK(P0,P1,t) tile_mask<MODE,true>(P0,P1,(t),NT,qrel,hi,cfl3,mring)
  bool resc=false;
  #define START(P0,P1) do{ const float rm=max2f(rowmax(P0,P1),-100.f); resc=false; \
    { const float dl=rm; mhat=fadd_s(mhat,dl); \
      _Pragma("unroll") for(int r=0;r<16;++r){P0[r]=fsub_s(P0[r],dl);P1[r]=fsub_s(P1[r],dl);} \
      SETNEGM(1); } \
    _Pragma("unroll") for(int r=0;r<16;++r)P0[r]=__builtin_amdgcn_exp2f(P0[r]); }while(0)
  #define RESC() do{ if(resc){ asm volatile("s_waitcnt lgkmcnt(0)":::"memory"); \
      _Pragma("unroll") for(int d_=0;d_<2;++d_) _Pragma("unroll") for(int r=0;r<16;++r)o[d_][r]*=wsf[crow(r,hi)]; } }while(0)
  f32x16 pA0,pA1,pB0,pB1;
  int sl_prev=0,sl_cur=0,sl_next=SLOTB;
  #define ROT() do{sl_prev=sl_cur;sl_cur=sl_next;sl_next=(sl_next==(NSLOT-1)*SLOTB)?0:sl_next+SLOTB; }while(0)
  DMA_K(2,2*SLOTB);
  WAIT_BAR(3);
  qkt(pA0,pA1,Kbase,qr,negm,r32,hi);asm volatile("s_nop 15\n\ts_nop 7":"+v"(pA0),"+v"(pA1));CMASK(pA0,pA1,0);
  START(pA0,pA1);
  _Pragma("unroll") for(int r=0;r<16;++r)pA1[r]=__builtin_amdgcn_exp2f(pA1[r]);
  WAIT_BAR(0);
  DMA_K(3,0);DMA_V(1,SLOTB);
  ROT();
  kload8(kf,kp0+sl_cur);
  WAIT_BAR(2);
  s16x4 vlo[8],vhi[8]; u32x4 pw0,pw1,pw2,pw3;
  #define PKW(P,B) cvtpk_s(P[B],P[B+1])
  #define PAF(k) __builtin_bit_cast(bf16x8,pw##k)
  #define VFR(i) (bf16x8){vlo[i][0],vlo[i][1],vlo[i][2],vlo[i][3],vhi[i][0],vhi[i][1],vhi[i][2],vhi[i][3]}
  #define PIN(x) asm volatile("":"+v"(x))
  #define MX3(a,b,c) __builtin_fmaxf(__builtin_fmaxf((a),(b)),(c))
  #define GAPA(MF,A0,A1,A2,A3,W0,W1,PW) do{ MF; sacc+=A0; sacc+=A1; sacc+=A2; sacc+=A3; PIN(sacc); W0; W1; PIN(PW); SBAR(); }while(0)
  #define EX(v) __builtin_amdgcn_exp2f(v)
  #define GAPB(MF,X,B) do{ MF; X[B]=EX(X[B]); X[B+1]=EX(X[B+1]); X[B+2]=EX(X[B+2]); X[B+3]=EX(X[B+3]); PIN(X); SBAR(); }while(0)
  #define VRD(i) do{ vlo[i]=vtr(vp_+(((i)>>2)*4096+((i)&3)*1024)); vhi[i]=vtr(vp_+(((i)>>2)*4096+((i)&3)*1024+512)); }while(0)
  #define KRD(G,j) do{ if(G){ kload2(kf,kp0+sl_next,j); SBAR(); } }while(0)
  #define STEP(C0,C1,P0,P1,t,GK,GV,GL) do{ SBAR(); if constexpr(MODE==2){ if((t)+2<NT){DMA_M((t)+2);} } \
    const lds_cptr vp_=vp0+sl_prev; \
    VRD(0); SBAR(); float sacc=(P0[0]+P0[1]); \
    GAPA(C0=__builtin_amdgcn_mfma_f32_32x32x16_bf16(kf[0],qr[0],negm,0,0,0), P0[2],P0[3],P0[4],P0[5],     pw0[0]=PKW(P0,0), pw0[1]=PKW(P0,2), pw0); \
    VRD(4); SBAR(); GAPA(C1=__builtin_amdgcn_mfma_f32_32x32x16_bf16(kf[1],qr[0],negm,0,0,0), P0[6],P0[7],P0[8],P0[9],     pw0[2]=PKW(P0,4), pw0[3]=PKW(P0,6), pw0); \
    VRD(1); SBAR(); GAPA(C0=__builtin_amdgcn_mfma_f32_32x32x16_bf16(kf[2],qr[1],C0,0,0,0),   P0[10],P0[11],P0[12],P0[13], pw1[0]=PKW(P0,8), pw1[1]=PKW(P0,10), pw1); \
    VRD(5); SBAR(); GAPA(C1=__builtin_amdgcn_mfma_f32_32x32x16_bf16(kf[3],qr[1],C1,0,0,0),   P0[14],P0[15],P1[0],P1[1],   pw1[2]=PKW(P0,12),pw1[3]=PKW(P0,14), pw1); \
    VRD(2); SBAR(); GAPA(C0=__builtin_amdgcn_mfma_f32_32x32x16_bf16(kf[4],qr[2],C0,0,0,0),   P1[2],P1[3],P1[4],P1[5],     pw2[0]=PKW(P1,0), pw2[1]=PKW(P1,2), pw2); \
    VRD(6); SBAR(); GAPA(C1=__builtin_amdgcn_mfma_f32_32x32x16_bf16(kf[5],qr[2],C1,0,0,0),   P1[6],P1[7],P1[8],P1[9],     pw2[2]=PKW(P1,4), pw2[3]=PKW(P1,6), pw2); \
    VRD(3); SBAR(); GAPA(C0=__builtin_amdgcn_mfma_f32_32x32x16_bf16(kf[6],qr[3],C0,0,0,0),   P1[10],P1[11],P1[12],P1[13], pw3[0]=PKW(P1,8), pw3[1]=PKW(P1,10), pw3); \
    VRD(7); SBAR(); GAPA(C1=__builtin_amdgcn_mfma_f32_32x32x16_bf16(kf[7],qr[3],C1,0,0,0),   P1[14],P1[15],0.f,0.f,       pw3[2]=PKW(P1,12),pw3[3]=PKW(P1,14), pw3); \
    l_reg+=sacc; \
    if(GK){DMA_K((t)+3,sl_cur);} if(GV){DMA_V((t)+1,sl_next);} \
    CMASK(C0,C1,t); \
    { float a=MX3(C0[0],C0[1],C1[0]),b=MX3(C0[2],C0[3],C1[1]); a=MX3(a,C1[2],C1[3]); \
      _Pragma("unroll") for(int r=4;r<16;r+=4){a=MX3(a,C0[r],C0[r+1]);b=MX3(b,C0[r+2],C0[r+3]);a=MX3(a,C1[r],C1[r+1]);b=MX3(b,C1[r+2],C1[r+3]);} \
      float rm=__builtin_fmaxf(a,b); { auto rr=__builtin_amdgcn_permlane32_swap(__float_as_uint(rm),__float_as_uint(rm),false,false); rm=__builtin_fmaxf(__uint_as_float(rr[0]),__uint_as_float(rr[1])); } \
      resc=false; \
      if(__builtin_expect(__any(rm>(float)THRL),0)){ const float dl=__builtin_fmaxf(rm,0.f); mhat+=dl; \
        _Pragma("unroll") for(int r=0;r<16;++r){C0[r]-=dl;C1[r]-=dl;} \
        const float f=__builtin_amdgcn_exp2f(-dl); l_reg*=f; if(hi==0)wsf[r32]=f; resc=true; } \
      if constexpr(MODE==1){ if(resc || ((((t)+1)&3)==0)) SETNEGM((t)+1); } else { if(resc) SETNEGM((t)+1); } } \
    SBAR(); \
    GAPB(o[0]=__builtin_amdgcn_mfma_f32_32x32x16_bf16(PAF(0),VFR(0),o[0],0,0,0), C0,0); \
    GAPB(o[1]=__builtin_amdgcn_mfma_f32_32x32x16_bf16(PAF(0),VFR(4),o[1],0,0,0), C0,4); \
    KRD(GL,0); GAPB(o[0]=__builtin_amdgcn_mfma_f32_32x32x16_bf16(PAF(1),VFR(1),o[0],0,0,0), C0,8); \
    KRD(GL,1); GAPB(o[1]=__builtin_amdgcn_mfma_f32_32x32x16_bf16(PAF(1),VFR(5),o[1],0,0,0), C0,12); \
    KRD(GL,2); GAPB(o[0]=__builtin_amdgcn_mfma_f32_32x32x16_bf16(PAF(2),VFR(2),o[0],0,0,0), C1,0); \
    KRD(GL,3); GAPB(o[1]=__builtin_amdgcn_mfma_f32_32x32x16_bf16(PAF(2),VFR(6),o[1],0,0,0), C1,4); \
    GAPB(o[0]=__builtin_amdgcn_mfma_f32_32x32x16_bf16(PAF(3),VFR(3),o[0],0,0,0), C1,8); \
    GAPB(o[1]=__builtin_amdgcn_mfma_f32_32x32x16_bf16(PAF(3),VFR(7),o[1],0,0,0), C1,12); \
    }while(0)
  int t=1;
  #undef CMASK
  #define CMASK(P0,P1,t) tile_mask<MODE,false>(P0,P1,(t),NT,qrel,hi,cfl3,mring)
  for(;t+5<NT;t+=2){
    STEP(pB0,pB1,pA0,pA1,t,true,true,true);     WAIT_BAR(2); RESC(); ROT();
    STEP(pA0,pA1,pB0,pB1,t+1,true,true,true);   WAIT_BAR(2); RESC(); ROT();
  }
  #undef CMASK
  #define CMASK(P0,P1,t) tile_mask<MODE,true>(P0,P1,(t),NT,qrel,hi,cfl3,mring)
  #define ENDW(tt) do{ if((tt)+3<NT){WAIT_BAR(2);} else if((tt)+2<NT){WAIT_BAR(1);} else {WAIT_BAR(0);} }while(0)
  for(;t+1<NT;t+=2){
    STEP(pB0,pB1,pA0,pA1,t,(t+3<NT),(t+1<NT),(t+1<NT));       ENDW(t);   RESC(); ROT();
    STEP(pA0,pA1,pB0,pB1,t+1,(t+4<NT),(t+2<NT),(t+2<NT));     ENDW(t+1); RESC(); ROT();
  }
  STEP(pB0,pB1,pA0,pA1,NT-1,false,false,false); RESC();
  { float sacc=pB0[0]+pB0[1]; _Pragma("unroll") for(int r=2;r<16;++r)sacc+=pB0[r]; _Pragma("unroll") for(int r=0;r<16;++r)sacc+=pB1[r]; l_reg+=sacc;
    pw0=(u32x4){PKW(pB0,0),PKW(pB0,2),PKW(pB0,4),PKW(pB0,6)};pw1=(u32x4){PKW(pB0,8),PKW(pB0,10),PKW(pB0,12),PKW(pB0,14)};pw2=(u32x4){PKW(pB1,0),PKW(pB1,2),PKW(pB1,4),PKW(pB1,6)};pw3=(u32x4){PKW(pB1,8),PKW(pB1,10),PKW(pB1,12),PKW(pB1,14)};
    SBAR(); pv(o,vb0+sl_cur,PAF(0),PAF(1),PAF(2),PAF(3)); }
  #undef PKW
  #undef PAF
  #undef VFR
  #undef PIN
  #undef MX3
  #undef GAPA
  #undef GAPB
  #undef EX
  #undef VRD
  #undef KRD
  #undef STEP
  #undef ENDW
  {auto rr=__builtin_amdgcn_permlane32_swap(__float_as_uint(l_reg),__float_as_uint(l_reg),false,false);l_reg=__uint_as_float(rr[0])+__uint_as_float(rr[1]);}
  if(hi==0)wsf[32+r32]=l_reg;asm volatile("s_waitcnt lgkmcnt(0)":::"memory");
  float rli[16];
  #pragma unroll
  for(int r=0;r<16;++r)rli[r]=__builtin_amdgcn_rcpf(wsf[32+crow(r,hi)]);
  bf16*Ow=O+(rowbase+q0+wid*QBLK)*ODM+h*D;
  { bf16*stg=(bf16*)(shm+LDS_OST)+wid*2048;
    #pragma unroll
    for(int r=0;r<16;++r){const int orow=crow(r,hi);
      #pragma unroll
      for(int d0=0;d0<2;++d0)stg[orow*64+d0*32+r32]=__float2bfloat16(o[d0][r]*rli[r]);}
    asm volatile("s_waitcnt lgkmcnt(0)":::"memory");
    #pragma unroll
    for(int i=0;i<4;++i){const int row=i*8+(lane>>3),ch=lane&7; const u32x4 v=*(const u32x4*)(stg+row*64+ch*8); ATTN_STORE16(Ow+(long)row*ODM+ch*8,v);} }
  asm volatile("s_waitcnt lgkmcnt(0)\n\ts_barrier":::"memory");
  #undef DMA_K
  #undef DMA_V
  #undef DMA_M
  #undef CMASK
  #undef START
  #undef RESC
  #undef ROT
  #undef SETNEGM
}
constexpr int ATTN_LDS_BYTES=LDS_TOTAL;
#undef SBAR
#undef WAIT_BAR
}
#define GAS __attribute__((address_space(1)))
#define LAS __attribute__((address_space(3)))
typedef unsigned short bf16;
typedef unsigned v4u __attribute__((ext_vector_type(4)));
typedef float f32x4 __attribute__((ext_vector_type(4)));
typedef short bf16x8 __attribute__((ext_vector_type(8)));
typedef GAS unsigned gu32;
typedef GAS unsigned long long gu64;
#define RLX_AGENT __ATOMIC_RELAXED, __HIP_MEMORY_SCOPE_AGENT
#define LDS_WAIT() asm volatile("s_waitcnt lgkmcnt(0)" ::: "memory")
#define VM_WAIT() asm volatile("s_waitcnt vmcnt(0)" ::: "memory")
__device__ __forceinline__ unsigned long long rt() { return __builtin_amdgcn_s_memrealtime(); }
__device__ __forceinline__ unsigned f2bf(float f) { unsigned u = __builtin_bit_cast(unsigned, f); return (u + 0x7fffu + ((u >> 16) & 1u)) >> 16; }
__device__ __forceinline__ unsigned pk2(float lo, float hi) { return f2bf(lo) | (f2bf(hi) << 16); }

#define XB_TMO      128
#define XB_XCNT(j)  (256  + 64 * (j))
#define XB_XSUB(j)  (1280 + 64 * (j))
#define XB_XGEN(j)  (2304 + 64 * (j))
#define XB_TOP      3328
#define XB_TOPGEN   3392
#define XCD_BAR_WORDS 3456
#define XB_SPIN_CAP (1u << 18)

__device__ __forceinline__ unsigned xb_ld(unsigned* p)              { return __hip_atomic_load(p, __ATOMIC_RELAXED, __HIP_MEMORY_SCOPE_AGENT); }
__device__ __forceinline__ unsigned xb_add(unsigned* p, unsigned v) { return __hip_atomic_fetch_add(p, v, __ATOMIC_RELAXED, __HIP_MEMORY_SCOPE_AGENT); }
__device__ __forceinline__ unsigned xb_xcc_id() { return (unsigned)__builtin_amdgcn_s_getreg((3 << 11) | 20) & 0xFu; }
#define XB_SPIN(cond, bar) do { unsigned _sp = 0; while (cond) { __builtin_amdgcn_s_sleep(1); \
    if ((++_sp & 255u) == 0u) { if (xb_ld(&(bar)[XB_TMO])) break; if (_sp > XB_SPIN_CAP) { atomicAdd(&(bar)[XB_TMO], 1u); break; } } } } while (0)

struct XcdBarrier {
    unsigned* bar; unsigned x;
    volatile LAS unsigned* st;
};

__device__ __forceinline__ XcdBarrier xcd_barrier_post(unsigned* bar, volatile LAS unsigned* st) {
    XcdBarrier b; b.bar = bar; b.x = xb_xcc_id(); b.st = st;
    if (threadIdx.x == 0) (void)xb_add(&bar[XB_XCNT(b.x)], 1u);
    return b;
}
__device__ __forceinline__ void xcd_barrier_complete(unsigned* bar, unsigned x, unsigned& nloc, unsigned& nx) {
    const unsigned G = gridDim.x * gridDim.y * gridDim.z;
    unsigned sum, cnt, mine, sp = 0u;
    for (;;) {
        sum = 0u; cnt = 0u; mine = 0u;
#pragma unroll
        for (unsigned j = 0; j < 16; ++j) { const unsigned c = xb_ld(&bar[XB_XCNT(j)]); sum += c; cnt += (c > 0u) ? 1u : 0u; mine = (j == x) ? c : mine; }
        if (sum == G) break;
        __builtin_amdgcn_s_sleep(1);
        if ((++sp & 255u) == 0u) { if (xb_ld(&bar[XB_TMO])) break; if (sp > XB_SPIN_CAP) { atomicAdd(&bar[XB_TMO], 1u); break; } }
    }
    nloc = mine > 0u ? mine : 1u; nx = cnt > 0u ? cnt : 1u;
}

__device__ __forceinline__ void xcd_barrier(const XcdBarrier& b) {
    asm volatile("s_waitcnt vmcnt(0)" ::: "memory");
    __syncthreads();
    if (threadIdx.x == 0) {
        unsigned* bar = b.bar;
        __builtin_amdgcn_s_waitcnt(0);
        unsigned nloc = b.st[0], nx = b.st[1];
        if (nloc == 0u) { xcd_barrier_complete(bar, b.x, nloc, nx); b.st[0] = nloc; b.st[1] = nx; }
        const unsigned old = xb_add(&bar[XB_XSUB(b.x)], 1u);
        const unsigned gen = old / nloc;
        if (old + 1u == (gen + 1u) * nloc) {
            __builtin_amdgcn_fence(__ATOMIC_RELEASE, "agent");
            asm volatile("s_waitcnt vmcnt(0)" ::: "memory");
            const unsigned og = xb_add(&bar[XB_TOP], 1u);
            const unsigned tg = og / nx;
            if (og + 1u == (tg + 1u) * nx) xb_add(&bar[XB_TOPGEN], 1u);
            else XB_SPIN(xb_ld(&bar[XB_TOPGEN]) == tg, bar);
            __builtin_amdgcn_fence(__ATOMIC_ACQUIRE, "agent");
            xb_add(&bar[XB_XGEN(b.x)], 1u);
            asm volatile("s_waitcnt vmcnt(0)" ::: "memory");
        } else {
            XB_SPIN(xb_ld(&bar[XB_XGEN(b.x)]) == gen, bar);
            __builtin_amdgcn_fence(__ATOMIC_ACQUIRE, "agent");
            asm volatile("s_waitcnt vmcnt(0)" ::: "memory");
        }
    }
    __syncthreads();
}

constexpr int NWAVES = 8, NTHR = 512;
constexpr int NB = 2, SEQ = 8192, T = NB * SEQ, DMODEL = 1024, FFH = 2816;
constexpr int UB_P = 3328, UA_P = 3072;
constexpr int NWIN = 6656, NWIN_B = 3584, NWIN_A = 3072;
constexpr float EPS = 1e-6f;
constexpr float LOG2E = 1.4426950408889634f;
constexpr float C2 = 0.125f * 1.4426950408889634f;
constexpr size_t MiB = 1u << 20;
constexpr size_t WS_CTL = 0, CTL_ZERO_BYTES = 1 * MiB;
constexpr size_t WS_ROPEC = 1 * MiB, WS_ROPES = 2 * MiB;
constexpr size_t WS_CF2 = 3 * MiB, WS_ACS = WS_CF2 + 512 * 1024, WS_DTA = WS_ACS + 512 * 1024;
constexpr size_t WS_SELM = WS_DTA + 512 * 1024, WS_KPART = WS_SELM + 512 * 1024, WS_IKB = WS_KPART + 512 * 1024;
constexpr size_t WS_WIN = 8 * MiB;
constexpr size_t WS_WG = 8 * MiB, WS_WB = 16 * MiB;
constexpr size_t WS_H = 24 * MiB;
constexpr size_t WS_Y = 56 * MiB;
constexpr size_t WS_U = 120 * MiB;
constexpr size_t WS_XT = 216 * MiB;
constexpr size_t WS_MASK = 232 * MiB;
constexpr size_t WS_BC = 232 * MiB, WS_CC = 240 * MiB;
constexpr size_t WS_MISC = 248 * MiB;
constexpr size_t WS_STATE = WS_Y;
constexpr size_t WS_BT = WS_Y + 16 * MiB, WS_PREV = WS_Y + 24 * MiB;
constexpr size_t WS_G = 120 * MiB, WS_MG = 152 * MiB;
constexpr size_t WS_W2B = 232 * MiB;
constexpr size_t WS_WO = WS_W2B, WS_WF1 = WS_W2B + 2 * MiB, WS_WF2 = WS_W2B + 13 * MiB;
constexpr size_t WS_HP = 56 * MiB;
constexpr size_t WS_END = 256 * MiB;
static_assert(WS_IKB + (size_t)T * 64 * 2 <= WS_WIN && WS_WIN + (size_t)NWIN * 1024 * 2 <= WS_H && WS_U + (size_t)T * UB_P * 2 <= WS_MASK && WS_U + (size_t)T * UA_P * 2 <= WS_XT, "ws map 1");
static_assert(WS_WF2 + (size_t)1024 * FFH * 2 <= WS_END && WS_HP + (size_t)T * FFH * 2 <= WS_MG && WS_MG + (size_t)T * 1024 * 4 <= WS_W2B && WS_MISC + (size_t)T * 128 * 4 <= WS_END, "ws map 2");
constexpr int CW_BAR = 4096;
constexpr int CW_QKN = 8192;
constexpr int CW_WQ = 8448;
constexpr int RING_BYTES = 131072;
constexpr int XTRA_OFF = RING_BYTES;
constexpr int LDSCTL_OFF = RING_BYTES + 8192, MISC_OFF = LDSCTL_OFF + 320;
constexpr int LDS_BYTES = 147456;
static_assert(MISC_OFF + 128 <= LDS_BYTES, "LDS map");

__device__ __forceinline__ float wave_sum(float v) {
#pragma unroll
    for (int o = 1; o < 64; o <<= 1) v += __shfl_xor(v, o);
    return v;
}
__device__ __forceinline__ float bfl(unsigned w) { return __builtin_bit_cast(float, w << 16); }
__device__ __forceinline__ float bfh(unsigned w) { return __builtin_bit_cast(float, w & 0xffff0000u); }
__device__ __forceinline__ float silu_(float x) { return x / (1.0f + __expf(-x)); }
__device__ __forceinline__ float softplus_(float x) { return fmaxf(x, 0.f) + log1pf(expf(-fabsf(x))); }
__device__ __forceinline__ float logsigmoid_(float x) { return fminf(x, 0.f) - log1pf(expf(-fabsf(x))); }

struct MapWin { __device__ __forceinline__ int operator()(int r) const {
    if (r < 3072) return 3088 + r;
    if (r < 3328) return 6160 + (r - 3072);
    if (r < 3584) { const int m = r - 3328; if (m < 64) return 6416 + m; if (m < 68) return 6480 + (m - 64); if (m < 76) return 1536 + (m - 68); if (m < 84) return 3080 + (m - 76); return -1; }
    const int a = r - 3584; if (a < 1536) return a;
    return 1544 + (a - 1536); } };
struct MapId { int off; __device__ __forceinline__ int operator()(int r) const { return off + r; } };
struct MapFfn { __device__ __forceinline__ int operator()(int r) const { const int t = r >> 8, w = r & 255; return w < 128 ? 128 * t + w : FFH + 128 * t + (w - 128); } };
template <class Map> __device__ __forceinline__ void tr_items(const float* W, int N, int K, bf16* WT, int nrows, Map map, LAS float* scr, int gw, int NGW, int lane) {
    const int nrb = nrows / 32, nitems = nrb * (K / 64);
    for (int it = gw; it < nitems; it += NGW) {
        const int rb = it % nrb, kb = it / nrb, r0 = rb * 32, k0 = kb * 64;
        const int c = map(r0 + (lane & 31));
#pragma unroll 8
        for (int i = 0; i < 32; ++i) { const int kk = 2 * i + (lane >> 5); scr[kk * 33 + (lane & 31)] = (c >= 0) ? W[(size_t)(k0 + kk) * N + c] : 0.f; }
        LDS_WAIT(); asm volatile("" ::: "memory");
        const int cc = lane & 7;
#pragma unroll
        for (int j = 0; j < 4; ++j) { const int n = (lane >> 3) + 8 * j; const LAS float* s = scr + (8 * cc) * 33 + n;
            v4u o; o.x = pk2(s[0 * 33], s[1 * 33]); o.y = pk2(s[2 * 33], s[3 * 33]); o.z = pk2(s[4 * 33], s[5 * 33]); o.w = pk2(s[6 * 33], s[7 * 33]);
            *(GAS v4u*)(WT + (size_t)(r0 + n) * K + k0 + 8 * cc) = o; }
        LDS_WAIT(); asm volatile("" ::: "memory");
    }
}
__device__ __forceinline__ void norm_rows_to_bf16(const float* X, const float* g, bf16* Hout, int gw, int NGW, int lane) {
    for (int m = gw; m < T; m += NGW) {
        const f32x4* xr = (const f32x4*)(X + (size_t)m * DMODEL) + lane;
        f32x4 v[4]; float s = 0.f;
#pragma unroll
        for (int j = 0; j < 4; ++j) { v[j] = xr[64 * j]; s += (v[j].x * v[j].x + v[j].y * v[j].y) + (v[j].z * v[j].z + v[j].w * v[j].w); }
        const float rstd = 1.0f / sqrtf(wave_sum(s) * (1.0f / DMODEL) + EPS);
        unsigned long long* o8 = (unsigned long long*)(Hout + (size_t)m * DMODEL) + lane;
#pragma unroll
        for (int j = 0; j < 4; ++j) { const f32x4 gv = ((const f32x4*)g)[lane + 64 * j];
            o8[64 * j] = (unsigned long long)pk2(v[j].x * rstd * gv.x, v[j].y * rstd * gv.y) | ((unsigned long long)pk2(v[j].z * rstd * gv.z, v[j].w * rstd * gv.w) << 32); }
    }
}
__device__ __forceinline__ void norm_res_rows(const float* V, const float* g1, const float* xold, float* xout, const float* g2, bf16* Hout, int gw, int NGW, int lane) {
    for (int m = gw; m < T; m += NGW) {
        const f32x4* vr = (const f32x4*)(V + (size_t)m * DMODEL) + lane; const f32x4* xr = (const f32x4*)(xold + (size_t)m * DMODEL) + lane;
        f32x4 v[4], x[4]; float s = 0.f;
#pragma unroll
        for (int j = 0; j < 4; ++j) { v[j] = vr[64 * j]; x[j] = xr[64 * j]; s += (v[j].x * v[j].x + v[j].y * v[j].y) + (v[j].z * v[j].z + v[j].w * v[j].w); }
        const float rstd = 1.0f / sqrtf(wave_sum(s) * (1.0f / DMODEL) + EPS);
        float s2 = 0.f; f32x4* xo = (f32x4*)(xout + (size_t)m * DMODEL) + lane;
#pragma unroll
        for (int j = 0; j < 4; ++j) { const f32x4 gv = ((const f32x4*)g1)[lane + 64 * j]; x[j] = x[j] + v[j] * rstd * gv; xo[64 * j] = x[j];
            s2 += (x[j].x * x[j].x + x[j].y * x[j].y) + (x[j].z * x[j].z + x[j].w * x[j].w); }
        if (g2) {
            const float rstd2 = 1.0f / sqrtf(wave_sum(s2) * (1.0f / DMODEL) + EPS);
            unsigned long long* o8 = (unsigned long long*)(Hout + (size_t)m * DMODEL) + lane;
#pragma unroll
            for (int j = 0; j < 4; ++j) { const f32x4 gv = ((const f32x4*)g2)[lane + 64 * j];
                o8[64 * j] = (unsigned long long)pk2(x[j].x * rstd2 * gv.x, x[j].y * rstd2 * gv.y) | ((unsigned long long)pk2(x[j].z * rstd2 * gv.z, x[j].w * rstd2 * gv.w) << 32); }
        }
    }
}
__device__ __forceinline__ void rope_tables(float* RC, float* RS, int gtid, int NGT) {
    for (int i = gtid; i < SEQ * 32; i += NGT) { const int pos = i >> 5, k = i & 31;
        const float inv = powf(10000.0f, -(float)(2 * k) / 64.0f); const float ang = (float)pos * inv;
        RC[i] = cosf(ang); RS[i] = sinf(ang); }
}
__device__ __forceinline__ void rope_pair4(unsigned long long& a, unsigned long long& b, const f32x4 c, const f32x4 s, f32x4& o1, f32x4& o2) {
    const unsigned a0 = (unsigned)a, a1 = (unsigned)(a >> 32), b0 = (unsigned)b, b1 = (unsigned)(b >> 32);
    const f32x4 x1 = {bfl(a0), bfh(a0), bfl(a1), bfh(a1)}, x2 = {bfl(b0), bfh(b0), bfl(b1), bfh(b1)};
    o1 = x1 * c - x2 * s; o2 = x2 * c + x1 * s;
    a = (unsigned long long)pk2(o1.x, o1.y) | ((unsigned long long)pk2(o1.z, o1.w) << 32); b = (unsigned long long)pk2(o2.x, o2.y) | ((unsigned long long)pk2(o2.z, o2.w) << 32);
}
__device__ __forceinline__ void rope_phase(bf16* UB, const float* MISCF, bf16* IKB, float* KPART, const float* RC, const float* RS, LAS unsigned char* lds, int G, int bx, int tid, int lane, int wave) {
    LAS float* red = (LAS float*)lds;
    for (int unit = bx; unit < T / 64; unit += G) {
        f32x4 ks1 = {0.f, 0.f, 0.f, 0.f}, ks2 = {0.f, 0.f, 0.f, 0.f};
        const int hd = lane >> 3, d = (lane & 7) * 4;
        for (int i = 0; i < 8; ++i) {
            const int m = unit * 64 + wave * 8 + i, pos = m & (SEQ - 1);
            const f32x4 c = *(const f32x4*)(RC + pos * 32 + d), s = *(const f32x4*)(RS + pos * 32 + d);
            bf16* row = UB + (size_t)m * UB_P;
            const int segs[4] = {0, 512, 1536, 2048};
#pragma unroll
            for (int sg = 0; sg < 4; ++sg) {
                unsigned long long* p1 = (unsigned long long*)(row + segs[sg] + hd * 64 + d); unsigned long long* p2 = (unsigned long long*)(row + segs[sg] + hd * 64 + 32 + d);
                unsigned long long a = *p1, b = *p2; f32x4 o1, o2; rope_pair4(a, b, c, s, o1, o2); *p1 = a; *p2 = b;
                if (sg == 1) { ks1 = ks1 + o1; ks2 = ks2 + o2; }
            }
            if (lane < 32) {
                unsigned long long* p1 = (unsigned long long*)(row + 3072 + hd * 64 + d); unsigned long long* p2 = (unsigned long long*)(row + 3072 + hd * 64 + 32 + d);
                unsigned long long a = *p1, b = *p2; f32x4 o1, o2; rope_pair4(a, b, c, s, o1, o2); *p1 = a; *p2 = b;
            }
            if (lane < 8) {
                const f32x4 x1 = *(const f32x4*)(MISCF + (size_t)m * 128 + d), x2 = *(const f32x4*)(MISCF + (size_t)m * 128 + 32 + d);
                const f32x4 o1 = x1 * c - x2 * s, o2 = x2 * c + x1 * s;
                *(unsigned long long*)(IKB + (size_t)m * 64 + d) = (unsigned long long)pk2(o1.x, o1.y) | ((unsigned long long)pk2(o1.z, o1.w) << 32);
                *(unsigned long long*)(IKB + (size_t)m * 64 + 32 + d) = (unsigned long long)pk2(o2.x, o2.y) | ((unsigned long long)pk2(o2.z, o2.w) << 32);
            }
        }
        *(LAS f32x4*)(red + wave * 512 + hd * 64 + d) = ks1; *(LAS f32x4*)(red + wave * 512 + hd * 64 + 32 + d) = ks2;
        __syncthreads();
        { float a = 0.f;
#pragma unroll
          for (int w = 0; w < 8; ++w) a += red[w * 512 + tid];
          KPART[(size_t)unit * 512 + tid] = a; }
        __syncthreads();
    }
}
__device__ __forceinline__ void moba_gate_phase(const bf16* UB, const float* KPART, unsigned* SELM, LAS unsigned char* lds, int G, int bx, int tid, int lane, int wave) {
    LAS float* km = (LAS float*)lds;
    for (int unit = bx; unit < T / 64; unit += G) {
        const int b = (unit * 64) / SEQ;
        __syncthreads();
#pragma unroll 4
        for (int i = tid; i < 8 * 32 * 64; i += NTHR) { const int dd = i & 63, n = (i >> 6) & 31, hh = i >> 11;
            const float* kp = KPART + (size_t)(b * 128 + 4 * n) * 512 + hh * 64 + dd;
            km[(hh * 32 + n) * 68 + dd] = ((kp[0] + kp[512]) + (kp[1024] + kp[1536])) * (1.0f / 256.0f); }
        __syncthreads();
        const int hd = lane >> 3, j = lane & 7;
#pragma unroll 1
        for (int i = 0; i < 8; ++i) {
            const int m = unit * 64 + wave * 8 + i, pos = m & (SEQ - 1), cur = pos >> 8;
            const v4u* qp = (const v4u*)(UB + (size_t)m * UB_P + hd * 64);
            v4u qv[8];
#pragma unroll
            for (int k = 0; k < 8; ++k) qv[k] = qp[k];
            float val[4];
#pragma unroll
            for (int ii = 0; ii < 4; ++ii) { const int n = j + 8 * ii; const LAS f32x4* kr = (const LAS f32x4*)(km + (hd * 32 + n) * 68); float acc = 0.f;
#pragma unroll
                for (int k = 0; k < 8; ++k) { const f32x4 k0 = kr[2 * k], k1 = kr[2 * k + 1]; const v4u q = qv[k];
                    acc += bfl(q.x) * k0.x + bfh(q.x) * k0.y + bfl(q.y) * k0.z + bfh(q.y) * k0.w + bfl(q.z) * k1.x + bfh(q.z) * k1.y + bfl(q.w) * k1.z + bfh(q.w) * k1.w; }
                val[ii] = (n < cur) ? acc : -INFINITY; asm volatile("" ::: "memory"); }
            unsigned selmask = 0u;
#pragma unroll
            for (int round = 0; round < 3; ++round) {
                float bv = val[0]; int bn = j;
#pragma unroll
                for (int ii = 1; ii < 4; ++ii) { if (val[ii] > bv) { bv = val[ii]; bn = j + 8 * ii; } }
#pragma unroll
                for (int o = 1; o < 8; o <<= 1) { const float ov = __shfl_xor(bv, o); const int on = __shfl_xor(bn, o); if (ov > bv || (ov == bv && on < bn)) { bv = ov; bn = on; } }
                if (bv > -INFINITY) selmask |= 1u << bn;
#pragma unroll
                for (int ii = 0; ii < 4; ++ii) if (bn == j + 8 * ii) val[ii] = -INFINITY;
            }
            if (j == 0) SELM[(size_t)m * 8 + hd] = selmask;
        }
    }
}
constexpr int DSA_CAP = 1792;
typedef __attribute__((ext_vector_type(8))) short dsa_bf16x8;
typedef __attribute__((ext_vector_type(4))) float dsa_f32x4;
struct DsaCtx { dsa_bf16x8 af[4][2]; float wq[4][4]; int b, p0, g4; };
struct DsaB { dsa_bf16x8 b0, b1; };
__device__ __forceinline__ DsaB dsa_loadb(const DsaCtx& c, const bf16* IKB, int key0, int lane) {
    const bf16* kp = IKB + ((size_t)c.b * SEQ + key0 + (lane & 15)) * 64 + 8 * (lane >> 4);
    DsaB r; r.b0 = *(const dsa_bf16x8*)(kp); r.b1 = *(const dsa_bf16x8*)(kp + 32); return r;
}
__device__ __forceinline__ DsaB dsa_loadbc(const DsaCtx& c, const bf16* IKB, int key0, int lane) {
    const bf16* kp = IKB + ((size_t)c.b * SEQ + min(key0 + (lane & 15), SEQ - 1)) * 64 + 8 * (lane >> 4);
    DsaB r; r.b0 = *(const dsa_bf16x8*)(kp); r.b1 = *(const dsa_bf16x8*)(kp + 32); return r;
}
struct DsaB4 { DsaB t[4]; };
__device__ __forceinline__ DsaB4 dsa_loadb4(const DsaCtx& c, const bf16* IKB, int key0g, int lane) {
    DsaB4 r;
#pragma unroll
    for (int j = 0; j < 4; ++j) { const int key = min(key0g + 16 * j + (lane & 15), SEQ - 1);
        const bf16* kp = IKB + ((size_t)c.b * SEQ + key) * 64 + 8 * (lane >> 4);
        r.t[j].b0 = *(const dsa_bf16x8*)(kp); r.t[j].b1 = *(const dsa_bf16x8*)(kp + 32); }
    return r;
}
template <bool CHECK> __device__ __forceinline__ void dsa_tile(const DsaCtx& c, const DsaB& bb, int key0, int lane, unsigned (&mono)[4], unsigned& vbits) {
    dsa_f32x4 a[4];
#pragma unroll
    for (int hh = 0; hh < 4; ++hh) { dsa_f32x4 z = {0.f, 0.f, 0.f, 0.f};
        z = __builtin_amdgcn_mfma_f32_16x16x32_bf16(c.af[hh][0], bb.b0, z, 0, 0, 0);
        a[hh] = __builtin_amdgcn_mfma_f32_16x16x32_bf16(c.af[hh][1], bb.b1, z, 0, 0, 0); }
    vbits = 0xfu;
    if constexpr (CHECK) { const int d = key0 + (lane & 15) - c.p0 - c.g4; vbits = (d <= 0 ? 1u : 0u) | (d <= 1 ? 2u : 0u) | (d <= 2 ? 4u : 0u) | (d <= 3 ? 8u : 0u); }
#pragma unroll
    for (int r = 0; r < 4; ++r) {
        float sc = c.wq[r][0] * __builtin_amdgcn_fmed3f(a[0][r], 0.f, INFINITY);
        sc = fmaf(c.wq[r][1], __builtin_amdgcn_fmed3f(a[1][r], 0.f, INFINITY), sc);
        sc = fmaf(c.wq[r][2], __builtin_amdgcn_fmed3f(a[2][r], 0.f, INFINITY), sc);
        sc = fmaf(c.wq[r][3], __builtin_amdgcn_fmed3f(a[3][r], 0.f, INFINITY), sc);
        const unsigned u = __builtin_bit_cast(unsigned, sc);
        mono[r] = u ^ ((unsigned)((int)u >> 31) | 0x80000000u);
    }
}
__device__ __forceinline__ void dsa_scores(const DsaCtx& c, const DsaB& bb, int key0, int lane, unsigned (&k22)[4], bool (&valid)[4]) {
    unsigned mono[4], vb; dsa_tile<true>(c, bb, key0, lane, mono, vb);
#pragma unroll
    for (int r = 0; r < 4; ++r) { k22[r] = mono[r] >> 10; valid[r] = (vb >> r) & 1u; }
}
__device__ __forceinline__ void dsa_scan(LAS unsigned* hist, int q, unsigned need, int lane, LAS unsigned* o_bin, LAS unsigned* o_above, LAS unsigned* o_cnt) {
    const LAS unsigned* hrow = hist + q * 2048; const int rot = 67 * q;
    unsigned cnt = 0;
#pragma unroll 8
    for (int i = 0; i < 32; ++i) cnt += hrow[(32 * lane + i + rot) & 2047];
    unsigned sfx = cnt;
#pragma unroll
    for (int o = 1; o < 64; o <<= 1) { const unsigned t = __shfl_down(sfx, o); if (lane + o < 64) sfx += t; }
    const unsigned above = sfx - cnt;
    if (lane == 0) { *o_bin = 0u; *o_above = 0u; *o_cnt = 0u; }
    if (above < need && sfx >= need) {
        unsigned cum = above;
        for (int i = 31; i >= 0; --i) { const unsigned h = hrow[(32 * lane + i + rot) & 2047];
            if (cum + h >= need) { *o_bin = (unsigned)(32 * lane + i); *o_above = cum; *o_cnt = h; break; }
            cum += h; }
    }
}
__device__ __forceinline__ void dsa_topk_phase(const bf16* UB, const bf16* IKB, const float* MISCF, unsigned long long* MASKT, LAS unsigned char* lds, int G, int bx, int vcu, int tid_in, int lane_in, int wave) {
    LAS unsigned* hist = (LAS unsigned*)lds;
    LAS unsigned* par = (LAS unsigned*)(lds + XTRA_OFF);
    const int nun = T / 16;
    for (int it = 0;; ++it) {
        int unit;
        if (G == 256) { if (it >= 4) break; unit = (it == 0) ? vcu : (it == 1) ? 511 - vcu : (it == 2) ? 512 + vcu : 1023 - vcu; }
        else { unit = bx + it * G; if (unit >= nun) break; }
        int tid = tid_in; asm volatile("" : "+v"(tid)); const int lane = tid & 63;
        DsaCtx c; const int row0 = unit * 16; c.b = row0 >> 13; c.p0 = row0 & (SEQ - 1); c.g4 = 4 * (lane >> 4);
        { const bf16* qp = UB + (size_t)(row0 + (lane & 15)) * UB_P + 3072 + 8 * (lane >> 4);
#pragma unroll
          for (int hh = 0; hh < 4; ++hh) { c.af[hh][0] = *(const dsa_bf16x8*)(qp + hh * 64); c.af[hh][1] = *(const dsa_bf16x8*)(qp + hh * 64 + 32); }
#pragma unroll
          for (int r = 0; r < 4; ++r) { const dsa_f32x4 w4 = *(const dsa_f32x4*)(MISCF + (size_t)(row0 + c.g4 + r) * 128 + 64);
              c.wq[r][0] = w4[0] * 0.0625f; c.wq[r][1] = w4[1] * 0.0625f; c.wq[r][2] = w4[2] * 0.0625f; c.wq[r][3] = w4[3] * 0.0625f; } }
        const int nmine = (c.p0 + 15 - 16 * wave >= 0) ? ((c.p0 + 15 - 16 * wave) >> 7) + 1 : 0;
        const int ngrp = (c.p0 + 15 - 64 * wave >= 0) ? ((c.p0 + 15 - 64 * wave) >> 9) + 1 : 0;
        int rotq[4], baseq[4];
#pragma unroll
        for (int r = 0; r < 4; ++r) { rotq[r] = 67 * (c.g4 + r); baseq[r] = (c.g4 + r) * 2048; }
        __syncthreads();
        for (int i = tid; i < 8192; i += NTHR) ((LAS v4u*)hist)[i] = (v4u){0u, 0u, 0u, 0u};
        if (tid == 0) par[96] = 0u;
        __syncthreads();
        { DsaB4 cur = dsa_loadb4(c, IKB, 64 * wave, lane);
          for (int s = 0; s < ngrp; ++s) { const int key0g = 512 * s + 64 * wave;
#pragma unroll
            for (int j = 0; j < 4; ++j) { const int key0 = key0g + 16 * j; const DsaB bt = cur.t[j];
              cur.t[j] = dsa_loadbc(c, IKB, (s + 1 < ngrp) ? key0 + 512 : key0, lane);
              if (key0 <= c.p0 + 15) { unsigned mono[4], vb; dsa_tile<true>(c, bt, key0, lane, mono, vb);
#pragma unroll
                for (int r = 0; r < 4; ++r) __hip_atomic_fetch_add(hist + baseq[r] + (((mono[r] >> 21) + rotq[r]) & 2047), (vb >> r) & 1u, __ATOMIC_RELAXED, __HIP_MEMORY_SCOPE_WORKGROUP); } } } }
        __syncthreads();
#pragma unroll
        for (int k = 0; k < 2; ++k) { const int q = 2 * wave + k; dsa_scan(hist, q, 256u, lane, par + q, par + 16 + q, par + 80 + q);
            if (lane == 0) { const bool all = (c.p0 + q) < 256;
                if (all) { par[q] = 0xffffffffu; par[16 + q] = 0u; par[80 + q] = 0u; } else if (par[80 + q] > (unsigned)DSA_CAP) par[96] = 1u; } }
        __syncthreads();
        const bool ovf = par[96] != 0u;
        LAS unsigned char* gtbase = lds;
        if (!ovf) {
            gtbase = lds + DSA_CAP * 64;
            LAS unsigned* cand = (LAS unsigned*)lds; LAS unsigned* cnt = par + 100;
            for (int i = tid; i < 1024; i += NTHR) ((LAS v4u*)gtbase)[i] = (v4u){0u, 0u, 0u, 0u};
            if (tid < 16) cnt[tid] = 0u;
            __syncthreads();
            { LAS unsigned short* gt16 = (LAS unsigned short*)gtbase;
              DsaB4 cur = dsa_loadb4(c, IKB, 64 * wave, lane); int pb1[4];
#pragma unroll
              for (int r = 0; r < 4; ++r) pb1[r] = (int)par[c.g4 + r];
              for (int s = 0; s < ngrp; ++s) { const int key0g = 512 * s + 64 * wave;
#pragma unroll
               for (int j = 0; j < 4; ++j) { const int key0 = key0g + 16 * j; const DsaB bt = cur.t[j];
                cur.t[j] = dsa_loadbc(c, IKB, (s + 1 < ngrp) ? key0 + 512 : key0, lane);
                if (key0 <= c.p0 + 15) { unsigned mono[4], vb; dsa_tile<true>(c, bt, key0, lane, mono, vb);
#pragma unroll
                for (int r = 0; r < 4; ++r) { const int bin = (int)(mono[r] >> 21); const bool v = (vb >> r) & 1u;
                    const unsigned long long bg = __ballot(v && bin > pb1[r]);
                    if (lane < 4) gt16[(4 * lane + r) * 512 + (key0 >> 4)] = (unsigned short)(bg >> (16 * lane));
                    if (v && bin == pb1[r]) { const int q = c.g4 + r; const unsigned pos = __hip_atomic_fetch_add(cnt + q, 1u, __ATOMIC_RELAXED, __HIP_MEMORY_SCOPE_WORKGROUP);
                        if (pos < (unsigned)DSA_CAP) cand[q * DSA_CAP + pos] = (((mono[r] >> 2) & 0x7ffffu) << 13) | (unsigned)(8191 - (key0 + (lane & 15))); } } } }
               } }
            __syncthreads();
            { LAS unsigned* gt32 = (LAS unsigned*)gtbase;
#pragma unroll 1
              for (int k = 0; k < 2; ++k) { const int q = 2 * wave + k; const unsigned n = min(cnt[q], (unsigned)DSA_CAP), need = 256u - par[16 + q];
                if ((int)par[q] != -1 && n > 0u) {
                    const LAS unsigned* cq = cand + q * DSA_CAP; unsigned thr = 0u;
                    for (int bit = 31; bit >= 0; --bit) { const unsigned trial = thr | (1u << bit); unsigned cge = 0u;
                        for (unsigned i = lane; i < n; i += 64) cge += (cq[i] >= trial) ? 1u : 0u;
#pragma unroll
                        for (int o = 1; o < 64; o <<= 1) cge += __shfl_xor(cge, o);
                        if (cge >= need) thr = trial; }
                    for (unsigned i = lane; i < n; i += 64) { const unsigned e = cq[i];
                        if (e >= thr) { const unsigned key = 8191u - (e & 8191u); __hip_atomic_fetch_or(gt32 + q * 256 + (key >> 5), 1u << (key & 31u), __ATOMIC_RELAXED, __HIP_MEMORY_SCOPE_WORKGROUP); } } } } }
            __syncthreads();
        } else {
            for (int i = tid; i < 8192; i += NTHR) ((LAS v4u*)hist)[i] = (v4u){0u, 0u, 0u, 0u};
            __syncthreads();
            { DsaB cur = dsa_loadb(c, IKB, 16 * wave, lane); unsigned pb1[4];
#pragma unroll
              for (int r = 0; r < 4; ++r) pb1[r] = par[c.g4 + r];
              for (int s = 0; s < nmine; ++s) { const int key0 = 128 * s + 16 * wave; const DsaB nxt = dsa_loadb(c, IKB, (s + 1 < nmine) ? key0 + 128 : key0, lane);
                unsigned k22[4]; bool valid[4]; dsa_scores(c, cur, key0, lane, k22, valid); cur = nxt;
#pragma unroll
                for (int r = 0; r < 4; ++r) { const int q = c.g4 + r; if (valid[r] && (k22[r] >> 11) == pb1[r]) __hip_atomic_fetch_add(hist + q * 2048 + (((k22[r] & 2047u) + 67 * q) & 2047), 1u, __ATOMIC_RELAXED, __HIP_MEMORY_SCOPE_WORKGROUP); } } }
            __syncthreads();
#pragma unroll
            for (int k = 0; k < 2; ++k) { const int q = 2 * wave + k; const unsigned c1 = par[16 + q];
                dsa_scan(hist, q, 256u - c1, lane, par + 32 + q, par + 48 + q, par + 64 + q);
                if (lane == 0) { const unsigned b2 = par[32 + q], c2 = par[48 + q]; const bool all = (c.p0 + q) < 256;
                    par[32 + q] = all ? 0xffffffffu : ((par[q] << 11) | b2); par[48 + q] = all ? 0u : (256u - c1 - c2); if (all) par[64 + q] = 0u; } }
            __syncthreads();
            for (int i = tid; i < 2048; i += NTHR) ((LAS v4u*)hist)[i] = (v4u){0u, 0u, 0u, 0u};
            __syncthreads();
            { LAS unsigned short* gt16 = (LAS unsigned short*)lds; LAS unsigned short* eq16 = (LAS unsigned short*)(lds + 16384);
              DsaB cur = dsa_loadb(c, IKB, 16 * wave, lane); int pt22[4];
#pragma unroll
              for (int r = 0; r < 4; ++r) pt22[r] = (int)par[32 + c.g4 + r];
              for (int s = 0; s < nmine; ++s) { const int key0 = 128 * s + 16 * wave; const DsaB nxt = dsa_loadb(c, IKB, (s + 1 < nmine) ? key0 + 128 : key0, lane);
                unsigned k22[4]; bool valid[4]; dsa_scores(c, cur, key0, lane, k22, valid); cur = nxt;
#pragma unroll
                for (int r = 0; r < 4; ++r) { const int t22 = pt22[r];
                    const bool gt = valid[r] && ((int)k22[r] > t22), eq = valid[r] && ((int)k22[r] == t22);
                    const unsigned long long bg = __ballot(gt), be = __ballot(eq);
                    if (lane < 4) { gt16[(4 * lane + r) * 512 + (key0 >> 4)] = (unsigned short)(bg >> (16 * lane)); eq16[(4 * lane + r) * 512 + (key0 >> 4)] = (unsigned short)(be >> (16 * lane)); } } } }
            __syncthreads();
            { LAS unsigned* gt32 = (LAS unsigned*)lds; LAS unsigned* eq32 = (LAS unsigned*)(lds + 16384);
#pragma unroll
              for (int k = 0; k < 2; ++k) { const int q = 2 * wave + k; const unsigned quota = par[48 + q], eqcnt = par[64 + q]; unsigned base = 0u;
                for (int rnd = 0; rnd < 4; ++rnd) { const int wi = q * 256 + rnd * 64 + lane; const unsigned e = eq32[wi]; unsigned kw = e;
                    if (eqcnt > quota) { const unsigned cn = __popc(e); unsigned inc = cn;
#pragma unroll
                        for (int o = 1; o < 64; o <<= 1) { const unsigned t = __shfl_up(inc, o); if (lane >= o) inc += t; }
                        const unsigned exc = base + inc - cn; base += __shfl(inc, 63);
                        if (exc + cn <= quota) kw = e; else if (exc >= quota) kw = 0u; else { unsigned rem = quota - exc, w = e; kw = 0u; while (rem > 0u) { const unsigned low = w & (0u - w); kw |= low; w ^= low; --rem; } } }
                    gt32[wi] |= kw; } } }
            __syncthreads();
        }
        { const LAS unsigned long long* gt64 = (const LAS unsigned long long*)gtbase;
#pragma unroll
          for (int k = 0; k < 4; ++k) { const int idx = tid + NTHR * k, qq = idx & 15, t = idx >> 4;
              MASKT[((size_t)(c.b * 128 + t)) * SEQ + c.p0 + qq] = gt64[qq * 128 + t]; } }
    }
    __syncthreads();
}
typedef __attribute__((ext_vector_type(8))) short s_bf16x8;
typedef __attribute__((ext_vector_type(16))) float s_f32x16;
__device__ __forceinline__ int crow_(int r, int hi) { return (r & 3) + 8 * (r >> 2) + 4 * hi; }
__device__ __forceinline__ void ssd_prep_phase(const bf16* UA, const float* MISCF, const float* conv_w, const float* conv_b, const float* dt_bias, const float* a_log, const float* fbias,
                                               float* CF2, float* ACS, float* DTA, bf16* XT, bf16* BT, bf16* BC, bf16* CC, unsigned* QKN, LAS unsigned char* lds, int G, int bx, int tid, int lane, int wave) {
    const int NU = 16 + 64 + 256;
    for (int unit = bx; unit < NU; unit += G) {
        __syncthreads();
        if (unit < 16) {
            const int b = unit >> 3, h = unit & 7; const float fb = fbias[h];
            float v[16]; float run = 0.f;
#pragma unroll
            for (int i = 0; i < 16; ++i) { const int t = 16 * tid + i; run += logsigmoid_(MISCF[((size_t)b * SEQ + t) * 128 + 76 + h] + fb) * LOG2E; v[i] = run; }
            float inc = run;
#pragma unroll
            for (int o = 1; o < 64; o <<= 1) { const float t_ = __shfl_up(inc, o); if (lane >= o) inc += t_; }
            LAS float* wt = (LAS float*)lds;
            if (lane == 63) wt[wave] = inc;
            __syncthreads();
            float off = inc - run;
            for (int w = 0; w < wave; ++w) off += wt[w];
#pragma unroll
            for (int i = 0; i < 16; ++i) CF2[((size_t)b * 8 + h) * SEQ + 16 * tid + i] = off + v[i];
        } else if (unit < 80) {
            const int u = unit - 16, b = u >> 5, cch = u & 31, h = wave;
            const float bias = dt_bias[h], a = -expf(a_log[h]);
            float dtv[4], cs[4]; float run = 0.f;
#pragma unroll
            for (int i = 0; i < 4; ++i) { const int t = cch * 256 + 4 * lane + i; dtv[i] = softplus_(MISCF[((size_t)b * SEQ + t) * 128 + 68 + h] + bias); run += dtv[i] * a; cs[i] = run; }
            float inc = run;
#pragma unroll
            for (int o = 1; o < 64; o <<= 1) { const float t_ = __shfl_up(inc, o); if (lane >= o) inc += t_; }
            const float off = inc - run;
#pragma unroll
            for (int i = 0; i < 4; ++i) { const size_t o_ = ((size_t)b * 8 + h) * SEQ + cch * 256 + 4 * lane + i; ACS[o_] = off + cs[i]; DTA[o_] = dtv[i]; }
        } else {
            const int u = unit - 80, b = u >> 7, t0 = (u & 127) * 64; const int ch0 = 2 * tid;
            {
                const int tt = tid >> 3, hd = tid & 7; const bf16* qrow = UA + ((size_t)b * SEQ + t0 + tt) * UA_P + 1536 + hd * 64;
                float q2 = 0.f, k2 = 0.f;
#pragma unroll
                for (int k8 = 0; k8 < 8; ++k8) { const v4u a4 = *(const v4u*)(qrow + 8 * k8), b4 = *(const v4u*)(qrow + 512 + 8 * k8);
                    q2 += bfl(a4.x) * bfl(a4.x) + bfh(a4.x) * bfh(a4.x) + bfl(a4.y) * bfl(a4.y) + bfh(a4.y) * bfh(a4.y) + bfl(a4.z) * bfl(a4.z) + bfh(a4.z) * bfh(a4.z) + bfl(a4.w) * bfl(a4.w) + bfh(a4.w) * bfh(a4.w);
                    k2 += bfl(b4.x) * bfl(b4.x) + bfh(b4.x) * bfh(b4.x) + bfl(b4.y) * bfl(b4.y) + bfh(b4.y) * bfh(b4.y) + bfl(b4.z) * bfl(b4.z) + bfh(b4.z) * bfh(b4.z) + bfl(b4.w) * bfl(b4.w) + bfh(b4.w) * bfh(b4.w); }
#pragma unroll
                for (int o = 8; o < 64; o <<= 1) { q2 = fmaxf(q2, __shfl_xor(q2, o)); k2 = fmaxf(k2, __shfl_xor(k2, o)); }
                if (lane < 8) { __hip_atomic_fetch_max(QKN + (b * 8 + hd) * 2, __builtin_bit_cast(unsigned, q2), __ATOMIC_RELAXED, __HIP_MEMORY_SCOPE_AGENT);
                                __hip_atomic_fetch_max(QKN + (b * 8 + hd) * 2 + 1, __builtin_bit_cast(unsigned, k2), __ATOMIC_RELAXED, __HIP_MEMORY_SCOPE_AGENT); }
            }
            LAS unsigned short* tl = (LAS unsigned short*)lds;
            float cw[4][2], cb[2];
#pragma unroll
            for (int w = 0; w < 4; ++w) { cw[w][0] = conv_w[w * 1024 + ch0]; cw[w][1] = conv_w[w * 1024 + ch0 + 1]; }
            cb[0] = conv_b[ch0]; cb[1] = conv_b[ch0 + 1];
            const bf16* src = UA + ((size_t)b * SEQ) * UA_P + 512 + ch0;
            float r0[2] = {0.f, 0.f}, r1[2] = {0.f, 0.f}, r2[2] = {0.f, 0.f};
            if (t0 > 0) { const unsigned w0 = *(const unsigned*)(src + (size_t)(t0 - 3) * UA_P), w1 = *(const unsigned*)(src + (size_t)(t0 - 2) * UA_P), w2 = *(const unsigned*)(src + (size_t)(t0 - 1) * UA_P);
                r0[0] = bfl(w0); r0[1] = bfh(w0); r1[0] = bfl(w1); r1[1] = bfh(w1); r2[0] = bfl(w2); r2[1] = bfh(w2); }
#pragma unroll 8
            for (int tt = 0; tt < 64; ++tt) {
                const unsigned wv = *(const unsigned*)(src + (size_t)(t0 + tt) * UA_P); const float c0 = bfl(wv), c1 = bfh(wv);
                const float y0 = cb[0] + cw[0][0] * r0[0] + cw[1][0] * r1[0] + cw[2][0] * r2[0] + cw[3][0] * c0;
                const float y1 = cb[1] + cw[0][1] * r0[1] + cw[1][1] * r1[1] + cw[2][1] * r2[1] + cw[3][1] * c1;
                r0[0] = r1[0]; r0[1] = r1[1]; r1[0] = r2[0]; r1[1] = r2[1]; r2[0] = c0; r2[1] = c1;
                const unsigned o0 = f2bf(silu_(y0)), o1 = f2bf(silu_(y1));
                if (ch0 < 768) { tl[ch0 * 68 + tt] = (unsigned short)o0; tl[(ch0 + 1) * 68 + tt] = (unsigned short)o1; }
                if (ch0 >= 512) { const size_t row = (size_t)b * SEQ + t0 + tt;
                    if (ch0 < 768) *(unsigned*)(BC + row * 256 + (ch0 - 512)) = o0 | (o1 << 16); else *(unsigned*)(CC + row * 256 + (ch0 - 768)) = o0 | (o1 << 16); }
            }
            __syncthreads();
#pragma unroll
            for (int k = 0; k < 12; ++k) { const int idx = tid + NTHR * k, rowc = idx >> 3, chunk = idx & 7;
                const LAS unsigned long long* sp = (const LAS unsigned long long*)(tl + rowc * 68 + chunk * 8);
                const unsigned long long lo = sp[0], hi = sp[1];
                bf16* dst = (rowc < 512) ? XT + (((size_t)b * 8 + (rowc >> 6)) * 64 + (rowc & 63)) * SEQ + t0 + chunk * 8
                                         : BT + (((size_t)b * 2 + ((rowc - 512) >> 7)) * 128 + ((rowc - 512) & 127)) * SEQ + t0 + chunk * 8;
                v4u o; o.x = (unsigned)lo; o.y = (unsigned)(lo >> 32); o.z = (unsigned)hi; o.w = (unsigned)(hi >> 32); *(v4u*)dst = o; }
        }
    }
    __syncthreads();
}
__device__ __forceinline__ void ssd_state_phase(const bf16* XT, const bf16* BT, const float* ACS, const float* DTA, float* STATE, LAS unsigned char* lds, int G, int bx, int tid, int lane, int wave) {
    LAS float* wl = (LAS float*)lds;
    const int r32 = lane & 31, hi = lane >> 5, d0 = wave & 1, nb = wave >> 1;
    for (int unit = bx; unit < NB * 32 * 8; unit += G) {
        const int h = unit & 7, cch = (unit >> 3) & 31, b = unit >> 8, g = h >> 2;
        __syncthreads();
        if (tid < 256) { const size_t o_ = ((size_t)b * 8 + h) * SEQ + cch * 256; wl[tid] = DTA[o_ + tid] * expf(ACS[o_ + 255] - ACS[o_ + tid]); }
        __syncthreads();
        const bf16* xp = XT + (((size_t)b * 8 + h) * 64 + 32 * d0 + r32) * SEQ + cch * 256 + 8 * hi;
        const bf16* bp = BT + (((size_t)b * 2 + g) * 128 + 32 * nb + r32) * SEQ + cch * 256 + 8 * hi;
        s_f32x16 acc = {};
#pragma unroll 4
        for (int k = 0; k < 16; ++k) {
            const v4u xa = *(const v4u*)(xp + 16 * k); const s_bf16x8 bb = *(const s_bf16x8*)(bp + 16 * k);
            const LAS f32x4* w4 = (const LAS f32x4*)(wl + 16 * k + 8 * hi); const f32x4 wa = w4[0], wb = w4[1];
            v4u xs; xs.x = pk2(bfl(xa.x) * wa.x, bfh(xa.x) * wa.y); xs.y = pk2(bfl(xa.y) * wa.z, bfh(xa.y) * wa.w); xs.z = pk2(bfl(xa.z) * wb.x, bfh(xa.z) * wb.y); xs.w = pk2(bfl(xa.w) * wb.z, bfh(xa.w) * wb.w);
            acc = __builtin_amdgcn_mfma_f32_32x32x16_bf16(__builtin_bit_cast(s_bf16x8, xs), bb, acc, 0, 0, 0);
        }
        float* sp = STATE + ((((size_t)b * 32 + cch) * 8 + h) * 64 + 32 * d0) * 128 + 32 * nb + r32;
#pragma unroll
        for (int r = 0; r < 16; ++r) sp[(size_t)crow_(r, hi) * 128] = acc[r];
    }
    __syncthreads();
}
__device__ __forceinline__ void ssd_scan_phase(const float* STATE, const float* ACS, bf16* PREV, int G, int bx, int tid) {
    for (int idx = bx * NTHR + tid; idx < NB * 8 * 8192; idx += G * NTHR) {
        const int b = idx >> 16, h = (idx >> 13) & 7, pn = idx & 8191; float run = 0.f;
#pragma unroll 4
        for (int cch = 0; cch < 32; ++cch) { const size_t o_ = (((size_t)b * 32 + cch) * 8 + h) * 8192 + pn;
            const float s = STATE[o_]; PREV[o_] = (bf16)f2bf(run);
            run = run * expf(ACS[((size_t)b * 8 + h) * SEQ + cch * 256 + 255]) + s; }
    }
}
__device__ __forceinline__ void ssd_out_phase(const bf16* UA, const bf16* XT, const bf16* BC, const bf16* CC, const bf16* PREV, const float* ACS, const float* DTA, const float* d_skip, bf16* Y0,
                                              int G, int bx, int lane, int wave) {
    const int r32 = lane & 31, hi = lane >> 5;
    for (int unit = bx; unit < NB * 32 * 8; unit += G) {
        const int h = unit & 7, cch = (unit >> 3) & 31, b = unit >> 8, g = h >> 2;
        const int ql = 32 * wave + r32; const size_t rowl = (size_t)b * SEQ + cch * 256 + ql;
        const size_t abase = ((size_t)b * 8 + h) * SEQ + cch * 256;
        const float acs_l = ACS[abase + ql], Dh = d_skip[h];
        s_bf16x8 cf[8];
#pragma unroll
        for (int kn = 0; kn < 8; ++kn) cf[kn] = *(const s_bf16x8*)(CC + rowl * 256 + g * 128 + 16 * kn + 8 * hi);
        s_f32x16 o[2]; o[0] = s_f32x16{}; o[1] = s_f32x16{};
        { const bf16* pp = PREV + ((((size_t)b * 32 + cch) * 8 + h) * 64 + r32) * 128 + 8 * hi;
#pragma unroll
          for (int d0 = 0; d0 < 2; ++d0)
#pragma unroll
              for (int kn = 0; kn < 8; ++kn) o[d0] = __builtin_amdgcn_mfma_f32_32x32x16_bf16(*(const s_bf16x8*)(pp + (size_t)d0 * 32 * 128 + 16 * kn), cf[kn], o[d0], 0, 0, 0);
          const float e = expf(acs_l);
#pragma unroll
          for (int r = 0; r < 16; ++r) { o[0][r] *= e; o[1][r] *= e; } }
        const bf16* xp = XT + (((size_t)b * 8 + h) * 64 + r32) * SEQ + cch * 256 + 4 * hi;
        for (int st = 0; st <= wave; ++st) {
            s_f32x16 s = {};
            { const bf16* bp = BC + ((size_t)b * SEQ + cch * 256 + 32 * st + r32) * 256 + g * 128 + 8 * hi;
#pragma unroll
              for (int kn = 0; kn < 8; ++kn) s = __builtin_amdgcn_mfma_f32_32x32x16_bf16(*(const s_bf16x8*)(bp + 16 * kn), cf[kn], s, 0, 0, 0); }
            float P[16];
#pragma unroll
            for (int gq = 0; gq < 4; ++gq) { const f32x4 a4 = *(const f32x4*)(ACS + abase + 32 * st + 8 * gq + 4 * hi), d4 = *(const f32x4*)(DTA + abase + 32 * st + 8 * gq + 4 * hi);
#pragma unroll
                for (int j = 0; j < 4; ++j) { const int key = 32 * st + 8 * gq + 4 * hi + j;
                    const float f = (key <= ql) ? expf(fminf(acs_l - a4[j], 0.f)) * d4[j] : 0.f;
                    float p = s[4 * gq + j] * f; if (key == ql) p += Dh; P[4 * gq + j] = p; } }
            v4u pf0, pf1;
            pf0.x = pk2(P[0], P[1]); pf0.y = pk2(P[2], P[3]); pf0.z = pk2(P[4], P[5]); pf0.w = pk2(P[6], P[7]);
            pf1.x = pk2(P[8], P[9]); pf1.y = pk2(P[10], P[11]); pf1.z = pk2(P[12], P[13]); pf1.w = pk2(P[14], P[15]);
#pragma unroll
            for (int d0 = 0; d0 < 2; ++d0) { const bf16* xq = xp + (size_t)d0 * 32 * SEQ + 32 * st;
                const unsigned long long a0 = *(const unsigned long long*)(xq), a1 = *(const unsigned long long*)(xq + 8), a2 = *(const unsigned long long*)(xq + 16), a3 = *(const unsigned long long*)(xq + 24);
                v4u x0, x1; x0.x = (unsigned)a0; x0.y = (unsigned)(a0 >> 32); x0.z = (unsigned)a1; x0.w = (unsigned)(a1 >> 32); x1.x = (unsigned)a2; x1.y = (unsigned)(a2 >> 32); x1.z = (unsigned)a3; x1.w = (unsigned)(a3 >> 32);
                o[d0] = __builtin_amdgcn_mfma_f32_32x32x16_bf16(__builtin_bit_cast(s_bf16x8, x0), __builtin_bit_cast(s_bf16x8, pf0), o[d0], 0, 0, 0);
                o[d0] = __builtin_amdgcn_mfma_f32_32x32x16_bf16(__builtin_bit_cast(s_bf16x8, x1), __builtin_bit_cast(s_bf16x8, pf1), o[d0], 0, 0, 0); }
        }
#pragma unroll
        for (int d0 = 0; d0 < 2; ++d0)
#pragma unroll
            for (int gq = 0; gq < 4; ++gq) { const int p = 32 * d0 + 8 * gq + 4 * hi;
                const unsigned long long zw = *(const unsigned long long*)(UA + rowl * UA_P + h * 64 + p); const unsigned z0 = (unsigned)zw, z1 = (unsigned)(zw >> 32);
                const float y0 = o[d0][4 * gq] * silu_(bfl(z0)), y1 = o[d0][4 * gq + 1] * silu_(bfh(z0)), y2 = o[d0][4 * gq + 2] * silu_(bfl(z1)), y3 = o[d0][4 * gq + 3] * silu_(bfh(z1));
                *(unsigned long long*)(Y0 + rowl * 512 + h * 64 + p) = (unsigned long long)pk2(y0, y1) | ((unsigned long long)pk2(y2, y3) << 32); }
    }
}
__device__ __forceinline__ void ssd_gnorm_phase(bf16* Y0, const float* normw, int gw, int NGW, int lane) {
    for (int m = gw; m < T; m += NGW) {
        v4u* p = (v4u*)(Y0 + (size_t)m * 512) + lane; const v4u w = *p;
        float v[8] = {bfl(w.x), bfh(w.x), bfl(w.y), bfh(w.y), bfl(w.z), bfh(w.z), bfl(w.w), bfh(w.w)}; float s = 0.f;
#pragma unroll
        for (int j = 0; j < 8; ++j) s += v[j] * v[j];
#pragma unroll
        for (int o = 1; o < 32; o <<= 1) s += __shfl_xor(s, o);
        const float rstd = 1.0f / sqrtf(s * (1.0f / 256.0f) + EPS);
        const f32x4 g0 = ((const f32x4*)normw)[2 * lane], g1 = ((const f32x4*)normw)[2 * lane + 1];
        v4u o; o.x = pk2(v[0] * rstd * g0.x, v[1] * rstd * g0.y); o.y = pk2(v[2] * rstd * g0.z, v[3] * rstd * g0.w); o.z = pk2(v[4] * rstd * g1.x, v[5] * rstd * g1.y); o.w = pk2(v[6] * rstd * g1.z, v[7] * rstd * g1.w);
        *p = o;
    }
}
typedef attn_body::bf16 abf;
template <int ONLY> __device__ __forceinline__ void attn_bd_phase(char* lds, const bf16* UB, bf16* Y2, bf16* Y3, const unsigned* SELM, const unsigned long long* MASKT, int G, int vcu, int tid) {
    for (int v = vcu; v < 256; v += G)
        for (int i = 0; i < 4; ++i) {
            const int s = v & 15, qb = (i & 1) ? 31 - s : s, bh = ((i >> 1) << 4) | (v >> 4);
            int tid_u = tid; asm volatile("" : "+v"(tid_u));
            const int branch = bh >> 4, b = (bh >> 3) & 1, h = bh & 7;
            if (ONLY >= 0 && branch != ONLY) continue;
#ifdef ATT_BASE
            attn_body::attn_unit<8, 3, ATT_BASE_DM, ATT_BASE_ODM>(b, h, qb, (const abf*)UB, (const abf*)UB + 512, (const abf*)UB + 1024, (abf*)Y2, lds, SELM, nullptr, tid_u);
#endif
#ifndef ATT_SKIP1
            if (branch == 0) attn_body::attn_unit<8, 1, UB_P, 512>(b, h, qb, (const abf*)UB, (const abf*)UB + 512, (const abf*)UB + 1024, (abf*)Y2, lds, SELM, nullptr, tid_u);
#endif
#ifndef ATT_SKIP2
            if (branch == 1) attn_body::attn_unit<8, 2, UB_P, 512>(b, h, qb, (const abf*)UB + 1536, (const abf*)UB + 2048, (const abf*)UB + 2560, (abf*)Y3, lds, MASKT, nullptr, tid_u);
#endif
        }
}
__device__ __forceinline__ void attn_fox_phase(char* lds, volatile LAS unsigned* slot, const bf16* UA, bf16* Y1, const float* CF2, const float* QKN, unsigned* counter, int tid) {
    for (;;) {
        if (tid == 0) *slot = __hip_atomic_fetch_add(counter, 1u, __ATOMIC_RELAXED, __HIP_MEMORY_SCOPE_AGENT);
        __syncthreads();
        const unsigned u = (unsigned)__builtin_amdgcn_readfirstlane((int)*slot);
        if (u >= 512u) break;
        const int qb = 31 - (int)(u >> 4), bh = (int)(u & 15u), b = bh >> 3, h = bh & 7;
        int tid_u = tid; asm volatile("" : "+v"(tid_u));
        attn_body::attn_unit<8, 0, UA_P, 512>(b, h, qb, (const abf*)UA + 1536, (const abf*)UA + 2048, (const abf*)UA + 2560, (abf*)Y1, lds, CF2, QKN, tid_u);
    }
}
template <class Epi> __device__ __forceinline__ void run_gemm(LAS unsigned char* lds, const bf16* A, int lda, const bf16* Bt, int ldb, int N, int K, int G, int bx, int tid, const Epi& E) {
    pg8::Gemm g{A, Bt, T, N, K, lda, ldb}; pg8::StaticOrder S; S.init(T, N, G, bx);
    pg8::gemm_phase<Epi, pg8::StaticOrder, true, true>(lds, g, S, E, tid);
}

constexpr int PH_PER_LAYER = 24, N_PHASES = 2 * PH_PER_LAYER;
struct Args { const float* in[19]; float* out; unsigned char* ws; int ph_lo, ph_hi; };
#define RC ((float*)(ws + WS_ROPEC))
#define RS ((float*)(ws + WS_ROPES))
#define CF2 ((float*)(ws + WS_CF2))
#define ACS ((float*)(ws + WS_ACS))
#define DTA ((float*)(ws + WS_DTA))
#define SELM ((unsigned*)(ws + WS_SELM))
#define KPART ((float*)(ws + WS_KPART))
#define IKB ((bf16*)(ws + WS_IKB))
#define WIN ((bf16*)(ws + WS_WIN))
#define WG ((bf16*)(ws + WS_WG))
#define WB ((bf16*)(ws + WS_WB))
#define H ((bf16*)(ws + WS_H))
#define Y ((bf16*)(ws + WS_Y))
#define U ((bf16*)(ws + WS_U))
#define XT ((bf16*)(ws + WS_XT))
#define MASKT ((unsigned long long*)(ws + WS_MASK))
#define BC ((bf16*)(ws + WS_BC))
#define CC ((bf16*)(ws + WS_CC))
#define MISCF ((float*)(ws + WS_MISC))
#define STATE ((float*)(ws + WS_STATE))
#define BT ((bf16*)(ws + WS_BT))
#define PREV ((bf16*)(ws + WS_PREV))
#define GB ((bf16*)(ws + WS_G))
#define MG ((float*)(ws + WS_MG))
#define WO ((bf16*)(ws + WS_WO))
#define WF1 ((bf16*)(ws + WS_WF1))
#define WF2 ((bf16*)(ws + WS_WF2))
#define HP ((bf16*)(ws + WS_HP))
#define Y0 (Y)
#define Y1 (Y + (size_t)T * 512)
#define Y2 (Y + (size_t)2 * T * 512)
#define Y3 (Y + (size_t)3 * T * 512)

#ifndef PH_MASK
#define PH_MASK 0xffffffu
#endif
#define PHASE_PROLOGUE \
    int tid = threadIdx.x; asm volatile("" : "+v"(tid)); \
    int G = gridDim.x, bx = blockIdx.x; asm volatile("" : "+s"(G), "+s"(bx)); \
    unsigned long long wsi_ = (unsigned long long)args.ws; asm volatile("" : "+s"(wsi_)); unsigned char* ws = (unsigned char*)(GAS unsigned char*)wsi_;     \
    const int lane = tid & 63, wave = __builtin_amdgcn_readfirstlane(tid >> 6); \
    const int vcu = (G % 8 == 0) ? (bx % 8) * (G / 8) + bx / 8 : bx; \
    const int gw = vcu * NWAVES + wave, NGW = G * NWAVES, gtid = bx * NTHR + tid, NGT = G * NTHR; \
    LAS float* scr = (LAS float*)(lds + wave * 16384); \
    (void)lane; (void)vcu; (void)gw; (void)NGW; (void)gtid; (void)NGT; (void)scr; (void)ws;
#define IN(k) (lo <= (k) && (k) < hi && ((PH_MASK >> ((k) % PH_PER_LAYER)) & 1u))
#define INR(k) (lo <= (k) && (k) < hi)
#define SEAM(k) do { if (INR(k) && INR((k) + 1)) { if ((k) == 0) { asm volatile("s_waitcnt vmcnt(0)" ::: "memory"); cg::this_grid().sync(); } else xcd_barrier(bar); } } while (0)

#ifndef DUP_MASK
#define DUP_MASK 0u
#endif
#ifndef XTRA_BAR
#define XTRA_BAR 0
#endif
#define DUP(k) (((DUP_MASK >> ((k) % PH_PER_LAYER)) & 1u) != 0u)
#define PHASE(k, ...) do { if (IN(k)) { PHASE_PROLOGUE __VA_ARGS__ } if (DUP(k) && IN(k)) { PHASE_PROLOGUE __VA_ARGS__ } } while (0)
#undef SEAM
#define SEAM(k) do { if (INR(k) && INR((k) + 1)) { if ((k) == 0) { asm volatile("s_waitcnt vmcnt(0)" ::: "memory"); cg::this_grid().sync(); } else xcd_barrier(bar); \
    for (int xb_ = 0; xb_ < XTRA_BAR; ++xb_) xcd_barrier(bar); } } while (0)

template <int L> __device__ __forceinline__ void run_layer(const Args& args, const int lo, const int hi, const XcdBarrier& bar, LAS unsigned char* lds, unsigned char* lds_raw) {
    constexpr int B0 = L * PH_PER_LAYER;
    if (L == 0) {
        PHASE(B0 + 0,
            tr_items(args.in[2], 6484, 1024, WIN, NWIN, MapWin{}, scr, gw, NGW, lane);
            rope_tables(RC, RS, gtid, NGT);
            norm_rows_to_bf16(args.in[0], args.in[1], H, gw, NGW, lane); );
        SEAM(B0 + 0);
    }
    PHASE(B0 + 1,
        pg8::EpiIn E{U, UB_P, (1u << 0) | (1u << 1) | (1u << 6) | (1u << 7), C2, 13, MISCF};
        run_gemm(lds, H, 1024, WIN, 1024, NWIN_B, 1024, G, bx, tid, E); );
    SEAM(B0 + 1);
    PHASE(B0 + 2, rope_phase(U, MISCF, IKB, KPART, RC, RS, lds, G, bx, tid, lane, wave); );
    SEAM(B0 + 2);
    if (IN(B0 + 3)) { PHASE_PROLOGUE moba_gate_phase(U, KPART, SELM, lds, G, bx, tid, lane, wave); }
    if (IN(B0 + 3) && ((DUP_MASK >> 24) & 1u)) { PHASE_PROLOGUE moba_gate_phase(U, KPART, SELM, lds, G, bx, tid, lane, wave); }
    if (IN(B0 + 3)) { PHASE_PROLOGUE dsa_topk_phase(U, IKB, MISCF, MASKT, lds, G, bx, vcu, tid, lane, wave); }
    if (IN(B0 + 3) && ((DUP_MASK >> 25) & 1u)) { PHASE_PROLOGUE dsa_topk_phase(U, IKB, MISCF, MASKT, lds, G, bx, vcu, tid, lane, wave); }
    SEAM(B0 + 3);
    PHASE(B0 + 4, attn_bd_phase<-1>((char*)lds_raw, U, Y2, Y3, SELM, MASKT, G, vcu, tid); );
    if (IN(B0 + 4) && ((DUP_MASK >> 26) & 1u)) { PHASE_PROLOGUE attn_bd_phase<0>((char*)lds_raw, U, Y2, Y3, SELM, MASKT, G, vcu, tid); }
    if (IN(B0 + 4) && ((DUP_MASK >> 27) & 1u)) { PHASE_PROLOGUE attn_bd_phase<1>((char*)lds_raw, U, Y2, Y3, SELM, MASKT, G, vcu, tid); }
    SEAM(B0 + 4);
    PHASE(B0 + 5,
        pg8::EpiIn E{U, UA_P, (1u << 6) | (1u << 7), C2, -1, nullptr};
        run_gemm(lds, H, 1024, WIN + (size_t)NWIN_B * 1024, 1024, NWIN_A, 1024, G, bx, tid, E); );
    SEAM(B0 + 5);
    PHASE(B0 + 6, ssd_prep_phase(U, MISCF, args.in[3] + (size_t)L * 4096, args.in[4] + L * 1024, args.in[5] + L * 8, args.in[6] + L * 8, args.in[9] + L * 8, CF2, ACS, DTA, XT, BT, BC, CC, (unsigned*)(ws + WS_CTL) + CW_QKN + L * 32, lds, G, bx, tid, lane, wave); );
    SEAM(B0 + 6);
    PHASE(B0 + 7, ssd_state_phase(XT, BT, ACS, DTA, STATE, lds, G, bx, tid, lane, wave); );
    SEAM(B0 + 7);
    PHASE(B0 + 8, ssd_scan_phase(STATE, ACS, PREV, G, bx, tid); );
    SEAM(B0 + 8);
    PHASE(B0 + 9, ssd_out_phase(U, XT, BC, CC, PREV, ACS, DTA, args.in[7] + L * 8, Y0, G, bx, lane, wave); );
    SEAM(B0 + 9);
    if (IN(B0 + 10)) { PHASE_PROLOGUE ssd_gnorm_phase(Y0, args.in[8] + L * 512, gw, NGW, lane); }
#ifndef DUP10_ATTN_ONLY
#define DUP10_ATTN_ONLY 1
#endif
    if (IN(B0 + 10)) { PHASE_PROLOGUE
        tr_items(args.in[10] + (size_t)L * 1024 * 4096, 4096, 1024, WG, 4096, MapId{0}, scr, gw, NGW, lane);
        for (int n = 0; n < 4; ++n) tr_items(args.in[12] + ((size_t)L * 4 + n) * 512 * 1024, 1024, 512, WB + (size_t)n * 1024 * 512, 1024, MapId{0}, scr, gw, NGW, lane);
        tr_items(args.in[13] + (size_t)L * 1024 * 1024, 1024, 1024, WO, 1024, MapId{0}, scr, gw, NGW, lane);
        tr_items(args.in[16] + (size_t)L * 1024 * 5632, 5632, 1024, WF1, 5632, MapFfn{}, scr, gw, NGW, lane);
        tr_items(args.in[17] + (size_t)L * FFH * 1024, 1024, FFH, WF2, 1024, MapId{0}, scr, gw, NGW, lane);
        __syncthreads();
    }
    if (IN(B0 + 10)) { PHASE_PROLOGUE attn_fox_phase((char*)lds_raw, (volatile LAS unsigned*)(lds + MISC_OFF) + 16, U, Y1, CF2, (const float*)(ws + WS_CTL) + CW_QKN + L * 32, (unsigned*)(ws + WS_CTL) + CW_WQ + 128 * L, tid); }
    if (DUP(B0 + 10) && IN(B0 + 10)) { PHASE_PROLOGUE attn_fox_phase((char*)lds_raw, (volatile LAS unsigned*)(lds + MISC_OFF) + 16, U, Y1, CF2, (const float*)(ws + WS_CTL) + CW_QKN + L * 32, (unsigned*)(ws + WS_CTL) + CW_WQ + 128 * L + 64, tid); }
    SEAM(B0 + 10);
#pragma unroll
    for (int n = 0; n < 4; ++n) {
        PHASE(B0 + 11 + 2 * n,
            pg8::EpiSig E{GB, 1024, args.in[11] + (size_t)L * 4096 + n * 1024};
            run_gemm(lds, H, 1024, WG + (size_t)n * 1024 * 1024, 1024, 1024, 1024, G, bx, tid, E); );
        SEAM(B0 + 11 + 2 * n);
        if (IN(B0 + 12 + 2 * n)) { PHASE_PROLOGUE
            pg8::EpiBranch E{GB, MG, 1024, n == 0, n == 3};
            run_gemm(lds, Y + (size_t)n * T * 512, 512, WB + (size_t)n * 1024 * 512, 512, 1024, 512, G, bx, tid, E); }
        if (n == 0 && DUP(B0 + 12) && IN(B0 + 12)) { PHASE_PROLOGUE
            pg8::EpiBranch E{GB, MG, 1024, 1, 0};
            run_gemm(lds, Y, 512, WB, 512, 1024, 512, G, bx, tid, E); }
        SEAM(B0 + 12 + 2 * n);
    }
    PHASE(B0 + 19, pg8::EpiF32 E{MG, 1024}; run_gemm(lds, GB, 1024, WO, 1024, 1024, 1024, G, bx, tid, E); );
    SEAM(B0 + 19);
    if (IN(B0 + 20)) { PHASE_PROLOGUE norm_res_rows(MG, args.in[14] + L * 1024, (L == 0) ? args.in[0] : (const float*)args.out, args.out, args.in[15] + L * 1024, H, gw, NGW, lane); }
    SEAM(B0 + 20);
    PHASE(B0 + 21, pg8::EpiSwi E{HP, FFH}; run_gemm(lds, H, 1024, WF1, 1024, 5632, 1024, G, bx, tid, E); );
    SEAM(B0 + 21);
    PHASE(B0 + 22, pg8::EpiF32 E{MG, 1024}; run_gemm(lds, HP, FFH, WF2, FFH, 1024, FFH, G, bx, tid, E); );
    SEAM(B0 + 22);
    if (IN(B0 + 23)) { PHASE_PROLOGUE
        norm_res_rows(MG, args.in[18] + L * 1024, args.out, args.out, (L == 0) ? args.in[1] + 1024 : nullptr, H, gw, NGW, lane);
        if (L == 0) tr_items(args.in[2] + (size_t)1024 * 6484, 6484, 1024, WIN, NWIN, MapWin{}, scr, gw, NGW, lane);
    }
    if (L == 0) SEAM(B0 + 23);
}

__global__ void __launch_bounds__(NTHR, 2) hybrid_fwd(Args args) {
    extern __shared__ __attribute__((aligned(16))) unsigned char lds_raw[];
    LAS unsigned char* lds = (LAS unsigned char*)lds_raw;
    for (int u = threadIdx.x; u < (LDS_BYTES - LDSCTL_OFF) / 4; u += NTHR) ((LAS unsigned*)(lds + LDSCTL_OFF))[u] = 0u;
    __syncthreads();
    const int lo = args.ph_lo, hi = args.ph_hi;
    XcdBarrier bar; bar.bar = (unsigned*)(args.ws + WS_CTL) + CW_BAR; bar.x = 0; bar.st = nullptr;
    if (hi - lo > 1) bar = xcd_barrier_post((unsigned*)(args.ws + WS_CTL) + CW_BAR, (volatile LAS unsigned*)(lds + MISC_OFF) + 8);
    run_layer<0>(args, lo, hi, bar, lds, lds_raw);
    run_layer<1>(args, lo, hi, bar, lds, lds_raw);
}

#ifndef MK_PER_PHASE
#define MK_PER_PHASE 0
#endif
extern "C" void kernel_launch(void* const* d_in, const int* in_sizes, int n_in, void* d_out, int out_size, void* d_ws, size_t ws_size, hipStream_t stream) {
    static int grid = 0;
    if (grid == 0) {
        if (n_in != 19 || in_sizes[0] != T * DMODEL || out_size != T * DMODEL || ws_size < WS_END) { fprintf(stderr, "kernel_launch: unexpected shapes (n_in %d, in0 %d, out %d, ws %zu); nothing launched\n", n_in, n_in > 0 ? in_sizes[0] : -1, out_size, ws_size); grid = -1; return; }
        int dev = 0, cus = 0, per_cu = 0;
        if (hipGetDevice(&dev) != hipSuccess || hipDeviceGetAttribute(&cus, hipDeviceAttributeMultiprocessorCount, dev) != hipSuccess) { grid = -1; return; }
        if (hipFuncSetAttribute((const void*)hybrid_fwd, hipFuncAttributeMaxDynamicSharedMemorySize, LDS_BYTES) != hipSuccess) { fprintf(stderr, "kernel_launch: hipFuncSetAttribute failed\n"); grid = -1; return; }
        if (hipOccupancyMaxActiveBlocksPerMultiprocessor(&per_cu, (const void*)hybrid_fwd, NTHR, LDS_BYTES) != hipSuccess || per_cu < 1) { fprintf(stderr, "kernel_launch: occupancy query says %d\n", per_cu); per_cu = 1; }
        (void)hipGetLastError();
        grid = cus * 1;
        if (grid > 256) grid = 256;
    }
    if (grid < 0) return;
    (void)hipMemsetAsync((char*)d_ws + WS_CTL, 0, CTL_ZERO_BYTES, stream);
    Args a{};
    for (int i = 0; i < 19; ++i) a.in[i] = (const float*)d_in[i];
    a.out = (float*)d_out; a.ws = (unsigned char*)d_ws;
#if MK_PER_PHASE
    for (int p = 0; p < N_PHASES; ++p) { a.ph_lo = p; a.ph_hi = p + 1; hipLaunchKernelGGL(hybrid_fwd, dim3(grid), dim3(NTHR), LDS_BYTES, stream, a); }
#else
    a.ph_lo = 0; a.ph_hi = N_PHASES;
    void* kargs[] = {&a};
    hipError_t e = hipLaunchCooperativeKernel((const void*)hybrid_fwd, dim3(grid), dim3(NTHR), kargs, LDS_BYTES, stream);
    if (e != hipSuccess) fprintf(stderr, "kernel_launch: cooperative launch failed: %s (grid %d)\n", hipGetErrorString(e), grid);
#endif
}
```

```cpp
#include <hip/hip_runtime.h>
#include <hip/hip_cooperative_groups.h>
#include <hip/hip_bf16.h>
#include <cstdio>
#include <cstdint>
#include <cmath>
namespace cg = cooperative_groups;
namespace pg8 {
#define PG8_LAS __attribute__((address_space(3)))
typedef unsigned short bf16_t;
typedef short bf16x8 __attribute__((ext_vector_type(8)));
typedef float f32x4 __attribute__((ext_vector_type(4)));
typedef unsigned u32x4 __attribute__((ext_vector_type(4)));
constexpr int BM = 256, BK = 64, HALF = 128, HTB = HALF * BK * 2  , STAGE_BYTES = 8 * HTB, NXCD = 8, WGM = 8;

__host__ __device__ __forceinline__ int lds_byte(int r, int c) { const int st = (r >> 4) * 2 + (c >> 5), rr = r & 15, cc = c & 31, ob = rr * 64 + cc * 2; return st * 1024 + (ob ^ (((ob >> 9) & 1) << 5)); }
__host__ __device__ __forceinline__ void stage_rc(int b, int& R, int& C) { const int st = b / 1024, sb = b % 1024, swz = sb ^ (((sb >> 9) & 1) << 5); R = (st >> 1) * 16 + swz / 64; C = (st & 1) * 32 + (swz % 64) / 2; }
__host__ __device__ __forceinline__ int perm32(int rho) { const int n = rho >> 4, i = rho & 15; return 8 * (i >> 2) + 4 * n + (i & 3); }

struct Unit { int pm, pn; };
struct Gemm { const bf16_t* A; const bf16_t* Bt; int M, N, K, lda, ldb; };

struct StaticOrder {
    int nM, nN, nwg, G, c;
    __host__ __device__ void init(int M, int N, int G_, int c_) { nM = M / BM; nN = N / BM; nwg = nM * nN; G = G_; c = c_; }
    __host__ __device__ bool next(int i, Unit& u) const {
        const long L = (long)i * G + c; if (L >= nwg) return false;
        int wgid = (int)L; { const int q = nwg / NXCD, r = nwg % NXCD, xcd = wgid % NXCD, off = wgid / NXCD; wgid = (xcd < r ? xcd * (q + 1) : r * (q + 1) + (xcd - r) * q) + off; }
        const int nig = WGM * nN, gid = wgid / nig, fm = gid * WGM, gsz = (nM - fm) < WGM ? (nM - fm) : WGM;
        u.pm = fm + ((wgid % nig) % gsz); u.pn = (wgid % nig) / gsz; return true;
    }
    __device__ __forceinline__ void a_ready(const Unit&) const {}
    __device__ __forceinline__ void done(const Unit&) const {}
};
typedef float f32x2 __attribute__((ext_vector_type(2)));
typedef __bf16 bf16x2_t __attribute__((ext_vector_type(2)));
typedef unsigned u32x2 __attribute__((ext_vector_type(2)));
__device__ __forceinline__ unsigned cvt_pk_bf16(float lo, float hi) { f32x2 v = {lo, hi}; bf16x2_t b = __builtin_convertvector(v, bf16x2_t); return __builtin_bit_cast(unsigned, b); }
__device__ __forceinline__ float bf_lo(unsigned w) { return __builtin_bit_cast(float, w << 16); }
__device__ __forceinline__ float bf_hi(unsigned w) { return __builtin_bit_cast(float, w & 0xffff0000u); }
__device__ __forceinline__ float sigmoidf_(float x) { return 1.0f / (1.0f + __expf(-x)); }

struct EpiIn {
    static constexpr bool PERM = true, AFTER_DRAIN = false;
    bf16_t* U; int ldu; unsigned scale_tiles; float scale; int misc_tile; float* misc;
    __device__ __forceinline__ void operator()(const f32x4 (&acc)[2][2][4][2], const Unit& u, int wr, int wc, int fr, int fq) const {
        const int row0 = u.pm * BM + wr * 64 + fr;
        if (u.pn == misc_tile) {
#pragma unroll
            for (int ai = 0; ai < 2; ++ai)
#pragma unroll
                for (int m = 0; m < 4; ++m) { float* rowp = misc + (size_t)(row0 + ai * HALF + m * 16) * 128 + wc * 32 + 8 * fq;
                    *(f32x4*)(rowp) = acc[ai][0][m][0]; *(f32x4*)(rowp + 4) = acc[ai][0][m][1]; }
            return;
        }
        const float sc = ((scale_tiles >> u.pn) & 1u) ? scale : 1.0f;
        const int col0 = u.pn * BM + wc * 32 + 8 * fq;
#pragma unroll
        for (int ai = 0; ai < 2; ++ai)
#pragma unroll
            for (int m = 0; m < 4; ++m) { bf16_t* rowp = U + (size_t)(row0 + ai * HALF + m * 16) * ldu + col0;
#pragma unroll
                for (int bj = 0; bj < 2; ++bj) { const f32x4 v0 = acc[ai][bj][m][0] * sc, v1 = acc[ai][bj][m][1] * sc;
                    u32x4 w; w.x = cvt_pk_bf16(v0[0], v0[1]); w.y = cvt_pk_bf16(v0[2], v0[3]); w.z = cvt_pk_bf16(v1[0], v1[1]); w.w = cvt_pk_bf16(v1[2], v1[3]);
                    *(u32x4*)(rowp + bj * HALF) = w; } }
    }
};
struct EpiSig {
    static constexpr bool PERM = true, AFTER_DRAIN = false;
    bf16_t* O; int ldc; const float* bias;
    __device__ __forceinline__ void operator()(const f32x4 (&acc)[2][2][4][2], const Unit& u, int wr, int wc, int fr, int fq) const {
        const int row0 = u.pm * BM + wr * 64 + fr, col0 = u.pn * BM + wc * 32 + 8 * fq;
        f32x4 bv[2][2];
#pragma unroll
        for (int bj = 0; bj < 2; ++bj)
#pragma unroll
            for (int n = 0; n < 2; ++n) bv[bj][n] = *(const f32x4*)(bias + col0 + bj * HALF + 4 * n);
#pragma unroll
        for (int ai = 0; ai < 2; ++ai)
#pragma unroll
            for (int m = 0; m < 4; ++m) { bf16_t* rowp = O + (size_t)(row0 + ai * HALF + m * 16) * ldc + col0;
#pragma unroll
                for (int bj = 0; bj < 2; ++bj) { f32x4 v0 = acc[ai][bj][m][0] + bv[bj][0], v1 = acc[ai][bj][m][1] + bv[bj][1];
#pragma unroll
                    for (int j = 0; j < 4; ++j) { v0[j] = sigmoidf_(v0[j]); v1[j] = sigmoidf_(v1[j]); }
                    u32x4 w; w.x = cvt_pk_bf16(v0[0], v0[1]); w.y = cvt_pk_bf16(v0[2], v0[3]); w.z = cvt_pk_bf16(v1[0], v1[1]); w.w = cvt_pk_bf16(v1[2], v1[3]);
                    *(u32x4*)(rowp + bj * HALF) = w; } }
    }
};
struct EpiBranch {
    static constexpr bool PERM = false, AFTER_DRAIN = false;
    bf16_t* G; float* Mg; int ldc; int first, last;
    __device__ __forceinline__ void operator()(const f32x4 (&acc)[2][2][4][2], const Unit& u, int wr, int wc, int fr, int fq) const {
        const int row0 = u.pm * BM + wr * 64 + fr, col0 = u.pn * BM + wc * 32 + 4 * fq;
#pragma unroll
        for (int ai = 0; ai < 2; ++ai)
#pragma unroll
            for (int m = 0; m < 4; ++m) { const size_t ro = (size_t)(row0 + ai * HALF + m * 16) * ldc + col0;
#pragma unroll
                for (int bj = 0; bj < 2; ++bj)
#pragma unroll
                    for (int n = 0; n < 2; ++n) { const size_t off = ro + bj * HALF + n * 16;
                        const u32x2 gw = *(const u32x2*)(G + off);
                        f32x4 v = acc[ai][bj][m][n]; v[0] *= bf_lo(gw.x); v[1] *= bf_hi(gw.x); v[2] *= bf_lo(gw.y); v[3] *= bf_hi(gw.y);
                        if (!first) v = v + *(const f32x4*)(Mg + off);
                        if (last) { u32x2 w; w.x = cvt_pk_bf16(v[0], v[1]); w.y = cvt_pk_bf16(v[2], v[3]); *(u32x2*)(G + off) = w; }
                        else *(f32x4*)(Mg + off) = v; } }
    }
};
struct EpiF32 {
    static constexpr bool PERM = false, AFTER_DRAIN = false;
    float* C; int ldc;
    __device__ __forceinline__ void operator()(const f32x4 (&acc)[2][2][4][2], const Unit& u, int wr, int wc, int fr, int fq) const {
        const int row0 = u.pm * BM + wr * 64 + fr, col0 = u.pn * BM + wc * 32 + 4 * fq;
#pragma unroll
        for (int ai = 0; ai < 2; ++ai)
#pragma unroll
            for (int m = 0; m < 4; ++m) { float* rowp = C + (size_t)(row0 + ai * HALF + m * 16) * ldc + col0;
#pragma unroll
                for (int bj = 0; bj < 2; ++bj)
#pragma unroll
                    for (int n = 0; n < 2; ++n) *(f32x4*)(rowp + bj * HALF + n * 16) = acc[ai][bj][m][n]; }
    }
};
struct EpiSwi {
    static constexpr bool PERM = true, AFTER_DRAIN = false;
    bf16_t* O; int ldc;
    __device__ __forceinline__ void operator()(const f32x4 (&acc)[2][2][4][2], const Unit& u, int wr, int wc, int fr, int fq) const {
        const int row0 = u.pm * BM + wr * 64 + fr, col0 = u.pn * HALF + wc * 32 + 8 * fq;
#pragma unroll
        for (int ai = 0; ai < 2; ++ai)
#pragma unroll
            for (int m = 0; m < 4; ++m) { bf16_t* rowp = O + (size_t)(row0 + ai * HALF + m * 16) * ldc + col0;
                f32x4 v0 = acc[ai][0][m][0], v1 = acc[ai][0][m][1]; const f32x4 u0 = acc[ai][1][m][0], u1 = acc[ai][1][m][1];
#pragma unroll
                for (int j = 0; j < 4; ++j) { v0[j] = v0[j] * sigmoidf_(v0[j]) * u0[j]; v1[j] = v1[j] * sigmoidf_(v1[j]) * u1[j]; }
                u32x4 w; w.x = cvt_pk_bf16(v0[0], v0[1]); w.y = cvt_pk_bf16(v0[2], v0[3]); w.z = cvt_pk_bf16(v1[0], v1[1]); w.w = cvt_pk_bf16(v1[2], v1[3]);
                *(u32x4*)(rowp) = w; }
    }
};

template <class Epi, class Sched, bool ALIGN_EPI = false, bool SP2 = false>
__device__ __forceinline__ void gemm_phase(PG8_LAS unsigned char* lds, const Gemm g, const Sched& S, const Epi& E, const int tid_in) {
    const int tid = tid_in, wid = __builtin_amdgcn_readfirstlane(tid >> 6), lane = tid & 63, wr = wid >> 2, wc = wid & 3, fr = lane & 15, fq = lane >> 4;
    const int K = g.K, nt = K / BK;
    unsigned voffA[2], voffB[2];
#pragma unroll
    for (int i = 0; i < 2; ++i) { int R, C; stage_rc(tid * 16 + i * 8192, R, C); const int Rb = Epi::PERM ? ((R & ~31) + perm32(R & 31)) : R;
        voffA[i] = (unsigned)(R * g.lda + C) * 2u; voffB[i] = (unsigned)(Rb * g.ldb + C) * 2u; }
    const size_t kstep = (size_t)(BK * 2);
    const size_t hstepA = (size_t)HALF * g.lda * 2, hstepB = (size_t)HALF * g.ldb * 2;
    const size_t tstepA = 2 * hstepA, tstepB = 2 * hstepB;
    const unsigned ldsw = (unsigned)wid * 1024u;
    const int aoff = lds_byte(wr * 64 + fr, fq * 8), boff = lds_byte(wc * 32 + fr, fq * 8);
#define PG8_SA(b, h) (((b) * 2 + (h)) * HTB)
#define PG8_SB(b, h) ((4 + (b) * 2 + (h)) * HTB)
#define PG8_STAGE(bufoff, gbase, voff) do { _Pragma("unroll") for (int _i = 0; _i < 2; ++_i) \
        __builtin_amdgcn_global_load_lds((const unsigned*)((const char*)(gbase) + (voff)[_i]), (PG8_LAS unsigned*)(lds + (bufoff) + ldsw + _i * 8192), 16, 0, 0); } while (0)
#define PG8_LDA(dst, b, h) do { _Pragma("unroll") for (int m = 0; m < 4; ++m) _Pragma("unroll") for (int k = 0; k < 2; ++k) dst[m][k] = *(const PG8_LAS bf16x8*)(lds + PG8_SA(b, h) + aoff + m * 2048 + k * 1024); } while (0)
#define PG8_LDB(dst, b, h) do { _Pragma("unroll") for (int n = 0; n < 2; ++n) _Pragma("unroll") for (int k = 0; k < 2; ++k) dst[n][k] = *(const PG8_LAS bf16x8*)(lds + PG8_SB(b, h) + boff + n * 2048 + k * 1024); } while (0)
#define PG8_MMA(ai, bj, At, Bt) do { __builtin_amdgcn_s_setprio(1); _Pragma("unroll") for (int m = 0; m < 4; ++m) _Pragma("unroll") for (int n = 0; n < 2; ++n) _Pragma("unroll") for (int k = 0; k < 2; ++k) \
        acc[ai][bj][m][n] = __builtin_amdgcn_mfma_f32_16x16x32_bf16(Bt[n][k], At[m][k], acc[ai][bj][m][n], 0, 0, 0); __builtin_amdgcn_s_setprio(0); } while (0)
#define PG8_WAIT_V(n) asm volatile("s_waitcnt vmcnt(" #n ")" ::: "memory")
#define PG8_WAIT_L(n) asm volatile("s_waitcnt lgkmcnt(" #n ")" ::: "memory")
#define PG8_BAR __builtin_amdgcn_s_barrier()
#define PG8_SCHED __builtin_amdgcn_sched_barrier(0)
    Unit cur, nxt; int ui = 0;
    if (!S.next(0, cur)) return;
    f32x4 acc[2][2][4][2];
#pragma unroll
    for (int a = 0; a < 2; ++a)
#pragma unroll
        for (int b = 0; b < 2; ++b)
#pragma unroll
            for (int m = 0; m < 4; ++m)
#pragma unroll
                for (int n = 0; n < 2; ++n) acc[a][b][m][n] = (f32x4){0.f, 0.f, 0.f, 0.f};
    bf16x8 At[4][2], B0[2][2], B1[2][2];
    const char* cA = (const char*)g.A + (size_t)cur.pm * tstepA; const char* cB = (const char*)g.Bt + (size_t)cur.pn * tstepB;
    S.a_ready(cur);
    if constexpr (SP2) {
        PG8_STAGE(PG8_SB(0, 0), cB, voffB); PG8_STAGE(PG8_SB(0, 1), cB + hstepB, voffB); PG8_STAGE(PG8_SA(0, 0), cA, voffA); PG8_STAGE(PG8_SA(0, 1), cA + hstepA, voffA);
        if (wr == 1) PG8_BAR;
        PG8_WAIT_V(2); PG8_BAR;
        PG8_STAGE(PG8_SB(1, 0), cB + kstep, voffB); PG8_STAGE(PG8_SA(1, 0), cA + kstep, voffA); PG8_STAGE(PG8_SB(1, 1), cB + hstepB + kstep, voffB);
        PG8_WAIT_V(6); PG8_BAR;
    } else {
        PG8_STAGE(PG8_SB(0, 0), cB, voffB); PG8_STAGE(PG8_SA(0, 0), cA, voffA); PG8_STAGE(PG8_SB(0, 1), cB + hstepB, voffB); PG8_STAGE(PG8_SA(0, 1), cA + hstepA, voffA);
        if (wr == 1) PG8_BAR;
        PG8_WAIT_V(4); PG8_BAR;
        PG8_STAGE(PG8_SB(1, 0), cB + kstep, voffB); PG8_STAGE(PG8_SA(1, 0), cA + kstep, voffA); PG8_STAGE(PG8_SB(1, 1), cB + hstepB + kstep, voffB);
        PG8_WAIT_V(6); PG8_BAR;
    }
    for (;;) {
        const bool has_next = S.next(ui + 1, nxt);
        const char* nA = has_next ? (const char*)g.A + (size_t)nxt.pm * tstepA : cA; const char* nB = has_next ? (const char*)g.Bt + (size_t)nxt.pn * tstepB : cB;
        for (int t = 0; t < nt; t += 2) {
            const bool last = (t == nt - 2);
            const char* a1 = cA + (size_t)(t + 1) * kstep;
            const char* a2 = last ? nA : cA + (size_t)(t + 2) * kstep; const char* b2 = last ? nB : cB + (size_t)(t + 2) * kstep;
            const char* a3 = a2 + kstep; const char* b3 = b2 + kstep;
            if (last && has_next) S.a_ready(nxt);
            if constexpr (SP2) {
            PG8_LDB(B0, 0, 0); PG8_LDB(B1, 0, 1); PG8_SCHED; PG8_LDA(At, 0, 0); PG8_STAGE(PG8_SA(1, 1), a1 + hstepA, voffA);
            PG8_WAIT_V(8); PG8_WAIT_L(0); PG8_BAR; PG8_MMA(0, 0, At, B0); PG8_MMA(0, 1, At, B1); PG8_BAR; PG8_SCHED;
            PG8_LDA(At, 0, 1); PG8_STAGE(PG8_SB(0, 0), b2, voffB); PG8_STAGE(PG8_SB(0, 1), b2 + hstepB, voffB); PG8_STAGE(PG8_SA(0, 0), a2, voffA);
            PG8_WAIT_V(8); PG8_WAIT_L(0); PG8_BAR; PG8_MMA(1, 0, At, B0); PG8_MMA(1, 1, At, B1); PG8_BAR; PG8_SCHED;
            PG8_LDB(B0, 1, 0); PG8_LDB(B1, 1, 1); PG8_SCHED; PG8_LDA(At, 1, 0); PG8_STAGE(PG8_SA(0, 1), a2 + hstepA, voffA);
            PG8_WAIT_V(8); PG8_WAIT_L(0); PG8_BAR; PG8_MMA(0, 0, At, B0); PG8_MMA(0, 1, At, B1); PG8_BAR; PG8_SCHED;
            PG8_LDA(At, 1, 1); PG8_STAGE(PG8_SB(1, 0), b3, voffB); PG8_STAGE(PG8_SB(1, 1), b3 + hstepB, voffB); PG8_STAGE(PG8_SA(1, 0), a3, voffA);
            PG8_WAIT_V(8); PG8_WAIT_L(0); PG8_BAR; PG8_MMA(1, 0, At, B0); PG8_MMA(1, 1, At, B1); PG8_BAR; PG8_SCHED;
            } else {
            PG8_LDB(B0, 0, 0); PG8_SCHED; PG8_LDA(At, 0, 0); PG8_STAGE(PG8_SA(1, 1), a1 + hstepA, voffA);
            PG8_WAIT_L(8); PG8_BAR; PG8_WAIT_L(0); PG8_MMA(0, 0, At, B0); PG8_BAR; PG8_SCHED;
            PG8_LDB(B1, 0, 1); PG8_STAGE(PG8_SB(0, 0), b2, voffB);
            PG8_BAR; PG8_WAIT_L(0); PG8_MMA(0, 1, At, B1); PG8_BAR;
            PG8_LDA(At, 0, 1); PG8_STAGE(PG8_SA(0, 0), a2, voffA);
            PG8_BAR; PG8_WAIT_L(0); PG8_MMA(1, 0, At, B0); PG8_BAR; PG8_SCHED;
            PG8_STAGE(PG8_SB(0, 1), b2 + hstepB, voffB);
            PG8_WAIT_V(6); PG8_BAR; PG8_MMA(1, 1, At, B1); PG8_BAR;
            PG8_LDB(B0, 1, 0); PG8_SCHED; PG8_LDA(At, 1, 0); PG8_STAGE(PG8_SA(0, 1), a2 + hstepA, voffA);
            PG8_WAIT_L(8); PG8_BAR; PG8_WAIT_L(0); PG8_MMA(0, 0, At, B0); PG8_BAR; PG8_SCHED;
            PG8_LDB(B1, 1, 1); PG8_STAGE(PG8_SB(1, 0), b3, voffB);
            PG8_BAR; PG8_WAIT_L(0); PG8_MMA(0, 1, At, B1); PG8_BAR;
            PG8_LDA(At, 1, 1); PG8_STAGE(PG8_SA(1, 0), a3, voffA);
            PG8_BAR; PG8_WAIT_L(0); PG8_MMA(1, 0, At, B0); PG8_BAR; PG8_SCHED;
            PG8_STAGE(PG8_SB(1, 1), b3 + hstepB, voffB);
            PG8_WAIT_V(6); PG8_BAR; PG8_MMA(1, 1, At, B1); PG8_BAR;
            }
        }
        if constexpr (ALIGN_EPI) { if (wr == 0) PG8_BAR; }
        if constexpr (!Epi::AFTER_DRAIN) { E(acc, cur, wr, wc, fr, fq); S.done(cur); }
        if (!has_next) break;
#pragma unroll
        for (int a = 0; a < 2; ++a)
#pragma unroll
            for (int b = 0; b < 2; ++b)
#pragma unroll
                for (int m = 0; m < 4; ++m)
#pragma unroll
                    for (int n = 0; n < 2; ++n) acc[a][b][m][n] = (f32x4){0.f, 0.f, 0.f, 0.f};
        cur = nxt; cA = nA; cB = nB; ++ui;
        if constexpr (ALIGN_EPI) { if (wr == 1) PG8_BAR; }
    }
    PG8_WAIT_V(0);
    if constexpr (!ALIGN_EPI) { if (wr == 0) PG8_BAR; }
    PG8_BAR;
    if constexpr (Epi::AFTER_DRAIN) { E.fused(acc, cur, wr, wc, fr, fq, lds, wid, lane); S.done(cur); }
#undef PG8_SA
#undef PG8_SB
#undef PG8_STAGE
#undef PG8_LDA
#undef PG8_LDB
#undef PG8_MMA
#undef PG8_WAIT_V
#undef PG8_WAIT_L
#undef PG8_BAR
#undef PG8_SCHED
}
}

#include <hip/hip_bf16.h>
#include <cmath>
namespace attn_body {
using bf16=__hip_bfloat16;
using bf16x8=__attribute__((ext_vector_type(8)))short;
using s16x4=__attribute__((ext_vector_type(4)))short;
using f32x16=__attribute__((ext_vector_type(16)))float;
using u32x4=__attribute__((ext_vector_type(4)))unsigned;
constexpr int BATCH=2,SEQ=8192,D=64;
constexpr int NW=8,QBLK=32,QB=QBLK*NW,KVBLK=64,NQB=SEQ/QB;
constexpr int ATTN_UNIT_ROWS=QB;
__device__ __forceinline__ int crow(int r,int hi){return (r&3)+8*(r>>2)+4*hi;}
#define SBAR() __builtin_amdgcn_sched_barrier(0)
__device__ __forceinline__ void cmask(f32x16&p0,f32x16&p1,int jb,int qrel,int hi){
  const float NEG=-INFINITY; int kb=64*jb+4*hi;
  #pragma unroll
  for(int r=0;r<16;++r){int kv=kb+(r&3)+8*(r>>2); if(kv>qrel)p0[r]=NEG; if(kv+32>qrel)p1[r]=NEG;}
}

constexpr int NSLOT=3, SLOTB=8192;
constexpr int LDS_K=0, LDS_V=NSLOT*SLOTB, LDS_WS=2*NSLOT*SLOTB, LDS_OST=LDS_WS+NW*64*4, LDS_BYTES=LDS_OST+NW*4096, LDS_CF=LDS_BYTES, LDS_TOTAL=LDS_CF+32768;
constexpr float C2=0.125f*1.4426950408889634f;
__device__ __forceinline__ void glds16(const void*gsrc,unsigned lds_dst){unsigned keep;
  asm volatile("s_mov_b32 %0, m0\n\ts_mov_b32 m0, %2\n\ts_nop 0\n\tglobal_load_lds_dwordx4 %1, off\n\ts_mov_b32 m0, %0":"=&s"(keep):"v"(gsrc),"s"(lds_dst):"memory");}
__device__ __forceinline__ void glds4(const void*gsrc,unsigned lds_dst){unsigned keep;
  asm volatile("s_mov_b32 %0, m0\n\ts_mov_b32 m0, %2\n\ts_nop 0\n\tglobal_load_lds_dword %1, off\n\ts_mov_b32 m0, %0":"=&s"(keep):"v"(gsrc),"s"(lds_dst):"memory");}
__device__ __forceinline__ float max3f(float a,float b,float c){float r;asm("v_max3_f32 %0, %1, %2, %3":"=v"(r):"v"(a),"v"(b),"v"(c));return r;}
__device__ __forceinline__ float max2f(float a,float b){float r;asm("v_max_f32_e32 %0, %1, %2":"=v"(r):"v"(a),"v"(b));return r;}
__device__ __forceinline__ float fadd_s(float a,float b){float r;asm("v_add_f32_e32 %0, %1, %2":"=v"(r):"v"(a),"v"(b));return r;}
__device__ __forceinline__ float fsub_s(float a,float b){float r;asm("v_sub_f32_e32 %0, %1, %2":"=v"(r):"v"(a),"v"(b));return r;}
typedef float f32x2_t __attribute__((ext_vector_type(2))); typedef __bf16 bf16x2_t __attribute__((ext_vector_type(2)));
__device__ __forceinline__ unsigned cvtpk_s(float lo,float hi){f32x2_t v={lo,hi};bf16x2_t b=__builtin_convertvector(v,bf16x2_t);return __builtin_bit_cast(unsigned,b);}
#define WAIT_BAR(N) asm volatile("s_waitcnt vmcnt(" #N ") lgkmcnt(0)\n\ts_barrier":::"memory")

__device__ __forceinline__ void qkt(f32x16&p0,f32x16&p1,const char*Kslot,const bf16x8*qr,const f32x16&negm,int r32,int hi){
  const char*kb=Kslot+hi*1024+r32*16;
  #pragma unroll
  for(int d0=0;d0<4;++d0){
    const bf16x8 b0=*reinterpret_cast<const bf16x8*>(kb+d0*2048);
    const bf16x8 b1=*reinterpret_cast<const bf16x8*>(kb+d0*2048+512);
    if(d0==0){p0=__builtin_amdgcn_mfma_f32_32x32x16_bf16(b0,qr[0],negm,0,0,0);p1=__builtin_amdgcn_mfma_f32_32x32x16_bf16(b1,qr[0],negm,0,0,0);}
    else{p0=__builtin_amdgcn_mfma_f32_32x32x16_bf16(b0,qr[d0],p0,0,0,0);p1=__builtin_amdgcn_mfma_f32_32x32x16_bf16(b1,qr[d0],p1,0,0,0);}}
}
typedef __attribute__((address_space(3))) const char* lds_cptr;
typedef short v4i16_t __attribute__((ext_vector_type(4)));
__device__ __forceinline__ void kload8(bf16x8*kf,lds_cptr kp){
  kf[0]=*(const __attribute__((address_space(3))) bf16x8*)(kp);      kf[1]=*(const __attribute__((address_space(3))) bf16x8*)(kp+512);
  kf[2]=*(const __attribute__((address_space(3))) bf16x8*)(kp+2048); kf[3]=*(const __attribute__((address_space(3))) bf16x8*)(kp+2560);
  kf[4]=*(const __attribute__((address_space(3))) bf16x8*)(kp+4096); kf[5]=*(const __attribute__((address_space(3))) bf16x8*)(kp+4608);
  kf[6]=*(const __attribute__((address_space(3))) bf16x8*)(kp+6144); kf[7]=*(const __attribute__((address_space(3))) bf16x8*)(kp+6656);
}
__device__ __forceinline__ void kload2(bf16x8*kf,lds_cptr kp,int j){ kf[2*j]=*(const __attribute__((address_space(3))) bf16x8*)(kp+j*2048); kf[2*j+1]=*(const __attribute__((address_space(3))) bf16x8*)(kp+j*2048+512); }
__device__ __forceinline__ s16x4 vtr(lds_cptr p){ return __builtin_bit_cast(s16x4,__builtin_amdgcn_ds_read_tr16_b64_v4i16((__attribute__((address_space(3))) v4i16_t*)p)); }
__device__ __forceinline__ float rowmax(const f32x16&p0,const f32x16&p1){
  float a=max3f(p0[0],p0[1],p1[0]),b=max3f(p0[2],p0[3],p1[1]);a=max3f(a,p1[2],p1[3]);
  #pragma unroll
  for(int r=4;r<16;r+=4){a=max3f(a,p0[r],p0[r+1]);b=max3f(b,p0[r+2],p0[r+3]);a=max3f(a,p1[r],p1[r+1]);b=max3f(b,p1[r+2],p1[r+3]);}
  const float m=max2f(a,b);
  auto rr=__builtin_amdgcn_permlane32_swap(__float_as_uint(m),__float_as_uint(m),false,false);
  return max2f(__uint_as_float(rr[0]),__uint_as_float(rr[1]));
}
__device__ __forceinline__ void pv(f32x16*o,int vb,bf16x8 pa0,bf16x8 pa1,bf16x8 pa2,bf16x8 pa3){
  #pragma unroll
  for(int d0=0;d0<2;++d0){s16x4 lo[4],hi[4];
    #pragma unroll
    for(int ks=0;ks<4;++ks){
      asm volatile("ds_read_b64_tr_b16 %0,%1 offset:%c2":"=&v"(lo[ks]):"v"(vb),"i"(d0*4096+ks*1024):"memory");
      asm volatile("ds_read_b64_tr_b16 %0,%1 offset:%c2":"=&v"(hi[ks]):"v"(vb),"i"(d0*4096+ks*1024+512):"memory");}
    asm volatile("s_waitcnt lgkmcnt(0)":::"memory");SBAR();
    #define PK(k) (bf16x8){lo[k][0],lo[k][1],lo[k][2],lo[k][3],hi[k][0],hi[k][1],hi[k][2],hi[k][3]}
    o[d0]=__builtin_amdgcn_mfma_f32_32x32x16_bf16(pa0,PK(0),o[d0],0,0,0);
    o[d0]=__builtin_amdgcn_mfma_f32_32x32x16_bf16(pa1,PK(1),o[d0],0,0,0);
    o[d0]=__builtin_amdgcn_mfma_f32_32x32x16_bf16(pa2,PK(2),o[d0],0,0,0);
    o[d0]=__builtin_amdgcn_mfma_f32_32x32x16_bf16(pa3,PK(3),o[d0],0,0,0);
    #undef PK
  }
}


typedef __attribute__((address_space(3))) const float* lds_cfptr;
typedef float f32x4m __attribute__((ext_vector_type(4)));
template<int MODE,bool BAND> __device__ __forceinline__ void tile_mask(f32x16&p0,f32x16&p1,int t,int NT,int qrel,int hi,lds_cfptr cfl,lds_cptr mring){
  const float NEG=-INFINITY;
  const int jb=t-(NT-4); const int dq=qrel-((BAND && jb>=0)?(64*jb+4*hi):-(1<<20));
  if constexpr(MODE==0){
    const __attribute__((address_space(3))) f32x4m* c4=(const __attribute__((address_space(3))) f32x4m*)(cfl+64*t+4*hi);
    #pragma unroll
    for(int g=0;g<4;++g){ const f32x4m a=c4[2*g], bq=c4[8+2*g];
      #pragma unroll
      for(int j=0;j<4;++j){ const int kc=j+8*g; const float v0=p0[4*g+j]-a[j], v1=p1[4*g+j]-bq[j];
        if constexpr(BAND){ p0[4*g+j]=(kc>dq)?NEG:v0; p1[4*g+j]=(kc+32>dq)?NEG:v1; } else { p0[4*g+j]=v0; p1[4*g+j]=v1; } }
      __builtin_amdgcn_sched_barrier(0); }
  }
  if constexpr(MODE==1 || MODE==3){
    if constexpr(BAND){
      #pragma unroll
      for(int r=0;r<16;++r){ const int kc=(r&3)+8*(r>>2); p0[r]=(kc>dq)?NEG:p0[r]; p1[r]=(kc+32>dq)?NEG:p1[r]; } }
  }
  if constexpr(MODE==2){
    const unsigned long long mw=*(const __attribute__((address_space(3))) unsigned long long*)(mring+(t&3)*256);
    const int lo=(int)((unsigned)mw>>(4*hi)), hw=(int)((unsigned)(mw>>32)>>(4*hi));
    #pragma unroll
    for(int r=0;r<16;++r){ const int sh=(r&3)+8*(r>>2);
      p0[r]=(((unsigned)lo>>sh)&1u)?p0[r]:NEG; p1[r]=(((unsigned)hw>>sh)&1u)?p1[r]:NEG; }
  }
}
#ifndef ATTN_STORE16
#define ATTN_STORE16(p,v) (*(u32x4*)(p)=(v))
#endif
template<int THRL,int MODE,int DM,int ODM> __device__ __forceinline__ void attn_unit(int b,int h,int qb,const bf16*Q,const bf16*__restrict__ K,const bf16*__restrict__ V,bf16*O,char*shm,const void*aux,const float*aux2,const int tid_in){
  const int tid=tid_in,lane=tid&63,r32=lane&31,hi=lane>>5; const int wid=__builtin_amdgcn_readfirstlane(tid>>6);
  const long rowbase=(long)b*SEQ; const int q0=qb*QB;
  const bf16*Qw=Q+(rowbase+q0+wid*QBLK)*DM+h*D;
  int t0=0;
  if constexpr(MODE==0){ const float*cf=(const float*)aux+((long)b*8+h)*SEQ; const float smax=sqrtf(aux2[(b*8+h)*2]*aux2[(b*8+h)*2+1]);
    const float bnd=cf[q0]+2.f*smax+40.f; const int ntl=(q0+QB)/KVBLK-4;
    const int j0=lane, j1=lane+64; const bool d0_=(j0<ntl)&&(cf[64*j0+63]>=bnd), d1_=(j1<ntl)&&(cf[64*j1+63]>=bnd);
    t0=(__popcll(__ballot(d0_))+__popcll(__ballot(d1_)))&~1; t0=__builtin_amdgcn_readfirstlane(t0); }
  const bf16*Kh=K+(rowbase+(long)t0*KVBLK)*DM+h*D,*Vh=V+(rowbase+(long)t0*KVBLK)*DM+h*D;
  const unsigned lds0=(unsigned)(uintptr_t)shm;
  float*wsf=(float*)(shm+LDS_WS)+wid*64;
  const bf16*ksrc=Kh+(long)lane*DM+wid*8;
  const bf16*vsrc=Vh+(long)(16*(wid&3)+(lane>>2))*DM+(wid>>2)*32+(lane&3)*8;
  const unsigned kdst=lds0+LDS_K+wid*1024, vdst=lds0+LDS_V+wid*1024;
  #define DMA_K(t,slot) glds16(ksrc+(long)(t)*KVBLK*DM,(unsigned)__builtin_amdgcn_readfirstlane(kdst+(slot)))
  #define DMA_V(t,slot) glds16(vsrc+(long)(t)*KVBLK*DM,(unsigned)__builtin_amdgcn_readfirstlane(vdst+(slot)))
  const int vb0=(int)(lds0+LDS_V)+((lane>>4)&1)*32+(lane&3)*8+(4*hi+((lane&15)>>2))*64;
  const char*Kbase=shm+LDS_K; bf16x8 kf[8];
  const lds_cptr shm3=(lds_cptr)shm; const lds_cptr kp0=shm3+LDS_K+hi*1024+r32*16; const lds_cptr vp0=shm3+LDS_V+((lane>>4)&1)*32+(lane&3)*8+(4*hi+((lane&15)>>2))*64;
  const int NT=(q0+QB)/KVBLK-t0;
  const char*msrc=nullptr; const unsigned mdst=lds0+LDS_CF+wid*1024;
  if constexpr(MODE==2){ msrc=(const char*)((const unsigned long long*)aux+(long)b*128*SEQ+q0+wid*QBLK)+lane*4; }
  #define DMA_M(t) glds4(msrc+(long)(t)*SEQ*8,(unsigned)__builtin_amdgcn_readfirstlane(mdst+(((t)&3)*256)))
  if constexpr(MODE==2){ DMA_M(0);DMA_M(1);DMA_M(2); }
  DMA_K(0,0);DMA_V(0,0);DMA_K(1,SLOTB);
  bf16x8 qr[4];
  #pragma unroll
  for(int d0=0;d0<4;++d0)qr[d0]=*reinterpret_cast<const bf16x8*>(&Qw[(long)r32*DM+d0*16+hi*8]);
  const int qrel=wid*QBLK+r32;
  float cfq2=0.f; unsigned selw=0u;
  const lds_cfptr cfl3=(lds_cfptr)(shm+LDS_CF); const lds_cptr mring=(lds_cptr)shm+LDS_CF+wid*1024+r32*8;
  if constexpr(MODE==0){ const float*cf=(const float*)aux+((long)b*8+h)*SEQ; cfq2=cf[q0+qrel];
    __attribute__((address_space(3))) f32x4m* cw=(__attribute__((address_space(3))) f32x4m*)(shm+LDS_CF);
    for(int i=tid;i<(q0+QB-t0*KVBLK)/4;i+=NW*64) cw[i]=((const f32x4m*)(cf+t0*KVBLK))[i]; }
  if constexpr(MODE==1){ selw=((const unsigned*)aux)[(rowbase+q0+qrel)*8+h]; }
  float mhat=0.f,l_reg=0.f;f32x16 o[2];o[0]=f32x16{};o[1]=f32x16{};f32x16 negm;
  #define SETNEGM(tt) do{ float v_=cfq2-mhat; if constexpr(MODE==1){ if(!((tt)>=NT-4 || ((selw>>((tt)>>2))&1u))) v_=-INFINITY; } \
      _Pragma("unroll") for(int r=0;r<16;++r)negm[r]=v_; asm volatile("":"+v"(negm)); }while(0)
  SETNEGM(0);
  #define CMASK(P0,P1,t) tile_mask<MODE,true>(P0,P1,(t),NT,qrel,hi,cfl3,mring)
  bool resc=false;
  #define START(P0,P1) do{ const float rm=max2f(rowmax(P0,P1),-100.f); resc=false; \
    { const float dl=rm; mhat=fadd_s(mhat,dl); \
      _Pragma("unroll") for(int r=0;r<16;++r){P0[r]=fsub_s(P0[r],dl);P1[r]=fsub_s(P1[r],dl);} \
      SETNEGM(1); } \
    _Pragma("unroll") for(int r=0;r<16;++r)P0[r]=__builtin_amdgcn_exp2f(P0[r]); }while(0)
  #define RESC() do{ if(resc){ asm volatile("s_waitcnt lgkmcnt(0)":::"memory"); \
      _Pragma("unroll") for(int d_=0;d_<2;++d_) _Pragma("unroll") for(int r=0;r<16;++r)o[d_][r]*=wsf[crow(r,hi)]; } }while(0)
  f32x16 pA0,pA1,pB0,pB1;
  int sl_prev=0,sl_cur=0,sl_next=SLOTB;
  #define ROT() do{sl_prev=sl_cur;sl_cur=sl_next;sl_next=(sl_next==(NSLOT-1)*SLOTB)?0:sl_next+SLOTB; }while(0)
  DMA_K(2,2*SLOTB);
  WAIT_BAR(3);
  qkt(pA0,pA1,Kbase,qr,negm,r32,hi);asm volatile("s_nop 15\n\ts_nop 7":"+v"(pA0),"+v"(pA1));CMASK(pA0,pA1,0);
  START(pA0,pA1);
  _Pragma("unroll") for(int r=0;r<16;++r)pA1[r]=__builtin_amdgcn_exp2f(pA1[r]);
  WAIT_BAR(0);
  DMA_K(3,0);DMA_V(1,SLOTB);
  ROT();
  kload8(kf,kp0+sl_cur);
  WAIT_BAR(2);
  s16x4 vlo[8],vhi[8]; u32x4 pw0,pw1,pw2,pw3;
  #define PKW(P,B) cvtpk_s(P[B],P[B+1])
  #define PAF(k) __builtin_bit_cast(bf16x8,pw##k)
  #define VFR(i) (bf16x8){vlo[i][0],vlo[i][1],vlo[i][2],vlo[i][3],vhi[i][0],vhi[i][1],vhi[i][2],vhi[i][3]}
  #define PIN(x) asm volatile("":"+v"(x))
  #define MX3(a,b,c) __builtin_fmaxf(__builtin_fmaxf((a),(b)),(c))
  #define GAPA(MF,A0,A1,A2,A3,W0,W1,PW) do{ MF; sacc+=A0; sacc+=A1; sacc+=A2; sacc+=A3; PIN(sacc); W0; W1; PIN(PW); SBAR(); }while(0)
  #define EX(v) __builtin_amdgcn_exp2f(v)
  #define GAPB(MF,X,B) do{ MF; X[B]=EX(X[B]); X[B+1]=EX(X[B+1]); X[B+2]=EX(X[B+2]); X[B+3]=EX(X[B+3]); PIN(X); SBAR(); }while(0)
  #define VRD(i) do{ vlo[i]=vtr(vp_+(((i)>>2)*4096+((i)&3)*1024)); vhi[i]=vtr(vp_+(((i)>>2)*4096+((i)&3)*1024+512)); }while(0)
  #define KRD(G,j) do{ if(G){ kload2(kf,kp0+sl_next,j); SBAR(); } }while(0)
  #define STEP(C0,C1,P0,P1,t,GK,GV,GL) do{ SBAR(); if constexpr(MODE==2){ if((t)+2<NT){DMA_M((t)+2);} } \
    const lds_cptr vp_=vp0+sl_prev; \
    VRD(0); SBAR(); float sacc=(P0[0]+P0[1]); \
    GAPA(C0=__builtin_amdgcn_mfma_f32_32x32x16_bf16(kf[0],qr[0],negm,0,0,0), P0[2],P0[3],P0[4],P0[5],     pw0[0]=PKW(P0,0), pw0[1]=PKW(P0,2), pw0); \
    VRD(4); SBAR(); GAPA(C1=__builtin_amdgcn_mfma_f32_32x32x16_bf16(kf[1],qr[0],negm,0,0,0), P0[6],P0[7],P0[8],P0[9],     pw0[2]=PKW(P0,4), pw0[3]=PKW(P0,6), pw0); \
    VRD(1); SBAR(); GAPA(C0=__builtin_amdgcn_mfma_f32_32x32x16_bf16(kf[2],qr[1],C0,0,0,0),   P0[10],P0[11],P0[12],P0[13], pw1[0]=PKW(P0,8), pw1[1]=PKW(P0,10), pw1); \
    VRD(5); SBAR(); GAPA(C1=__builtin_amdgcn_mfma_f32_32x32x16_bf16(kf[3],qr[1],C1,0,0,0),   P0[14],P0[15],P1[0],P1[1],   pw1[2]=PKW(P0,12),pw1[3]=PKW(P0,14), pw1); \
    VRD(2); SBAR(); GAPA(C0=__builtin_amdgcn_mfma_f32_32x32x16_bf16(kf[4],qr[2],C0,0,0,0),   P1[2],P1[3],P1[4],P1[5],     pw2[0]=PKW(P1,0), pw2[1]=PKW(P1,2), pw2); \
    VRD(6); SBAR(); GAPA(C1=__builtin_amdgcn_mfma_f32_32x32x16_bf16(kf[5],qr[2],C1,0,0,0),   P1[6],P1[7],P1[8],P1[9],     pw2[2]=PKW(P1,4), pw2[3]=PKW(P1,6), pw2); \
    VRD(3); SBAR(); GAPA(C0=__builtin_amdgcn_mfma_f32_32x32x16_bf16(kf[6],qr[3],C0,0,0,0),   P1[10],P1[11],P1[12],P1[13], pw3[0]=PKW(P1,8), pw3[1]=PKW(P1,10), pw3); \
    VRD(7); SBAR(); GAPA(C1=__builtin_amdgcn_mfma_f32_32x32x16_bf16(kf[7],qr[3],C1,0,0,0),   P1[14],P1[15],0.f,0.f,       pw3[2]=PKW(P1,12),pw3[3]=PKW(P1,14), pw3); \
    l_reg+=sacc; \
    if(GK){DMA_K((t)+3,sl_cur);} if(GV){DMA_V((t)+1,sl_next);} \
    CMASK(C0,C1,t); \
    { float a=MX3(C0[0],C0[1],C1[0]),b=MX3(C0[2],C0[3],C1[1]); a=MX3(a,C1[2],C1[3]); \
      _Pragma("unroll") for(int r=4;r<16;r+=4){a=MX3(a,C0[r],C0[r+1]);b=MX3(b,C0[r+2],C0[r+3]);a=MX3(a,C1[r],C1[r+1]);b=MX3(b,C1[r+2],C1[r+3]);} \
      float rm=__builtin_fmaxf(a,b); { auto rr=__builtin_amdgcn_permlane32_swap(__float_as_uint(rm),__float_as_uint(rm),false,false); rm=__builtin_fmaxf(__uint_as_float(rr[0]),__uint_as_float(rr[1])); } \
      resc=false; \
      if(__builtin_expect(__any(rm>(float)THRL),0)){ const float dl=__builtin_fmaxf(rm,0.f); mhat+=dl; \
        _Pragma("unroll") for(int r=0;r<16;++r){C0[r]-=dl;C1[r]-=dl;} \
        const float f=__builtin_amdgcn_exp2f(-dl); l_reg*=f; if(hi==0)wsf[r32]=f; resc=true; } \
      if constexpr(MODE==1){ if(resc || ((((t)+1)&3)==0)) SETNEGM((t)+1); } else { if(resc) SETNEGM((t)+1); } } \
    SBAR(); \
    GAPB(o[0]=__builtin_amdgcn_mfma_f32_32x32x16_bf16(PAF(0),VFR(0),o[0],0,0,0), C0,0); \
    GAPB(o[1]=__builtin_amdgcn_mfma_f32_32x32x16_bf16(PAF(0),VFR(4),o[1],0,0,0), C0,4); \
    KRD(GL,0); GAPB(o[0]=__builtin_amdgcn_mfma_f32_32x32x16_bf16(PAF(1),VFR(1),o[0],0,0,0), C0,8); \
    KRD(GL,1); GAPB(o[1]=__builtin_amdgcn_mfma_f32_32x32x16_bf16(PAF(1),VFR(5),o[1],0,0,0), C0,12); \
    KRD(GL,2); GAPB(o[0]=__builtin_amdgcn_mfma_f32_32x32x16_bf16(PAF(2),VFR(2),o[0],0,0,0), C1,0); \
    KRD(GL,3); GAPB(o[1]=__builtin_amdgcn_mfma_f32_32x32x16_bf16(PAF(2),VFR(6),o[1],0,0,0), C1,4); \
    GAPB(o[0]=__builtin_amdgcn_mfma_f32_32x32x16_bf16(PAF(3),VFR(3),o[0],0,0,0), C1,8); \
    GAPB(o[1]=__builtin_amdgcn_mfma_f32_32x32x16_bf16(PAF(3),VFR(7),o[1],0,0,0), C1,12); \
    }while(0)
  int t=1;
  #undef CMASK
  #define CMASK(P0,P1,t) tile_mask<MODE,false>(P0,P1,(t),NT,qrel,hi,cfl3,mring)
  for(;t+5<NT;t+=2){
    STEP(pB0,pB1,pA0,pA1,t,true,true,true);     WAIT_BAR(2); RESC(); ROT();
    STEP(pA0,pA1,pB0,pB1,t+1,true,true,true);   WAIT_BAR(2); RESC(); ROT();
  }
  #undef CMASK
  #define CMASK(P0,P1,t) tile_mask<MODE,true>(P0,P1,(t),NT,qrel,hi,cfl3,mring)
  #define ENDW(tt) do{ if((tt)+3<NT){WAIT_BAR(2);} else if((tt)+2<NT){WAIT_BAR(1);} else {WAIT_BAR(0);} }while(0)
  for(;t+1<NT;t+=2){
    STEP(pB0,pB1,pA0,pA1,t,(t+3<NT),(t+1<NT),(t+1<NT));       ENDW(t);   RESC(); ROT();
    STEP(pA0,pA1,pB0,pB1,t+1,(t+4<NT),(t+2<NT),(t+2<NT));     ENDW(t+1); RESC(); ROT();
  }
  STEP(pB0,pB1,pA0,pA1,NT-1,false,false,false); RESC();
  { float sacc=pB0[0]+pB0[1]; _Pragma("unroll") for(int r=2;r<16;++r)sacc+=pB0[r]; _Pragma("unroll") for(int r=0;r<16;++r)sacc+=pB1[r]; l_reg+=sacc;
    pw0=(u32x4){PKW(pB0,0),PKW(pB0,2),PKW(pB0,4),PKW(pB0,6)};pw1=(u32x4){PKW(pB0,8),PKW(pB0,10),PKW(pB0,12),PKW(pB0,14)};pw2=(u32x4){PKW(pB1,0),PKW(pB1,2),PKW(pB1,4),PKW(pB1,6)};pw3=(u32x4){PKW(pB1,8),PKW(pB1,10),PKW(pB1,12),PKW(pB1,14)};
    SBAR(); pv(o,vb0+sl_cur,PAF(0),PAF(1),PAF(2),PAF(3)); }
  #undef PKW
  #undef PAF
  #undef VFR
  #undef PIN
  #undef MX3
  #undef GAPA
  #undef GAPB
  #undef EX
  #undef VRD
  #undef KRD
  #undef STEP
  #undef ENDW
  {auto rr=__builtin_amdgcn_permlane32_swap(__float_as_uint(l_reg),__float_as_uint(l_reg),false,false);l_reg=__uint_as_float(rr[0])+__uint_as_float(rr[1]);}
  if(hi==0)wsf[32+r32]=l_reg;asm volatile("s_waitcnt lgkmcnt(0)":::"memory");
  float rli[16];
  #pragma unroll
  for(int r=0;r<16;++r)rli[r]=__builtin_amdgcn_rcpf(wsf[32+crow(r,hi)]);
  bf16*Ow=O+(rowbase+q0+wid*QBLK)*ODM+h*D;
  { bf16*stg=(bf16*)(shm+LDS_OST)+wid*2048;
    #pragma unroll
    for(int r=0;r<16;++r){const int orow=crow(r,hi);
      #pragma unroll
      for(int d0=0;d0<2;++d0)stg[orow*64+d0*32+r32]=__float2bfloat16(o[d0][r]*rli[r]);}
    asm volatile("s_waitcnt lgkmcnt(0)":::"memory");
    #pragma unroll
    for(int i=0;i<4;++i){const int row=i*8+(lane>>3),ch=lane&7; const u32x4 v=*(const u32x4*)(stg+row*64+ch*8); ATTN_STORE16(Ow+(long)row*ODM+ch*8,v);} }
  asm volatile("s_waitcnt lgkmcnt(0)\n\ts_barrier":::"memory");
  #undef DMA_K
  #undef DMA_V
  #undef DMA_M
  #undef CMASK
  #undef START
  #undef RESC
  #undef ROT
  #undef SETNEGM
}
constexpr int ATTN_LDS_BYTES=LDS_TOTAL;
#undef SBAR
#undef WAIT_BAR
}
#define GAS __attribute__((address_space(1)))
#define LAS __attribute__((address_space(3)))
typedef unsigned short bf16;
typedef unsigned v4u __attribute__((ext_vector_type(4)));
typedef float f32x4 __attribute__((ext_vector_type(4)));
typedef short bf16x8 __attribute__((ext_vector_type(8)));
typedef GAS unsigned gu32;
typedef GAS unsigned long long gu64;
#define RLX_AGENT __ATOMIC_RELAXED, __HIP_MEMORY_SCOPE_AGENT
#define LDS_WAIT() asm volatile("s_waitcnt lgkmcnt(0)" ::: "memory")
#define VM_WAIT() asm volatile("s_waitcnt vmcnt(0)" ::: "memory")
__device__ __forceinline__ unsigned long long rt() { return __builtin_amdgcn_s_memrealtime(); }
__device__ __forceinline__ unsigned f2bf(float f) { unsigned u = __builtin_bit_cast(unsigned, f); return (u + 0x7fffu + ((u >> 16) & 1u)) >> 16; }
__device__ __forceinline__ unsigned pk2(float lo, float hi) { return f2bf(lo) | (f2bf(hi) << 16); }

#define XB_TMO      128
#define XB_XCNT(j)  (256  + 64 * (j))
#define XB_XSUB(j)  (1280 + 64 * (j))
#define XB_XGEN(j)  (2304 + 64 * (j))
#define XB_TOP      3328
#define XB_TOPGEN   3392
#define XCD_BAR_WORDS 3456
#define XB_SPIN_CAP (1u << 18)

__device__ __forceinline__ unsigned xb_ld(unsigned* p)              { return __hip_atomic_load(p, __ATOMIC_RELAXED, __HIP_MEMORY_SCOPE_AGENT); }
__device__ __forceinline__ unsigned xb_add(unsigned* p, unsigned v) { return __hip_atomic_fetch_add(p, v, __ATOMIC_RELAXED, __HIP_MEMORY_SCOPE_AGENT); }
__device__ __forceinline__ unsigned xb_xcc_id() { return (unsigned)__builtin_amdgcn_s_getreg((3 << 11) | 20) & 0xFu; }
#define XB_SPIN(cond, bar) do { unsigned _sp = 0; while (cond) { __builtin_amdgcn_s_sleep(1); \
    if ((++_sp & 255u) == 0u) { if (xb_ld(&(bar)[XB_TMO])) break; if (_sp > XB_SPIN_CAP) { atomicAdd(&(bar)[XB_TMO], 1u); break; } } } } while (0)

struct XcdBarrier {
    unsigned* bar; unsigned x;
    volatile LAS unsigned* st;
};

__device__ __forceinline__ XcdBarrier xcd_barrier_post(unsigned* bar, volatile LAS unsigned* st) {
    XcdBarrier b; b.bar = bar; b.x = xb_xcc_id(); b.st = st;
    if (threadIdx.x == 0) (void)xb_add(&bar[XB_XCNT(b.x)], 1u);
    return b;
}
__device__ __forceinline__ void xcd_barrier_complete(unsigned* bar, unsigned x, unsigned& nloc, unsigned& nx) {
    const unsigned G = gridDim.x * gridDim.y * gridDim.z;
    unsigned sum, cnt, mine, sp = 0u;
    for (;;) {
        sum = 0u; cnt = 0u; mine = 0u;
#pragma unroll
        for (unsigned j = 0; j < 16; ++j) { const unsigned c = xb_ld(&bar[XB_XCNT(j)]); sum += c; cnt += (c > 0u) ? 1u : 0u; mine = (j == x) ? c : mine; }
        if (sum == G) break;
        __builtin_amdgcn_s_sleep(1);
        if ((++sp & 255u) == 0u) { if (xb_ld(&bar[XB_TMO])) break; if (sp > XB_SPIN_CAP) { atomicAdd(&bar[XB_TMO], 1u); break; } }
    }
    nloc = mine > 0u ? mine : 1u; nx = cnt > 0u ? cnt : 1u;
}

__device__ __forceinline__ void xcd_barrier(const XcdBarrier& b) {
    asm volatile("s_waitcnt vmcnt(0)" ::: "memory");
    __syncthreads();
    if (threadIdx.x == 0) {
        unsigned* bar = b.bar;
        __builtin_amdgcn_s_waitcnt(0);
        unsigned nloc = b.st[0], nx = b.st[1];
        if (nloc == 0u) { xcd_barrier_complete(bar, b.x, nloc, nx); b.st[0] = nloc; b.st[1] = nx; }
        const unsigned old = xb_add(&bar[XB_XSUB(b.x)], 1u);
        const unsigned gen = old / nloc;
        if (old + 1u == (gen + 1u) * nloc) {
            __builtin_amdgcn_fence(__ATOMIC_RELEASE, "agent");
            asm volatile("s_waitcnt vmcnt(0)" ::: "memory");
            const unsigned og = xb_add(&bar[XB_TOP], 1u);
            const unsigned tg = og / nx;
            if (og + 1u == (tg + 1u) * nx) xb_add(&bar[XB_TOPGEN], 1u);
            else XB_SPIN(xb_ld(&bar[XB_TOPGEN]) == tg, bar);
            __builtin_amdgcn_fence(__ATOMIC_ACQUIRE, "agent");
            xb_add(&bar[XB_XGEN(b.x)], 1u);
            asm volatile("s_waitcnt vmcnt(0)" ::: "memory");
        } else {
            XB_SPIN(xb_ld(&bar[XB_XGEN(b.x)]) == gen, bar);
            __builtin_amdgcn_fence(__ATOMIC_ACQUIRE, "agent");
            asm volatile("s_waitcnt vmcnt(0)" ::: "memory");
        }
    }
    __syncthreads();
}

constexpr int NWAVES = 8, NTHR = 512;
constexpr int NB = 2, SEQ = 8192, T = NB * SEQ, DMODEL = 1024, FFH = 2816;
constexpr int UB_P = 3328, UA_P = 3072;
constexpr int NWIN = 6656, NWIN_B = 3584, NWIN_A = 3072;
constexpr float EPS = 1e-6f;
constexpr float LOG2E = 1.4426950408889634f;
constexpr float C2 = 0.125f * 1.4426950408889634f;
constexpr size_t MiB = 1u << 20;
constexpr size_t WS_CTL = 0, CTL_ZERO_BYTES = 1 * MiB;
constexpr size_t WS_ROPEC = 1 * MiB, WS_ROPES = 2 * MiB;
constexpr size_t WS_CF2 = 3 * MiB, WS_ACS = WS_CF2 + 512 * 1024, WS_DTA = WS_ACS + 512 * 1024;
constexpr size_t WS_SELM = WS_DTA + 512 * 1024, WS_KPART = WS_SELM + 512 * 1024, WS_IKB = WS_KPART + 512 * 1024;
constexpr size_t WS_WIN = 8 * MiB;
constexpr size_t WS_WG = 8 * MiB, WS_WB = 16 * MiB;
constexpr size_t WS_H = 24 * MiB;
constexpr size_t WS_Y = 56 * MiB;
constexpr size_t WS_U = 120 * MiB;
constexpr size_t WS_XT = 216 * MiB;
constexpr size_t WS_MASK = 232 * MiB;
constexpr size_t WS_BC = 232 * MiB, WS_CC = 240 * MiB;
constexpr size_t WS_MISC = 248 * MiB;
constexpr size_t WS_STATE = WS_Y;
constexpr size_t WS_BT = WS_Y + 16 * MiB, WS_PREV = WS_Y + 24 * MiB;
constexpr size_t WS_G = 120 * MiB, WS_MG = 152 * MiB;
constexpr size_t WS_W2B = 232 * MiB;
constexpr size_t WS_WO = WS_W2B, WS_WF1 = WS_W2B + 2 * MiB, WS_WF2 = WS_W2B + 13 * MiB;
constexpr size_t WS_HP = 56 * MiB;
constexpr size_t WS_END = 256 * MiB;
static_assert(WS_IKB + (size_t)T * 64 * 2 <= WS_WIN && WS_WIN + (size_t)NWIN * 1024 * 2 <= WS_H && WS_U + (size_t)T * UB_P * 2 <= WS_MASK && WS_U + (size_t)T * UA_P * 2 <= WS_XT, "ws map 1");
static_assert(WS_WF2 + (size_t)1024 * FFH * 2 <= WS_END && WS_HP + (size_t)T * FFH * 2 <= WS_MG && WS_MG + (size_t)T * 1024 * 4 <= WS_W2B && WS_MISC + (size_t)T * 128 * 4 <= WS_END, "ws map 2");
constexpr int CW_BAR = 4096;
constexpr int CW_QKN = 8192;
constexpr int CW_WQ = 8448;
constexpr int RING_BYTES = 131072;
constexpr int XTRA_OFF = RING_BYTES;
constexpr int LDSCTL_OFF = RING_BYTES + 8192, MISC_OFF = LDSCTL_OFF + 320;
constexpr int LDS_BYTES = 147456;
static_assert(MISC_OFF + 128 <= LDS_BYTES, "LDS map");

__device__ __forceinline__ float wave_sum(float v) {
#pragma unroll
    for (int o = 1; o < 64; o <<= 1) v += __shfl_xor(v, o);
    return v;
}
__device__ __forceinline__ float bfl(unsigned w) { return __builtin_bit_cast(float, w << 16); }
__device__ __forceinline__ float bfh(unsigned w) { return __builtin_bit_cast(float, w & 0xffff0000u); }
__device__ __forceinline__ float silu_(float x) { return x / (1.0f + __expf(-x)); }
__device__ __forceinline__ float softplus_(float x) { return fmaxf(x, 0.f) + log1pf(expf(-fabsf(x))); }
__device__ __forceinline__ float logsigmoid_(float x) { return fminf(x, 0.f) - log1pf(expf(-fabsf(x))); }

struct MapWin { __device__ __forceinline__ int operator()(int r) const {
    if (r < 3072) return 3088 + r;
    if (r < 3328) return 6160 + (r - 3072);
    if (r < 3584) { const int m = r - 3328; if (m < 64) return 6416 + m; if (m < 68) return 6480 + (m - 64); if (m < 76) return 1536 + (m - 68); if (m < 84) return 3080 + (m - 76); return -1; }
    const int a = r - 3584; if (a < 1536) return a;
    return 1544 + (a - 1536); } };
struct MapId { int off; __device__ __forceinline__ int operator()(int r) const { return off + r; } };
struct MapFfn { __device__ __forceinline__ int operator()(int r) const { const int t = r >> 8, w = r & 255; return w < 128 ? 128 * t + w : FFH + 128 * t + (w - 128); } };
template <class Map> __device__ __forceinline__ void tr_items(const float* W, int N, int K, bf16* WT, int nrows, Map map, LAS float* scr, int gw, int NGW, int lane) {
    const int nrb = nrows / 32, nitems = nrb * (K / 64);
    for (int it = gw; it < nitems; it += NGW) {
        const int rb = it % nrb, kb = it / nrb, r0 = rb * 32, k0 = kb * 64;
        const int c = map(r0 + (lane & 31));
#pragma unroll 8
        for (int i = 0; i < 32; ++i) { const int kk = 2 * i + (lane >> 5); scr[kk * 33 + (lane & 31)] = (c >= 0) ? W[(size_t)(k0 + kk) * N + c] : 0.f; }
        LDS_WAIT(); asm volatile("" ::: "memory");
        const int cc = lane & 7;
#pragma unroll
        for (int j = 0; j < 4; ++j) { const int n = (lane >> 3) + 8 * j; const LAS float* s = scr + (8 * cc) * 33 + n;
            v4u o; o.x = pk2(s[0 * 33], s[1 * 33]); o.y = pk2(s[2 * 33], s[3 * 33]); o.z = pk2(s[4 * 33], s[5 * 33]); o.w = pk2(s[6 * 33], s[7 * 33]);
            *(GAS v4u*)(WT + (size_t)(r0 + n) * K + k0 + 8 * cc) = o; }
        LDS_WAIT(); asm volatile("" ::: "memory");
    }
}
__device__ __forceinline__ void norm_rows_to_bf16(const float* X, const float* g, bf16* Hout, int gw, int NGW, int lane) {
    for (int m = gw; m < T; m += NGW) {
        const f32x4* xr = (const f32x4*)(X + (size_t)m * DMODEL) + lane;
        f32x4 v[4]; float s = 0.f;
#pragma unroll
        for (int j = 0; j < 4; ++j) { v[j] = xr[64 * j]; s += (v[j].x * v[j].x + v[j].y * v[j].y) + (v[j].z * v[j].z + v[j].w * v[j].w); }
        const float rstd = 1.0f / sqrtf(wave_sum(s) * (1.0f / DMODEL) + EPS);
        unsigned long long* o8 = (unsigned long long*)(Hout + (size_t)m * DMODEL) + lane;
#pragma unroll
        for (int j = 0; j < 4; ++j) { const f32x4 gv = ((const f32x4*)g)[lane + 64 * j];
            o8[64 * j] = (unsigned long long)pk2(v[j].x * rstd * gv.x, v[j].y * rstd * gv.y) | ((unsigned long long)pk2(v[j].z * rstd * gv.z, v[j].w * rstd * gv.w) << 32); }
    }
}
__device__ __forceinline__ void norm_res_rows(const float* V, const float* g1, const float* xold, float* xout, const float* g2, bf16* Hout, int gw, int NGW, int lane) {
    for (int m = gw; m < T; m += NGW) {
        const f32x4* vr = (const f32x4*)(V + (size_t)m * DMODEL) + lane; const f32x4* xr = (const f32x4*)(xold + (size_t)m * DMODEL) + lane;
        f32x4 v[4], x[4]; float s = 0.f;
#pragma unroll
        for (int j = 0; j < 4; ++j) { v[j] = vr[64 * j]; x[j] = xr[64 * j]; s += (v[j].x * v[j].x + v[j].y * v[j].y) + (v[j].z * v[j].z + v[j].w * v[j].w); }
        const float rstd = 1.0f / sqrtf(wave_sum(s) * (1.0f / DMODEL) + EPS);
        float s2 = 0.f; f32x4* xo = (f32x4*)(xout + (size_t)m * DMODEL) + lane;
#pragma unroll
        for (int j = 0; j < 4; ++j) { const f32x4 gv = ((const f32x4*)g1)[lane + 64 * j]; x[j] = x[j] + v[j] * rstd * gv; xo[64 * j] = x[j];
            s2 += (x[j].x * x[j].x + x[j].y * x[j].y) + (x[j].z * x[j].z + x[j].w * x[j].w); }
        if (g2) {
            const float rstd2 = 1.0f / sqrtf(wave_sum(s2) * (1.0f / DMODEL) + EPS);
            unsigned long long* o8 = (unsigned long long*)(Hout + (size_t)m * DMODEL) + lane;
#pragma unroll
            for (int j = 0; j < 4; ++j) { const f32x4 gv = ((const f32x4*)g2)[lane + 64 * j];
                o8[64 * j] = (unsigned long long)pk2(x[j].x * rstd2 * gv.x, x[j].y * rstd2 * gv.y) | ((unsigned long long)pk2(x[j].z * rstd2 * gv.z, x[j].w * rstd2 * gv.w) << 32); }
        }
    }
}
__device__ __forceinline__ void rope_tables(float* RC, float* RS, int gtid, int NGT) {
    for (int i = gtid; i < SEQ * 32; i += NGT) { const int pos = i >> 5, k = i & 31;
        const float inv = powf(10000.0f, -(float)(2 * k) / 64.0f); const float ang = (float)pos * inv;
        RC[i] = cosf(ang); RS[i] = sinf(ang); }
}
__device__ __forceinline__ void rope_pair4(unsigned long long& a, unsigned long long& b, const f32x4 c, const f32x4 s, f32x4& o1, f32x4& o2) {
    const unsigned a0 = (unsigned)a, a1 = (unsigned)(a >> 32), b0 = (unsigned)b, b1 = (unsigned)(b >> 32);
    const f32x4 x1 = {bfl(a0), bfh(a0), bfl(a1), bfh(a1)}, x2 = {bfl(b0), bfh(b0), bfl(b1), bfh(b1)};
    o1 = x1 * c - x2 * s; o2 = x2 * c + x1 * s;
    a = (unsigned long long)pk2(o1.x, o1.y) | ((unsigned long long)pk2(o1.z, o1.w) << 32); b = (unsigned long long)pk2(o2.x, o2.y) | ((unsigned long long)pk2(o2.z, o2.w) << 32);
}
__device__ __forceinline__ void rope_phase(bf16* UB, const float* MISCF, bf16* IKB, float* KPART, const float* RC, const float* RS, LAS unsigned char* lds, int G, int bx, int tid, int lane, int wave) {
    LAS float* red = (LAS float*)lds;
    for (int unit = bx; unit < T / 64; unit += G) {
        f32x4 ks1 = {0.f, 0.f, 0.f, 0.f}, ks2 = {0.f, 0.f, 0.f, 0.f};
        const int hd = lane >> 3, d = (lane & 7) * 4;
        for (int i = 0; i < 8; ++i) {
            const int m = unit * 64 + wave * 8 + i, pos = m & (SEQ - 1);
            const f32x4 c = *(const f32x4*)(RC + pos * 32 + d), s = *(const f32x4*)(RS + pos * 32 + d);
            bf16* row = UB + (size_t)m * UB_P;
            const int segs[4] = {0, 512, 1536, 2048};
#pragma unroll
            for (int sg = 0; sg < 4; ++sg) {
                unsigned long long* p1 = (unsigned long long*)(row + segs[sg] + hd * 64 + d); unsigned long long* p2 = (unsigned long long*)(row + segs[sg] + hd * 64 + 32 + d);
                unsigned long long a = *p1, b = *p2; f32x4 o1, o2; rope_pair4(a, b, c, s, o1, o2); *p1 = a; *p2 = b;
                if (sg == 1) { ks1 = ks1 + o1; ks2 = ks2 + o2; }
            }
            if (lane < 32) {
                unsigned long long* p1 = (unsigned long long*)(row + 3072 + hd * 64 + d); unsigned long long* p2 = (unsigned long long*)(row + 3072 + hd * 64 + 32 + d);
                unsigned long long a = *p1, b = *p2; f32x4 o1, o2; rope_pair4(a, b, c, s, o1, o2); *p1 = a; *p2 = b;
            }
            if (lane < 8) {
                const f32x4 x1 = *(const f32x4*)(MISCF + (size_t)m * 128 + d), x2 = *(const f32x4*)(MISCF + (size_t)m * 128 + 32 + d);
                const f32x4 o1 = x1 * c - x2 * s, o2 = x2 * c + x1 * s;
                *(unsigned long long*)(IKB + (size_t)m * 64 + d) = (unsigned long long)pk2(o1.x, o1.y) | ((unsigned long long)pk2(o1.z, o1.w) << 32);
                *(unsigned long long*)(IKB + (size_t)m * 64 + 32 + d) = (unsigned long long)pk2(o2.x, o2.y) | ((unsigned long long)pk2(o2.z, o2.w) << 32);
            }
        }
        *(LAS f32x4*)(red + wave * 512 + hd * 64 + d) = ks1; *(LAS f32x4*)(red + wave * 512 + hd * 64 + 32 + d) = ks2;
        __syncthreads();
        { float a = 0.f;
#pragma unroll
          for (int w = 0; w < 8; ++w) a += red[w * 512 + tid];
          KPART[(size_t)unit * 512 + tid] = a; }
        __syncthreads();
    }
}
__device__ __forceinline__ void moba_gate_phase(const bf16* UB, const float* KPART, unsigned* SELM, LAS unsigned char* lds, int G, int bx, int tid, int lane, int wave) {
    LAS float* km = (LAS float*)lds;
    for (int unit = bx; unit < T / 64; unit += G) {
        const int b = (unit * 64) / SEQ;
        __syncthreads();
#pragma unroll 4
        for (int i = tid; i < 8 * 32 * 64; i += NTHR) { const int dd = i & 63, n = (i >> 6) & 31, hh = i >> 11;
            const float* kp = KPART + (size_t)(b * 128 + 4 * n) * 512 + hh * 64 + dd;
            km[(hh * 32 + n) * 68 + dd] = ((kp[0] + kp[512]) + (kp[1024] + kp[1536])) * (1.0f / 256.0f); }
        __syncthreads();
        const int hd = lane >> 3, j = lane & 7;
#pragma unroll 1
        for (int i = 0; i < 8; ++i) {
            const int m = unit * 64 + wave * 8 + i, pos = m & (SEQ - 1), cur = pos >> 8;
            const v4u* qp = (const v4u*)(UB + (size_t)m * UB_P + hd * 64);
            v4u qv[8];
#pragma unroll
            for (int k = 0; k < 8; ++k) qv[k] = qp[k];
            float val[4];
#pragma unroll
            for (int ii = 0; ii < 4; ++ii) { const int n = j + 8 * ii; const LAS f32x4* kr = (const LAS f32x4*)(km + (hd * 32 + n) * 68); float acc = 0.f;
#pragma unroll
                for (int k = 0; k < 8; ++k) { const f32x4 k0 = kr[2 * k], k1 = kr[2 * k + 1]; const v4u q = qv[k];
                    acc += bfl(q.x) * k0.x + bfh(q.x) * k0.y + bfl(q.y) * k0.z + bfh(q.y) * k0.w + bfl(q.z) * k1.x + bfh(q.z) * k1.y + bfl(q.w) * k1.z + bfh(q.w) * k1.w; }
                val[ii] = (n < cur) ? acc : -INFINITY; asm volatile("" ::: "memory"); }
            unsigned selmask = 0u;
#pragma unroll
            for (int round = 0; round < 3; ++round) {
                float bv = val[0]; int bn = j;
#pragma unroll
                for (int ii = 1; ii < 4; ++ii) { if (val[ii] > bv) { bv = val[ii]; bn = j + 8 * ii; } }
#pragma unroll
                for (int o = 1; o < 8; o <<= 1) { const float ov = __shfl_xor(bv, o); const int on = __shfl_xor(bn, o); if (ov > bv || (ov == bv && on < bn)) { bv = ov; bn = on; } }
                if (bv > -INFINITY) selmask |= 1u << bn;
#pragma unroll
                for (int ii = 0; ii < 4; ++ii) if (bn == j + 8 * ii) val[ii] = -INFINITY;
            }
            if (j == 0) SELM[(size_t)m * 8 + hd] = selmask;
        }
    }
}
constexpr int DSA_CAP = 1792;
typedef __attribute__((ext_vector_type(8))) short dsa_bf16x8;
typedef __attribute__((ext_vector_type(4))) float dsa_f32x4;
struct DsaCtx { dsa_bf16x8 af[4][2]; float wq[4][4]; int b, p0, g4; };
struct DsaB { dsa_bf16x8 b0, b1; };
__device__ __forceinline__ DsaB dsa_loadb(const DsaCtx& c, const bf16* IKB, int key0, int lane) {
    const bf16* kp = IKB + ((size_t)c.b * SEQ + key0 + (lane & 15)) * 64 + 8 * (lane >> 4);
    DsaB r; r.b0 = *(const dsa_bf16x8*)(kp); r.b1 = *(const dsa_bf16x8*)(kp + 32); return r;
}
__device__ __forceinline__ DsaB dsa_loadbc(const DsaCtx& c, const bf16* IKB, int key0, int lane) {
    const bf16* kp = IKB + ((size_t)c.b * SEQ + min(key0 + (lane & 15), SEQ - 1)) * 64 + 8 * (lane >> 4);
    DsaB r; r.b0 = *(const dsa_bf16x8*)(kp); r.b1 = *(const dsa_bf16x8*)(kp + 32); return r;
}
struct DsaB4 { DsaB t[4]; };
__device__ __forceinline__ DsaB4 dsa_loadb4(const DsaCtx& c, const bf16* IKB, int key0g, int lane) {
    DsaB4 r;
#pragma unroll
    for (int j = 0; j < 4; ++j) { const int key = min(key0g + 16 * j + (lane & 15), SEQ - 1);
        const bf16* kp = IKB + ((size_t)c.b * SEQ + key) * 64 + 8 * (lane >> 4);
        r.t[j].b0 = *(const dsa_bf16x8*)(kp); r.t[j].b1 = *(const dsa_bf16x8*)(kp + 32); }
    return r;
}
template <bool CHECK> __device__ __forceinline__ void dsa_tile(const DsaCtx& c, const DsaB& bb, int key0, int lane, unsigned (&mono)[4], unsigned& vbits) {
    dsa_f32x4 a[4];
#pragma unroll
    for (int hh = 0; hh < 4; ++hh) { dsa_f32x4 z = {0.f, 0.f, 0.f, 0.f};
        z = __builtin_amdgcn_mfma_f32_16x16x32_bf16(c.af[hh][0], bb.b0, z, 0, 0, 0);
        a[hh] = __builtin_amdgcn_mfma_f32_16x16x32_bf16(c.af[hh][1], bb.b1, z, 0, 0, 0); }
    vbits = 0xfu;
    if constexpr (CHECK) { const int d = key0 + (lane & 15) - c.p0 - c.g4; vbits = (d <= 0 ? 1u : 0u) | (d <= 1 ? 2u : 0u) | (d <= 2 ? 4u : 0u) | (d <= 3 ? 8u : 0u); }
#pragma unroll
    for (int r = 0; r < 4; ++r) {
        float sc = c.wq[r][0] * __builtin_amdgcn_fmed3f(a[0][r], 0.f, INFINITY);
        sc = fmaf(c.wq[r][1], __builtin_amdgcn_fmed3f(a[1][r], 0.f, INFINITY), sc);
        sc = fmaf(c.wq[r][2], __builtin_amdgcn_fmed3f(a[2][r], 0.f, INFINITY), sc);
        sc = fmaf(c.wq[r][3], __builtin_amdgcn_fmed3f(a[3][r], 0.f, INFINITY), sc);
        const unsigned u = __builtin_bit_cast(unsigned, sc);
        mono[r] = u ^ ((unsigned)((int)u >> 31) | 0x80000000u);
    }
}
__device__ __forceinline__ void dsa_scores(const DsaCtx& c, const DsaB& bb, int key0, int lane, unsigned (&k22)[4], bool (&valid)[4]) {
    unsigned mono[4], vb; dsa_tile<true>(c, bb, key0, lane, mono, vb);
#pragma unroll
    for (int r = 0; r < 4; ++r) { k22[r] = mono[r] >> 10; valid[r] = (vb >> r) & 1u; }
}
__device__ __forceinline__ void dsa_scan(LAS unsigned* hist, int q, unsigned need, int lane, LAS unsigned* o_bin, LAS unsigned* o_above, LAS unsigned* o_cnt) {
    const LAS unsigned* hrow = hist + q * 2048; const int rot = 67 * q;
    unsigned cnt = 0;
#pragma unroll 8
    for (int i = 0; i < 32; ++i) cnt += hrow[(32 * lane + i + rot) & 2047];
    unsigned sfx = cnt;
#pragma unroll
    for (int o = 1; o < 64; o <<= 1) { const unsigned t = __shfl_down(sfx, o); if (lane + o < 64) sfx += t; }
    const unsigned above = sfx - cnt;
    if (lane == 0) { *o_bin = 0u; *o_above = 0u; *o_cnt = 0u; }
    if (above < need && sfx >= need) {
        unsigned cum = above;
        for (int i = 31; i >= 0; --i) { const unsigned h = hrow[(32 * lane + i + rot) & 2047];
            if (cum + h >= need) { *o_bin = (unsigned)(32 * lane + i); *o_above = cum; *o_cnt = h; break; }
            cum += h; }
    }
}
__device__ __forceinline__ void dsa_topk_phase(const bf16* UB, const bf16* IKB, const float* MISCF, unsigned long long* MASKT, LAS unsigned char* lds, int G, int bx, int vcu, int tid_in, int lane_in, int wave) {
    LAS unsigned* hist = (LAS unsigned*)lds;
    LAS unsigned* par = (LAS unsigned*)(lds + XTRA_OFF);
    const int nun = T / 16;
    for (int it = 0;; ++it) {
        int unit;
        if (G == 256) { if (it >= 4) break; unit = (it == 0) ? vcu : (it == 1) ? 511 - vcu : (it == 2) ? 512 + vcu : 1023 - vcu; }
        else { unit = bx + it * G; if (unit >= nun) break; }
        int tid = tid_in; asm volatile("" : "+v"(tid)); const int lane = tid & 63;
        DsaCtx c; const int row0 = unit * 16; c.b = row0 >> 13; c.p0 = row0 & (SEQ - 1); c.g4 = 4 * (lane >> 4);
        { const bf16* qp = UB + (size_t)(row0 + (lane & 15)) * UB_P + 3072 + 8 * (lane >> 4);
#pragma unroll
          for (int hh = 0; hh < 4; ++hh) { c.af[hh][0] = *(const dsa_bf16x8*)(qp + hh * 64); c.af[hh][1] = *(const dsa_bf16x8*)(qp + hh * 64 + 32); }
#pragma unroll
          for (int r = 0; r < 4; ++r) { const dsa_f32x4 w4 = *(const dsa_f32x4*)(MISCF + (size_t)(row0 + c.g4 + r) * 128 + 64);
              c.wq[r][0] = w4[0] * 0.0625f; c.wq[r][1] = w4[1] * 0.0625f; c.wq[r][2] = w4[2] * 0.0625f; c.wq[r][3] = w4[3] * 0.0625f; } }
        const int nmine = (c.p0 + 15 - 16 * wave >= 0) ? ((c.p0 + 15 - 16 * wave) >> 7) + 1 : 0;
        const int ngrp = (c.p0 + 15 - 64 * wave >= 0) ? ((c.p0 + 15 - 64 * wave) >> 9) + 1 : 0;
        int rotq[4], baseq[4];
#pragma unroll
        for (int r = 0; r < 4; ++r) { rotq[r] = 67 * (c.g4 + r); baseq[r] = (c.g4 + r) * 2048; }
        __syncthreads();
        for (int i = tid; i < 8192; i += NTHR) ((LAS v4u*)hist)[i] = (v4u){0u, 0u, 0u, 0u};
        if (tid == 0) par[96] = 0u;
        __syncthreads();
        { DsaB4 cur = dsa_loadb4(c, IKB, 64 * wave, lane);
          for (int s = 0; s < ngrp; ++s) { const int key0g = 512 * s + 64 * wave;
#pragma unroll
            for (int j = 0; j < 4; ++j) { const int key0 = key0g + 16 * j; const DsaB bt = cur.t[j];
              cur.t[j] = dsa_loadbc(c, IKB, (s + 1 < ngrp) ? key0 + 512 : key0, lane);
              if (key0 <= c.p0 + 15) { unsigned mono[4], vb; dsa_tile<true>(c, bt, key0, lane, mono, vb);
#pragma unroll
                for (int r = 0; r < 4; ++r) __hip_atomic_fetch_add(hist + baseq[r] + (((mono[r] >> 21) + rotq[r]) & 2047), (vb >> r) & 1u, __ATOMIC_RELAXED, __HIP_MEMORY_SCOPE_WORKGROUP); } } } }
        __syncthreads();
#pragma unroll
        for (int k = 0; k < 2; ++k) { const int q = 2 * wave + k; dsa_scan(hist, q, 256u, lane, par + q, par + 16 + q, par + 80 + q);
            if (lane == 0) { const bool all = (c.p0 + q) < 256;
                if (all) { par[q] = 0xffffffffu; par[16 + q] = 0u; par[80 + q] = 0u; } else if (par[80 + q] > (unsigned)DSA_CAP) par[96] = 1u; } }
        __syncthreads();
        const bool ovf = par[96] != 0u;
        LAS unsigned char* gtbase = lds;
        if (!ovf) {
            gtbase = lds + DSA_CAP * 64;
            LAS unsigned* cand = (LAS unsigned*)lds; LAS unsigned* cnt = par + 100;
            for (int i = tid; i < 1024; i += NTHR) ((LAS v4u*)gtbase)[i] = (v4u){0u, 0u, 0u, 0u};
            if (tid < 16) cnt[tid] = 0u;
            __syncthreads();
            { LAS unsigned short* gt16 = (LAS unsigned short*)gtbase;
              DsaB4 cur = dsa_loadb4(c, IKB, 64 * wave, lane); int pb1[4];
#pragma unroll
              for (int r = 0; r < 4; ++r) pb1[r] = (int)par[c.g4 + r];
              for (int s = 0; s < ngrp; ++s) { const int key0g = 512 * s + 64 * wave;
#pragma unroll
               for (int j = 0; j < 4; ++j) { const int key0 = key0g + 16 * j; const DsaB bt = cur.t[j];
                cur.t[j] = dsa_loadbc(c, IKB, (s + 1 < ngrp) ? key0 + 512 : key0, lane);
                if (key0 <= c.p0 + 15) { unsigned mono[4], vb; dsa_tile<true>(c, bt, key0, lane, mono, vb);
#pragma unroll
                for (int r = 0; r < 4; ++r) { const int bin = (int)(mono[r] >> 21); const bool v = (vb >> r) & 1u;
                    const unsigned long long bg = __ballot(v && bin > pb1[r]);
                    if (lane < 4) gt16[(4 * lane + r) * 512 + (key0 >> 4)] = (unsigned short)(bg >> (16 * lane));
                    if (v && bin == pb1[r]) { const int q = c.g4 + r; const unsigned pos = __hip_atomic_fetch_add(cnt + q, 1u, __ATOMIC_RELAXED, __HIP_MEMORY_SCOPE_WORKGROUP);
                        if (pos < (unsigned)DSA_CAP) cand[q * DSA_CAP + pos] = (((mono[r] >> 2) & 0x7ffffu) << 13) | (unsigned)(8191 - (key0 + (lane & 15))); } } } }
               } }
            __syncthreads();
            { LAS unsigned* gt32 = (LAS unsigned*)gtbase;
#pragma unroll 1
              for (int k = 0; k < 2; ++k) { const int q = 2 * wave + k; const unsigned n = min(cnt[q], (unsigned)DSA_CAP), need = 256u - par[16 + q];
                if ((int)par[q] != -1 && n > 0u) {
                    const LAS unsigned* cq = cand + q * DSA_CAP; unsigned thr = 0u;
                    for (int bit = 31; bit >= 0; --bit) { const unsigned trial = thr | (1u << bit); unsigned cge = 0u;
                        for (unsigned i = lane; i < n; i += 64) cge += (cq[i] >= trial) ? 1u : 0u;
#pragma unroll
                        for (int o = 1; o < 64; o <<= 1) cge += __shfl_xor(cge, o);
                        if (cge >= need) thr = trial; }
                    for (unsigned i = lane; i < n; i += 64) { const unsigned e = cq[i];
                        if (e >= thr) { const unsigned key = 8191u - (e & 8191u); __hip_atomic_fetch_or(gt32 + q * 256 + (key >> 5), 1u << (key & 31u), __ATOMIC_RELAXED, __HIP_MEMORY_SCOPE_WORKGROUP); } } } } }
            __syncthreads();
        } else {
            for (int i = tid; i < 8192; i += NTHR) ((LAS v4u*)hist)[i] = (v4u){0u, 0u, 0u, 0u};
            __syncthreads();
            { DsaB cur = dsa_loadb(c, IKB, 16 * wave, lane); unsigned pb1[4];
#pragma unroll
              for (int r = 0; r < 4; ++r) pb1[r] = par[c.g4 + r];
              for (int s = 0; s < nmine; ++s) { const int key0 = 128 * s + 16 * wave; const DsaB nxt = dsa_loadb(c, IKB, (s + 1 < nmine) ? key0 + 128 : key0, lane);
                unsigned k22[4]; bool valid[4]; dsa_scores(c, cur, key0, lane, k22, valid); cur = nxt;
#pragma unroll
                for (int r = 0; r < 4; ++r) { const int q = c.g4 + r; if (valid[r] && (k22[r] >> 11) == pb1[r]) __hip_atomic_fetch_add(hist + q * 2048 + (((k22[r] & 2047u) + 67 * q) & 2047), 1u, __ATOMIC_RELAXED, __HIP_MEMORY_SCOPE_WORKGROUP); } } }
            __syncthreads();
#pragma unroll
            for (int k = 0; k < 2; ++k) { const int q = 2 * wave + k; const unsigned c1 = par[16 + q];
                dsa_scan(hist, q, 256u - c1, lane, par + 32 + q, par + 48 + q, par + 64 + q);
                if (lane == 0) { const unsigned b2 = par[32 + q], c2 = par[48 + q]; const bool all = (c.p0 + q) < 256;
                    par[32 + q] = all ? 0xffffffffu : ((par[q] << 11) | b2); par[48 + q] = all ? 0u : (256u - c1 - c2); if (all) par[64 + q] = 0u; } }
            __syncthreads();
            for (int i = tid; i < 2048; i += NTHR) ((LAS v4u*)hist)[i] = (v4u){0u, 0u, 0u, 0u};
            __syncthreads();
            { LAS unsigned short* gt16 = (LAS unsigned short*)lds; LAS unsigned short* eq16 = (LAS unsigned short*)(lds + 16384);
              DsaB cur = dsa_loadb(c, IKB, 16 * wave, lane); int pt22[4];
#pragma unroll
              for (int r = 0; r < 4; ++r) pt22[r] = (int)par[32 + c.g4 + r];
              for (int s = 0; s < nmine; ++s) { const int key0 = 128 * s + 16 * wave; const DsaB nxt = dsa_loadb(c, IKB, (s + 1 < nmine) ? key0 + 128 : key0, lane);
                unsigned k22[4]; bool valid[4]; dsa_scores(c, cur, key0, lane, k22, valid); cur = nxt;
#pragma unroll
                for (int r = 0; r < 4; ++r) { const int t22 = pt22[r];
                    const bool gt = valid[r] && ((int)k22[r] > t22), eq = valid[r] && ((int)k22[r] == t22);
                    const unsigned long long bg = __ballot(gt), be = __ballot(eq);
                    if (lane < 4) { gt16[(4 * lane + r) * 512 + (key0 >> 4)] = (unsigned short)(bg >> (16 * lane)); eq16[(4 * lane + r) * 512 + (key0 >> 4)] = (unsigned short)(be >> (16 * lane)); } } } }
            __syncthreads();
            { LAS unsigned* gt32 = (LAS unsigned*)lds; LAS unsigned* eq32 = (LAS unsigned*)(lds + 16384);
#pragma unroll
              for (int k = 0; k < 2; ++k) { const int q = 2 * wave + k; const unsigned quota = par[48 + q], eqcnt = par[64 + q]; unsigned base = 0u;
                for (int rnd = 0; rnd < 4; ++rnd) { const int wi = q * 256 + rnd * 64 + lane; const unsigned e = eq32[wi]; unsigned kw = e;
                    if (eqcnt > quota) { const unsigned cn = __popc(e); unsigned inc = cn;
#pragma unroll
                        for (int o = 1; o < 64; o <<= 1) { const unsigned t = __shfl_up(inc, o); if (lane >= o) inc += t; }
                        const unsigned exc = base + inc - cn; base += __shfl(inc, 63);
                        if (exc + cn <= quota) kw = e; else if (exc >= quota) kw = 0u; else { unsigned rem = quota - exc, w = e; kw = 0u; while (rem > 0u) { const unsigned low = w & (0u - w); kw |= low; w ^= low; --rem; } } }
                    gt32[wi] |= kw; } } }
            __syncthreads();
        }
        { const LAS unsigned long long* gt64 = (const LAS unsigned long long*)gtbase;
#pragma unroll
          for (int k = 0; k < 4; ++k) { const int idx = tid + NTHR * k, qq = idx & 15, t = idx >> 4;
              MASKT[((size_t)(c.b * 128 + t)) * SEQ + c.p0 + qq] = gt64[qq * 128 + t]; } }
    }
    __syncthreads();
}
typedef __attribute__((ext_vector_type(8))) short s_bf16x8;
typedef __attribute__((ext_vector_type(16))) float s_f32x16;
__device__ __forceinline__ int crow_(int r, int hi) { return (r & 3) + 8 * (r >> 2) + 4 * hi; }
__device__ __forceinline__ void ssd_prep_phase(const bf16* UA, const float* MISCF, const float* conv_w, const float* conv_b, const float* dt_bias, const float* a_log, const float* fbias,
                                               float* CF2, float* ACS, float* DTA, bf16* XT, bf16* BT, bf16* BC, bf16* CC, unsigned* QKN, LAS unsigned char* lds, int G, int bx, int tid, int lane, int wave) {
    const int NU = 16 + 64 + 256;
    for (int unit = bx; unit < NU; unit += G) {
        __syncthreads();
        if (unit < 16) {
            const int b = unit >> 3, h = unit & 7; const float fb = fbias[h];
            float v[16]; float run = 0.f;
#pragma unroll
            for (int i = 0; i < 16; ++i) { const int t = 16 * tid + i; run += logsigmoid_(MISCF[((size_t)b * SEQ + t) * 128 + 76 + h] + fb) * LOG2E; v[i] = run; }
            float inc = run;
#pragma unroll
            for (int o = 1; o < 64; o <<= 1) { const float t_ = __shfl_up(inc, o); if (lane >= o) inc += t_; }
            LAS float* wt = (LAS float*)lds;
            if (lane == 63) wt[wave] = inc;
            __syncthreads();
            float off = inc - run;
            for (int w = 0; w < wave; ++w) off += wt[w];
#pragma unroll
            for (int i = 0; i < 16; ++i) CF2[((size_t)b * 8 + h) * SEQ + 16 * tid + i] = off + v[i];
        } else if (unit < 80) {
            const int u = unit - 16, b = u >> 5, cch = u & 31, h = wave;
            const float bias = dt_bias[h], a = -expf(a_log[h]);
            float dtv[4], cs[4]; float run = 0.f;
#pragma unroll
            for (int i = 0; i < 4; ++i) { const int t = cch * 256 + 4 * lane + i; dtv[i] = softplus_(MISCF[((size_t)b * SEQ + t) * 128 + 68 + h] + bias); run += dtv[i] * a; cs[i] = run; }
            float inc = run;
#pragma unroll
            for (int o = 1; o < 64; o <<= 1) { const float t_ = __shfl_up(inc, o); if (lane >= o) inc += t_; }
            const float off = inc - run;
#pragma unroll
            for (int i = 0; i < 4; ++i) { const size_t o_ = ((size_t)b * 8 + h) * SEQ + cch * 256 + 4 * lane + i; ACS[o_] = off + cs[i]; DTA[o_] = dtv[i]; }
        } else {
            const int u = unit - 80, b = u >> 7, t0 = (u & 127) * 64; const int ch0 = 2 * tid;
            {
                const int tt = tid >> 3, hd = tid & 7; const bf16* qrow = UA + ((size_t)b * SEQ + t0 + tt) * UA_P + 1536 + hd * 64;
                float q2 = 0.f, k2 = 0.f;
#pragma unroll
                for (int k8 = 0; k8 < 8; ++k8) { const v4u a4 = *(const v4u*)(qrow + 8 * k8), b4 = *(const v4u*)(qrow + 512 + 8 * k8);
                    q2 += bfl(a4.x) * bfl(a4.x) + bfh(a4.x) * bfh(a4.x) + bfl(a4.y) * bfl(a4.y) + bfh(a4.y) * bfh(a4.y) + bfl(a4.z) * bfl(a4.z) + bfh(a4.z) * bfh(a4.z) + bfl(a4.w) * bfl(a4.w) + bfh(a4.w) * bfh(a4.w);
                    k2 += bfl(b4.x) * bfl(b4.x) + bfh(b4.x) * bfh(b4.x) + bfl(b4.y) * bfl(b4.y) + bfh(b4.y) * bfh(b4.y) + bfl(b4.z) * bfl(b4.z) + bfh(b4.z) * bfh(b4.z) + bfl(b4.w) * bfl(b4.w) + bfh(b4.w) * bfh(b4.w); }
#pragma unroll
                for (int o = 8; o < 64; o <<= 1) { q2 = fmaxf(q2, __shfl_xor(q2, o)); k2 = fmaxf(k2, __shfl_xor(k2, o)); }
                if (lane < 8) { __hip_atomic_fetch_max(QKN + (b * 8 + hd) * 2, __builtin_bit_cast(unsigned, q2), __ATOMIC_RELAXED, __HIP_MEMORY_SCOPE_AGENT);
                                __hip_atomic_fetch_max(QKN + (b * 8 + hd) * 2 + 1, __builtin_bit_cast(unsigned, k2), __ATOMIC_RELAXED, __HIP_MEMORY_SCOPE_AGENT); }
            }
            LAS unsigned short* tl = (LAS unsigned short*)lds;
            float cw[4][2], cb[2];
#pragma unroll
            for (int w = 0; w < 4; ++w) { cw[w][0] = conv_w[w * 1024 + ch0]; cw[w][1] = conv_w[w * 1024 + ch0 + 1]; }
            cb[0] = conv_b[ch0]; cb[1] = conv_b[ch0 + 1];
            const bf16* src = UA + ((size_t)b * SEQ) * UA_P + 512 + ch0;
            float r0[2] = {0.f, 0.f}, r1[2] = {0.f, 0.f}, r2[2] = {0.f, 0.f};
            if (t0 > 0) { const unsigned w0 = *(const unsigned*)(src + (size_t)(t0 - 3) * UA_P), w1 = *(const unsigned*)(src + (size_t)(t0 - 2) * UA_P), w2 = *(const unsigned*)(src + (size_t)(t0 - 1) * UA_P);
                r0[0] = bfl(w0); r0[1] = bfh(w0); r1[0] = bfl(w1); r1[1] = bfh(w1); r2[0] = bfl(w2); r2[1] = bfh(w2); }
#pragma unroll 8
            for (int tt = 0; tt < 64; ++tt) {
                const unsigned wv = *(const unsigned*)(src + (size_t)(t0 + tt) * UA_P); const float c0 = bfl(wv), c1 = bfh(wv);
                const float y0 = cb[0] + cw[0][0] * r0[0] + cw[1][0] * r1[0] + cw[2][0] * r2[0] + cw[3][0] * c0;
                const float y1 = cb[1] + cw[0][1] * r0[1] + cw[1][1] * r1[1] + cw[2][1] * r2[1] + cw[3][1] * c1;
                r0[0] = r1[0]; r0[1] = r1[1]; r1[0] = r2[0]; r1[1] = r2[1]; r2[0] = c0; r2[1] = c1;
                const unsigned o0 = f2bf(silu_(y0)), o1 = f2bf(silu_(y1));
                if (ch0 < 768) { tl[ch0 * 68 + tt] = (unsigned short)o0; tl[(ch0 + 1) * 68 + tt] = (unsigned short)o1; }
                if (ch0 >= 512) { const size_t row = (size_t)b * SEQ + t0 + tt;
                    if (ch0 < 768) *(unsigned*)(BC + row * 256 + (ch0 - 512)) = o0 | (o1 << 16); else *(unsigned*)(CC + row * 256 + (ch0 - 768)) = o0 | (o1 << 16); }
            }
            __syncthreads();
#pragma unroll
            for (int k = 0; k < 12; ++k) { const int idx = tid + NTHR * k, rowc = idx >> 3, chunk = idx & 7;
                const LAS unsigned long long* sp = (const LAS unsigned long long*)(tl + rowc * 68 + chunk * 8);
                const unsigned long long lo = sp[0], hi = sp[1];
                bf16* dst = (rowc < 512) ? XT + (((size_t)b * 8 + (rowc >> 6)) * 64 + (rowc & 63)) * SEQ + t0 + chunk * 8
                                         : BT + (((size_t)b * 2 + ((rowc - 512) >> 7)) * 128 + ((rowc - 512) & 127)) * SEQ + t0 + chunk * 8;
                v4u o; o.x = (unsigned)lo; o.y = (unsigned)(lo >> 32); o.z = (unsigned)hi; o.w = (unsigned)(hi >> 32); *(v4u*)dst = o; }
        }
    }
    __syncthreads();
}
__device__ __forceinline__ void ssd_state_phase(const bf16* XT, const bf16* BT, const float* ACS, const float* DTA, float* STATE, LAS unsigned char* lds, int G, int bx, int tid, int lane, int wave) {
    LAS float* wl = (LAS float*)lds;
    const int r32 = lane & 31, hi = lane >> 5, d0 = wave & 1, nb = wave >> 1;
    for (int unit = bx; unit < NB * 32 * 8; unit += G) {
        const int h = unit & 7, cch = (unit >> 3) & 31, b = unit >> 8, g = h >> 2;
        __syncthreads();
        if (tid < 256) { const size_t o_ = ((size_t)b * 8 + h) * SEQ + cch * 256; wl[tid] = DTA[o_ + tid] * expf(ACS[o_ + 255] - ACS[o_ + tid]); }
        __syncthreads();
        const bf16* xp = XT + (((size_t)b * 8 + h) * 64 + 32 * d0 + r32) * SEQ + cch * 256 + 8 * hi;
        const bf16* bp = BT + (((size_t)b * 2 + g) * 128 + 32 * nb + r32) * SEQ + cch * 256 + 8 * hi;
        s_f32x16 acc = {};
#pragma unroll 4
        for (int k = 0; k < 16; ++k) {
            const v4u xa = *(const v4u*)(xp + 16 * k); const s_bf16x8 bb = *(const s_bf16x8*)(bp + 16 * k);
            const LAS f32x4* w4 = (const LAS f32x4*)(wl + 16 * k + 8 * hi); const f32x4 wa = w4[0], wb = w4[1];
            v4u xs; xs.x = pk2(bfl(xa.x) * wa.x, bfh(xa.x) * wa.y); xs.y = pk2(bfl(xa.y) * wa.z, bfh(xa.y) * wa.w); xs.z = pk2(bfl(xa.z) * wb.x, bfh(xa.z) * wb.y); xs.w = pk2(bfl(xa.w) * wb.z, bfh(xa.w) * wb.w);
            acc = __builtin_amdgcn_mfma_f32_32x32x16_bf16(__builtin_bit_cast(s_bf16x8, xs), bb, acc, 0, 0, 0);
        }
        float* sp = STATE + ((((size_t)b * 32 + cch) * 8 + h) * 64 + 32 * d0) * 128 + 32 * nb + r32;
#pragma unroll
        for (int r = 0; r < 16; ++r) sp[(size_t)crow_(r, hi) * 128] = acc[r];
    }
    __syncthreads();
}
__device__ __forceinline__ void ssd_scan_phase(const float* STATE, const float* ACS, bf16* PREV, int G, int bx, int tid) {
    for (int idx = bx * NTHR + tid; idx < NB * 8 * 8192; idx += G * NTHR) {
        const int b = idx >> 16, h = (idx >> 13) & 7, pn = idx & 8191; float run = 0.f;
#pragma unroll 4
        for (int cch = 0; cch < 32; ++cch) { const size_t o_ = (((size_t)b * 32 + cch) * 8 + h) * 8192 + pn;
            const float s = STATE[o_]; PREV[o_] = (bf16)f2bf(run);
            run = run * expf(ACS[((size_t)b * 8 + h) * SEQ + cch * 256 + 255]) + s; }
    }
}
__device__ __forceinline__ void ssd_out_phase(const bf16* UA, const bf16* XT, const bf16* BC, const bf16* CC, const bf16* PREV, const float* ACS, const float* DTA, const float* d_skip, bf16* Y0,
                                              int G, int bx, int lane, int wave) {
    const int r32 = lane & 31, hi = lane >> 5;
    for (int unit = bx; unit < NB * 32 * 8; unit += G) {
        const int h = unit & 7, cch = (unit >> 3) & 31, b = unit >> 8, g = h >> 2;
        const int ql = 32 * wave + r32; const size_t rowl = (size_t)b * SEQ + cch * 256 + ql;
        const size_t abase = ((size_t)b * 8 + h) * SEQ + cch * 256;
        const float acs_l = ACS[abase + ql], Dh = d_skip[h];
        s_bf16x8 cf[8];
#pragma unroll
        for (int kn = 0; kn < 8; ++kn) cf[kn] = *(const s_bf16x8*)(CC + rowl * 256 + g * 128 + 16 * kn + 8 * hi);
        s_f32x16 o[2]; o[0] = s_f32x16{}; o[1] = s_f32x16{};
        { const bf16* pp = PREV + ((((size_t)b * 32 + cch) * 8 + h) * 64 + r32) * 128 + 8 * hi;
#pragma unroll
          for (int d0 = 0; d0 < 2; ++d0)
#pragma unroll
              for (int kn = 0; kn < 8; ++kn) o[d0] = __builtin_amdgcn_mfma_f32_32x32x16_bf16(*(const s_bf16x8*)(pp + (size_t)d0 * 32 * 128 + 16 * kn), cf[kn], o[d0], 0, 0, 0);
          const float e = expf(acs_l);
#pragma unroll
          for (int r = 0; r < 16; ++r) { o[0][r] *= e; o[1][r] *= e; } }
        const bf16* xp = XT + (((size_t)b * 8 + h) * 64 + r32) * SEQ + cch * 256 + 4 * hi;
        for (int st = 0; st <= wave; ++st) {
            s_f32x16 s = {};
            { const bf16* bp = BC + ((size_t)b * SEQ + cch * 256 + 32 * st + r32) * 256 + g * 128 + 8 * hi;
#pragma unroll
              for (int kn = 0; kn < 8; ++kn) s = __builtin_amdgcn_mfma_f32_32x32x16_bf16(*(const s_bf16x8*)(bp + 16 * kn), cf[kn], s, 0, 0, 0); }
            float P[16];
#pragma unroll
            for (int gq = 0; gq < 4; ++gq) { const f32x4 a4 = *(const f32x4*)(ACS + abase + 32 * st + 8 * gq + 4 * hi), d4 = *(const f32x4*)(DTA + abase + 32 * st + 8 * gq + 4 * hi);
#pragma unroll
                for (int j = 0; j < 4; ++j) { const int key = 32 * st + 8 * gq + 4 * hi + j;
                    const float f = (key <= ql) ? expf(fminf(acs_l - a4[j], 0.f)) * d4[j] : 0.f;
                    float p = s[4 * gq + j] * f; if (key == ql) p += Dh; P[4 * gq + j] = p; } }
            v4u pf0, pf1;
            pf0.x = pk2(P[0], P[1]); pf0.y = pk2(P[2], P[3]); pf0.z = pk2(P[4], P[5]); pf0.w = pk2(P[6], P[7]);
            pf1.x = pk2(P[8], P[9]); pf1.y = pk2(P[10], P[11]); pf1.z = pk2(P[12], P[13]); pf1.w = pk2(P[14], P[15]);
#pragma unroll
            for (int d0 = 0; d0 < 2; ++d0) { const bf16* xq = xp + (size_t)d0 * 32 * SEQ + 32 * st;
                const unsigned long long a0 = *(const unsigned long long*)(xq), a1 = *(const unsigned long long*)(xq + 8), a2 = *(const unsigned long long*)(xq + 16), a3 = *(const unsigned long long*)(xq + 24);
                v4u x0, x1; x0.x = (unsigned)a0; x0.y = (unsigned)(a0 >> 32); x0.z = (unsigned)a1; x0.w = (unsigned)(a1 >> 32); x1.x = (unsigned)a2; x1.y = (unsigned)(a2 >> 32); x1.z = (unsigned)a3; x1.w = (unsigned)(a3 >> 32);
                o[d0] = __builtin_amdgcn_mfma_f32_32x32x16_bf16(__builtin_bit_cast(s_bf16x8, x0), __builtin_bit_cast(s_bf16x8, pf0), o[d0], 0, 0, 0);
                o[d0] = __builtin_amdgcn_mfma_f32_32x32x16_bf16(__builtin_bit_cast(s_bf16x8, x1), __builtin_bit_cast(s_bf16x8, pf1), o[d0], 0, 0, 0); }
        }
#pragma unroll
        for (int d0 = 0; d0 < 2; ++d0)
#pragma unroll
            for (int gq = 0; gq < 4; ++gq) { const int p = 32 * d0 + 8 * gq + 4 * hi;
                const unsigned long long zw = *(const unsigned long long*)(UA + rowl * UA_P + h * 64 + p); const unsigned z0 = (unsigned)zw, z1 = (unsigned)(zw >> 32);
                const float y0 = o[d0][4 * gq] * silu_(bfl(z0)), y1 = o[d0][4 * gq + 1] * silu_(bfh(z0)), y2 = o[d0][4 * gq + 2] * silu_(bfl(z1)), y3 = o[d0][4 * gq + 3] * silu_(bfh(z1));
                *(unsigned long long*)(Y0 + rowl * 512 + h * 64 + p) = (unsigned long long)pk2(y0, y1) | ((unsigned long long)pk2(y2, y3) << 32); }
    }
}
__device__ __forceinline__ void ssd_gnorm_phase(bf16* Y0, const float* normw, int gw, int NGW, int lane) {
    for (int m = gw; m < T; m += NGW) {
        v4u* p = (v4u*)(Y0 + (size_t)m * 512) + lane; const v4u w = *p;
        float v[8] = {bfl(w.x), bfh(w.x), bfl(w.y), bfh(w.y), bfl(w.z), bfh(w.z), bfl(w.w), bfh(w.w)}; float s = 0.f;
#pragma unroll
        for (int j = 0; j < 8; ++j) s += v[j] * v[j];
#pragma unroll
        for (int o = 1; o < 32; o <<= 1) s += __shfl_xor(s, o);
        const float rstd = 1.0f / sqrtf(s * (1.0f / 256.0f) + EPS);
        const f32x4 g0 = ((const f32x4*)normw)[2 * lane], g1 = ((const f32x4*)normw)[2 * lane + 1];
        v4u o; o.x = pk2(v[0] * rstd * g0.x, v[1] * rstd * g0.y); o.y = pk2(v[2] * rstd * g0.z, v[3] * rstd * g0.w); o.z = pk2(v[4] * rstd * g1.x, v[5] * rstd * g1.y); o.w = pk2(v[6] * rstd * g1.z, v[7] * rstd * g1.w);
        *p = o;
    }
}
typedef attn_body::bf16 abf;
template <int ONLY> __device__ __forceinline__ void attn_bd_phase(char* lds, const bf16* UB, bf16* Y2, bf16* Y3, const unsigned* SELM, const unsigned long long* MASKT, int G, int vcu, int tid) {
    for (int v = vcu; v < 256; v += G)
        for (int i = 0; i < 4; ++i) {
            const int s = v & 15, qb = (i & 1) ? 31 - s : s, bh = ((i >> 1) << 4) | (v >> 4);
            int tid_u = tid; asm volatile("" : "+v"(tid_u));
            const int branch = bh >> 4, b = (bh >> 3) & 1, h = bh & 7;
            if (ONLY >= 0 && branch != ONLY) continue;
#ifdef ATT_BASE
            attn_body::attn_unit<8, 3, ATT_BASE_DM, ATT_BASE_ODM>(b, h, qb, (const abf*)UB, (const abf*)UB + 512, (const abf*)UB + 1024, (abf*)Y2, lds, SELM, nullptr, tid_u);
#endif
#ifndef ATT_SKIP1
            if (branch == 0) attn_body::attn_unit<8, 1, UB_P, 512>(b, h, qb, (const abf*)UB, (const abf*)UB + 512, (const abf*)UB + 1024, (abf*)Y2, lds, SELM, nullptr, tid_u);
#endif
#ifndef ATT_SKIP2
            if (branch == 1) attn_body::attn_unit<8, 2, UB_P, 512>(b, h, qb, (const abf*)UB + 1536, (const abf*)UB + 2048, (const abf*)UB + 2560, (abf*)Y3, lds, MASKT, nullptr, tid_u);
#endif
        }
}
__device__ __forceinline__ void attn_fox_phase(char* lds, volatile LAS unsigned* slot, const bf16* UA, bf16* Y1, const float* CF2, const float* QKN, unsigned* counter, int tid) {
    for (;;) {
        if (tid == 0) *slot = __hip_atomic_fetch_add(counter, 1u, __ATOMIC_RELAXED, __HIP_MEMORY_SCOPE_AGENT);
        __syncthreads();
        const unsigned u = (unsigned)__builtin_amdgcn_readfirstlane((int)*slot);
        if (u >= 512u) break;
        const int qb = 31 - (int)(u >> 4), bh = (int)(u & 15u), b = bh >> 3, h = bh & 7;
        int tid_u = tid; asm volatile("" : "+v"(tid_u));
        attn_body::attn_unit<8, 0, UA_P, 512>(b, h, qb, (const abf*)UA + 1536, (const abf*)UA + 2048, (const abf*)UA + 2560, (abf*)Y1, lds, CF2, QKN, tid_u);
    }
}
template <class Epi> __device__ __forceinline__ void run_gemm(LAS unsigned char* lds, const bf16* A, int lda, const bf16* Bt, int ldb, int N, int K, int G, int bx, int tid, const Epi& E) {
    pg8::Gemm g{A, Bt, T, N, K, lda, ldb}; pg8::StaticOrder S; S.init(T, N, G, bx);
    pg8::gemm_phase<Epi, pg8::StaticOrder, true, true>(lds, g, S, E, tid);
}

constexpr int PH_PER_LAYER = 24, N_PHASES = 2 * PH_PER_LAYER;
struct Args { const float* in[19]; float* out; unsigned char* ws; int ph_lo, ph_hi; };
#define RC ((float*)(ws + WS_ROPEC))
#define RS ((float*)(ws + WS_ROPES))
#define CF2 ((float*)(ws + WS_CF2))
#define ACS ((float*)(ws + WS_ACS))
#define DTA ((float*)(ws + WS_DTA))
#define SELM ((unsigned*)(ws + WS_SELM))
#define KPART ((float*)(ws + WS_KPART))
#define IKB ((bf16*)(ws + WS_IKB))
#define WIN ((bf16*)(ws + WS_WIN))
#define WG ((bf16*)(ws + WS_WG))
#define WB ((bf16*)(ws + WS_WB))
#define H ((bf16*)(ws + WS_H))
#define Y ((bf16*)(ws + WS_Y))
#define U ((bf16*)(ws + WS_U))
#define XT ((bf16*)(ws + WS_XT))
#define MASKT ((unsigned long long*)(ws + WS_MASK))
#define BC ((bf16*)(ws + WS_BC))
#define CC ((bf16*)(ws + WS_CC))
#define MISCF ((float*)(ws + WS_MISC))
#define STATE ((float*)(ws + WS_STATE))
#define BT ((bf16*)(ws + WS_BT))
#define PREV ((bf16*)(ws + WS_PREV))
#define GB ((bf16*)(ws + WS_G))
#define MG ((float*)(ws + WS_MG))
#define WO ((bf16*)(ws + WS_WO))
#define WF1 ((bf16*)(ws + WS_WF1))
#define WF2 ((bf16*)(ws + WS_WF2))
#define HP ((bf16*)(ws + WS_HP))
#define Y0 (Y)
#define Y1 (Y + (size_t)T * 512)
#define Y2 (Y + (size_t)2 * T * 512)
#define Y3 (Y + (size_t)3 * T * 512)

#ifndef PH_MASK
#define PH_MASK 0xffffffu
#endif
#define PHASE_PROLOGUE \
    int tid = threadIdx.x; asm volatile("" : "+v"(tid)); \
    int G = gridDim.x, bx = blockIdx.x; asm volatile("" : "+s"(G), "+s"(bx)); \
    unsigned long long wsi_ = (unsigned long long)args.ws; asm volatile("" : "+s"(wsi_)); unsigned char* ws = (unsigned char*)(GAS unsigned char*)wsi_;     \
    const int lane = tid & 63, wave = __builtin_amdgcn_readfirstlane(tid >> 6); \
    const int vcu = (G % 8 == 0) ? (bx % 8) * (G / 8) + bx / 8 : bx; \
    const int gw = vcu * NWAVES + wave, NGW = G * NWAVES, gtid = bx * NTHR + tid, NGT = G * NTHR; \
    LAS float* scr = (LAS float*)(lds + wave * 16384); \
    (void)lane; (void)vcu; (void)gw; (void)NGW; (void)gtid; (void)NGT; (void)scr; (void)ws;
#define IN(k) (lo <= (k) && (k) < hi && ((PH_MASK >> ((k) % PH_PER_LAYER)) & 1u))
#define INR(k) (lo <= (k) && (k) < hi)
#define SEAM(k) do { if (INR(k) && INR((k) + 1)) { if ((k) == 0) { asm volatile("s_waitcnt vmcnt(0)" ::: "memory"); cg::this_grid().sync(); } else xcd_barrier(bar); } } while (0)

#ifndef DUP_MASK
#define DUP_MASK 0u
#endif
#ifndef XTRA_BAR
#define XTRA_BAR 0
#endif
#define DUP(k) (((DUP_MASK >> ((k) % PH_PER_LAYER)) & 1u) != 0u)
#define PHASE(k, ...) do { if (IN(k)) { PHASE_PROLOGUE __VA_ARGS__ } if (DUP(k) && IN(k)) { PHASE_PROLOGUE __VA_ARGS__ } } while (0)
#undef SEAM
#define SEAM(k) do { if (INR(k) && INR((k) + 1)) { if ((k) == 0) { asm volatile("s_waitcnt vmcnt(0)" ::: "memory"); cg::this_grid().sync(); } else xcd_barrier(bar); \
    for (int xb_ = 0; xb_ < XTRA_BAR; ++xb_) xcd_barrier(bar); } } while (0)

template <int L> __device__ __forceinline__ void run_layer(const Args& args, const int lo, const int hi, const XcdBarrier& bar, LAS unsigned char* lds, unsigned char* lds_raw) {
    constexpr int B0 = L * PH_PER_LAYER;
    if (L == 0) {
        PHASE(B0 + 0,
            tr_items(args.in[2], 6484, 1024, WIN, NWIN, MapWin{}, scr, gw, NGW, lane);
            rope_tables(RC, RS, gtid, NGT);
            norm_rows_to_bf16(args.in[0], args.in[1], H, gw, NGW, lane); );
        SEAM(B0 + 0);
    }
    PHASE(B0 + 1,
        pg8::EpiIn E{U, UB_P, (1u << 0) | (1u << 1) | (1u << 6) | (1u << 7), C2, 13, MISCF};
        run_gemm(lds, H, 1024, WIN, 1024, NWIN_B, 1024, G, bx, tid, E); );
    SEAM(B0 + 1);
    PHASE(B0 + 2, rope_phase(U, MISCF, IKB, KPART, RC, RS, lds, G, bx, tid, lane, wave); );
    SEAM(B0 + 2);
    if (IN(B0 + 3)) { PHASE_PROLOGUE moba_gate_phase(U, KPART, SELM, lds, G, bx, tid, lane, wave); }
    if (IN(B0 + 3) && ((DUP_MASK >> 24) & 1u)) { PHASE_PROLOGUE moba_gate_phase(U, KPART, SELM, lds, G, bx, tid, lane, wave); }
    if (IN(B0 + 3)) { PHASE_PROLOGUE dsa_topk_phase(U, IKB, MISCF, MASKT, lds, G, bx, vcu, tid, lane, wave); }
    if (IN(B0 + 3) && ((DUP_MASK >> 25) & 1u)) { PHASE_PROLOGUE dsa_topk_phase(U, IKB, MISCF, MASKT, lds, G, bx, vcu, tid, lane, wave); }
    SEAM(B0 + 3);
    PHASE(B0 + 4, attn_bd_phase<-1>((char*)lds_raw, U, Y2, Y3, SELM, MASKT, G, vcu, tid); );
    if (IN(B0 + 4) && ((DUP_MASK >> 26) & 1u)) { PHASE_PROLOGUE attn_bd_phase<0>((char*)lds_raw, U, Y2, Y3, SELM, MASKT, G, vcu, tid); }
    if (IN(B0 + 4) && ((DUP_MASK >> 27) & 1u)) { PHASE_PROLOGUE attn_bd_phase<1>((char*)lds_raw, U, Y2, Y3, SELM, MASKT, G, vcu, tid); }
    SEAM(B0 + 4);
    PHASE(B0 + 5,
        pg8::EpiIn E{U, UA_P, (1u << 6) | (1u << 7), C2, -1, nullptr};
        run_gemm(lds, H, 1024, WIN + (size_t)NWIN_B * 1024, 1024, NWIN_A, 1024, G, bx, tid, E); );
    SEAM(B0 + 5);
    PHASE(B0 + 6, ssd_prep_phase(U, MISCF, args.in[3] + (size_t)L * 4096, args.in[4] + L * 1024, args.in[5] + L * 8, args.in[6] + L * 8, args.in[9] + L * 8, CF2, ACS, DTA, XT, BT, BC, CC, (unsigned*)(ws + WS_CTL) + CW_QKN + L * 32, lds, G, bx, tid, lane, wave); );
    SEAM(B0 + 6);
    PHASE(B0 + 7, ssd_state_phase(XT, BT, ACS, DTA, STATE, lds, G, bx, tid, lane, wave); );
    SEAM(B0 + 7);
    PHASE(B0 + 8, ssd_scan_phase(STATE, ACS, PREV, G, bx, tid); );
    SEAM(B0 + 8);
    PHASE(B0 + 9, ssd_out_phase(U, XT, BC, CC, PREV, ACS, DTA, args.in[7] + L * 8, Y0, G, bx, lane, wave); );
    SEAM(B0 + 9);
    if (IN(B0 + 10)) { PHASE_PROLOGUE ssd_gnorm_phase(Y0, args.in[8] + L * 512, gw, NGW, lane); }
#ifndef DUP10_ATTN_ONLY
#define DUP10_ATTN_ONLY 1
#endif
    if (IN(B0 + 10)) { PHASE_PROLOGUE
        tr_items(args.in[10] + (size_t)L * 1024 * 4096, 4096, 1024, WG, 4096, MapId{0}, scr, gw, NGW, lane);
        for (int n = 0; n < 4; ++n) tr_items(args.in[12] + ((size_t)L * 4 + n) * 512 * 1024, 1024, 512, WB + (size_t)n * 1024 * 512, 1024, MapId{0}, scr, gw, NGW, lane);
        tr_items(args.in[13] + (size_t)L * 1024 * 1024, 1024, 1024, WO, 1024, MapId{0}, scr, gw, NGW, lane);
        tr_items(args.in[16] + (size_t)L * 1024 * 5632, 5632, 1024, WF1, 5632, MapFfn{}, scr, gw, NGW, lane);
        tr_items(args.in[17] + (size_t)L * FFH * 1024, 1024, FFH, WF2, 1024, MapId{0}, scr, gw, NGW, lane);
        __syncthreads();
    }
    if (IN(B0 + 10)) { PHASE_PROLOGUE attn_fox_phase((char*)lds_raw, (volatile LAS unsigned*)(lds + MISC_OFF) + 16, U, Y1, CF2, (const float*)(ws + WS_CTL) + CW_QKN + L * 32, (unsigned*)(ws + WS_CTL) + CW_WQ + 128 * L, tid); }
    if (DUP(B0 + 10) && IN(B0 + 10)) { PHASE_PROLOGUE attn_fox_phase((char*)lds_raw, (volatile LAS unsigned*)(lds + MISC_OFF) + 16, U, Y1, CF2, (const float*)(ws + WS_CTL) + CW_QKN + L * 32, (unsigned*)(ws + WS_CTL) + CW_WQ + 128 * L + 64, tid); }
    SEAM(B0 + 10);
    if (IN(B0 + 11)) {
#pragma unroll
        for (int n = 0; n < 4; ++n) {
            { PHASE_PROLOGUE
              pg8::EpiSig E{GB, 1024, args.in[11] + (size_t)L * 4096 + n * 1024};
              run_gemm(lds, H, 1024, WG + (size_t)n * 1024 * 1024, 1024, 1024, 1024, G, bx, tid, E); }
            asm volatile("s_waitcnt vmcnt(0)" ::: "memory"); __syncthreads();
            { PHASE_PROLOGUE
              pg8::EpiBranch E{GB, MG, 1024, n == 0, n == 3};
              run_gemm(lds, Y + (size_t)n * T * 512, 512, WB + (size_t)n * 1024 * 512, 512, 1024, 512, G, bx, tid, E); }
            asm volatile("s_waitcnt vmcnt(0)" ::: "memory"); __syncthreads();
        }
    }
    SEAM(B0 + 11);
    PHASE(B0 + 19, pg8::EpiF32 E{MG, 1024}; run_gemm(lds, GB, 1024, WO, 1024, 1024, 1024, G, bx, tid, E); );
    SEAM(B0 + 19);
    if (IN(B0 + 20)) { PHASE_PROLOGUE norm_res_rows(MG, args.in[14] + L * 1024, (L == 0) ? args.in[0] : (const float*)args.out, args.out, args.in[15] + L * 1024, H, gw, NGW, lane); }
    SEAM(B0 + 20);
    PHASE(B0 + 21, pg8::EpiSwi E{HP, FFH}; run_gemm(lds, H, 1024, WF1, 1024, 5632, 1024, G, bx, tid, E); );
    SEAM(B0 + 21);
    PHASE(B0 + 22, pg8::EpiF32 E{MG, 1024}; run_gemm(lds, HP, FFH, WF2, FFH, 1024, FFH, G, bx, tid, E); );
    SEAM(B0 + 22);
    if (IN(B0 + 23)) { PHASE_PROLOGUE
        norm_res_rows(MG, args.in[18] + L * 1024, args.out, args.out, (L == 0) ? args.in[1] + 1024 : nullptr, H, gw, NGW, lane);
        if (L == 0) tr_items(args.in[2] + (size_t)1024 * 6484, 6484, 1024, WIN, NWIN, MapWin{}, scr, gw, NGW, lane);
    }
    if (L == 0) SEAM(B0 + 23);
}

__global__ void __launch_bounds__(NTHR, 2) hybrid_fwd(Args args) {
    extern __shared__ __attribute__((aligned(16))) unsigned char lds_raw[];
    LAS unsigned char* lds = (LAS unsigned char*)lds_raw;
    for (int u = threadIdx.x; u < (LDS_BYTES - LDSCTL_OFF) / 4; u += NTHR) ((LAS unsigned*)(lds + LDSCTL_OFF))[u] = 0u;
    __syncthreads();
    const int lo = args.ph_lo, hi = args.ph_hi;
    XcdBarrier bar; bar.bar = (unsigned*)(args.ws + WS_CTL) + CW_BAR; bar.x = 0; bar.st = nullptr;
    if (hi - lo > 1) bar = xcd_barrier_post((unsigned*)(args.ws + WS_CTL) + CW_BAR, (volatile LAS unsigned*)(lds + MISC_OFF) + 8);
    run_layer<0>(args, lo, hi, bar, lds, lds_raw);
    run_layer<1>(args, lo, hi, bar, lds, lds_raw);
}

#ifndef MK_PER_PHASE
#define MK_PER_PHASE 0
#endif
extern "C" void kernel_launch(void* const* d_in, const int* in_sizes, int n_in, void* d_out, int out_size, void* d_ws, size_t ws_size, hipStream_t stream) {
    static int grid = 0;
    if (grid == 0) {
        if (n_in != 19 || in_sizes[0] != T * DMODEL || out_size != T * DMODEL || ws_size < WS_END) { fprintf(stderr, "kernel_launch: unexpected shapes (n_in %d, in0 %d, out %d, ws %zu); nothing launched\n", n_in, n_in > 0 ? in_sizes[0] : -1, out_size, ws_size); grid = -1; return; }
        int dev = 0, cus = 0, per_cu = 0;
        if (hipGetDevice(&dev) != hipSuccess || hipDeviceGetAttribute(&cus, hipDeviceAttributeMultiprocessorCount, dev) != hipSuccess) { grid = -1; return; }
        if (hipFuncSetAttribute((const void*)hybrid_fwd, hipFuncAttributeMaxDynamicSharedMemorySize, LDS_BYTES) != hipSuccess) { fprintf(stderr, "kernel_launch: hipFuncSetAttribute failed\n"); grid = -1; return; }
        if (hipOccupancyMaxActiveBlocksPerMultiprocessor(&per_cu, (const void*)hybrid_fwd, NTHR, LDS_BYTES) != hipSuccess || per_cu < 1) { fprintf(stderr, "kernel_launch: occupancy query says %d\n", per_cu); per_cu = 1; }
        (void)hipGetLastError();
        grid = cus * 1;
        if (grid > 256) grid = 256;
    }
    if (grid < 0) return;
    (void)hipMemsetAsync((char*)d_ws + WS_CTL, 0, CTL_ZERO_BYTES, stream);
    Args a{};
    for (int i = 0; i < 19; ++i) a.in[i] = (const float*)d_in[i];
    a.out = (float*)d_out; a.ws = (unsigned char*)d_ws;
#if MK_PER_PHASE
    for (int p = 0; p < N_PHASES; ++p) { a.ph_lo = p; a.ph_hi = p + 1; hipLaunchKernelGGL(hybrid_fwd, dim3(grid), dim3(NTHR), LDS_BYTES, stream, a); }
#else
    a.ph_lo = 0; a.ph_hi = N_PHASES;
    void* kargs[] = {&a};
    hipError_t e = hipLaunchCooperativeKernel((const void*)hybrid_fwd, dim3(grid), dim3(NTHR), kargs, LDS_BYTES, stream);
    if (e != hipSuccess) fprintf(stderr, "kernel_launch: cooperative launch failed: %s (grid %d)\n", hipGetErrorString(e), grid);
#endif
}
```
